# Optimizing an MI355X kernel written in HIP

```python
import jax, jax.numpy as jnp
from jax import lax
import numpy as np

D_MODEL = 1024
BATCH = 4
SEQ = 8192
DEPTH = 2

N_MIXERS = 2
CONV_WIDTH = 3
ATTN_GROUPS = ((128, 1), (512, 4), (2048, 16))
N_GROUPS = len(ATTN_GROUPS)
HEADS_PER_GROUP = 5
HEAD_DIM = 64
ATTN_WIDTH = N_GROUPS * HEADS_PER_GROUP * HEAD_DIM
ROPE_THETA = 10000.0
D_FF = 2816
N_EXPERTS = 8
TOP_K = 2
D_FF_EXPERT = 2816
RMS_EPS = 1e-6
N_EVEN = (DEPTH + 1) // 2
N_ODD = DEPTH // 2

kernel_name = "hybrid_conv_dilated_attn_moe_adaln"


def rms_norm(x, g):
    xf = x.astype(jnp.float32)
    y = xf * lax.rsqrt(jnp.mean(xf * xf, axis=-1, keepdims=True) + RMS_EPS)
    return (y * g.astype(jnp.float32)).astype(x.dtype)


def ada_params(c, w, b):
    mod = jax.nn.silu(c) @ w + b
    shift, scale, gate = jnp.split(mod, 3, axis=-1)
    return shift[:, None, :], scale[:, None, :], gate[:, None, :]


def modulated_residual(x, c, g, w_mod, b_mod, fn):
    shift, scale, gate = ada_params(c, w_mod, b_mod)
    h = rms_norm(x, g) * (1 + scale) + shift
    return x + gate * fn(h)


def rope(x, positions):
    inv_freq = ROPE_THETA ** (-jnp.arange(0, HEAD_DIM, 2, dtype=jnp.float32) / HEAD_DIM)
    ang = positions.astype(jnp.float32)[..., None] * inv_freq
    cos, sin = jnp.cos(ang)[:, :, None, :], jnp.sin(ang)[:, :, None, :]
    xf = x.astype(jnp.float32)
    x1, x2 = jnp.split(xf, 2, axis=-1)
    return jnp.concatenate([x1 * cos - x2 * sin, x2 * cos + x1 * sin], axis=-1).astype(x.dtype)


def short_conv_mixer(h, w_in, conv_w, w_out):
    b_gate, c_gate, u = jnp.split(h @ w_in, 3, axis=-1)
    v = c_gate * u
    conv = lax.conv_general_dilated(
        v, conv_w.astype(v.dtype)[:, None, :], window_strides=(1,),
        padding=[(CONV_WIDTH - 1, 0)], dimension_numbers=('NWC', 'WIO', 'NWC'),
        feature_group_count=v.shape[-1])
    return (b_gate * conv) @ w_out


def dilated_group_attention(q, k, v, dilation, steps):
    b, s, nh, dh = q.shape
    chunk = dilation * steps
    sp = -(-s // chunk) * chunk
    nb = sp // chunk
    pad = [(0, 0), (0, sp - s), (0, 0), (0, 0)]

    def to_blocks(t):
        return jnp.pad(t, pad).reshape(b, nb, steps, dilation, nh, dh)

    def with_prev(t):
        prev = jnp.pad(t[:, :-1], [(0, 0), (1, 0), (0, 0), (0, 0), (0, 0), (0, 0)])
        return jnp.concatenate([prev, t], axis=2)

    qb = to_blocks(q)
    kk = with_prev(to_blocks(k))
    vv = with_prev(to_blocks(v))
    scores = jnp.einsum('bnqrhd,bnkrhd->bnrhqk', qb, kk,
                        preferred_element_type=jnp.float32) * (dh ** -0.5)
    a = jnp.arange(steps)[:, None]
    j = jnp.arange(2 * steps)[None, :]
    band = (j >= a) & (j <= a + steps)
    not_first = jnp.arange(nb)[:, None, None] > 0
    valid = band[None] & (not_first | (j >= steps)[None])
    scores = jnp.where(valid[None, :, None, None], scores, -jnp.inf)
    lse = jax.nn.logsumexp(scores, axis=-1)
    p = jnp.exp(scores - lse[..., None])
    o = jnp.einsum('bnrhqk,bnkrhd->bnqrhd', p.astype(v.dtype), vv)
    o = o.reshape(b, sp, nh, dh)[:, :s]
    lse = lse.transpose(0, 1, 4, 2, 3).reshape(b, sp, nh)[:, :s]
    return o, lse


def dilated_attention_mixer(h, positions, w_qkv, w_o):
    b, s, _ = h.shape
    nh = N_GROUPS * HEADS_PER_GROUP
    qkv = (h @ w_qkv).reshape(b, s, 3, nh, HEAD_DIM)
    q = rope(qkv[:, :, 0], positions).reshape(b, s, N_GROUPS, HEADS_PER_GROUP, HEAD_DIM)
    k = rope(qkv[:, :, 1], positions).reshape(b, s, N_GROUPS, HEADS_PER_GROUP, HEAD_DIM)
    v = qkv[:, :, 2].reshape(b, s, N_GROUPS, HEADS_PER_GROUP, HEAD_DIM)
    outs, lses = [], []
    for g, (window, dil) in enumerate(ATTN_GROUPS):
        o, l = dilated_group_attention(q[:, :, g], k[:, :, g], v[:, :, g], dil, window // dil)
        outs.append(o)
        lses.append(l)
    alpha = jax.nn.softmax(jnp.stack(lses, axis=2), axis=2)
    o = jnp.stack(outs, axis=2) * alpha[..., None].astype(h.dtype)
    return o.reshape(b, s, ATTN_WIDTH) @ w_o


def swiglu(h, w_gate, w_up, w_down):
    return (jax.nn.silu(h @ w_gate) * (h @ w_up)) @ w_down


def moe_swiglu(h, w_router, w_gate, w_up, w_down):
    logits = jnp.einsum('bsd,de->bse', h, w_router, preferred_element_type=jnp.float32)
    top_val, top_idx = lax.top_k(logits, TOP_K)
    top_w = jax.nn.softmax(top_val, axis=-1)
    gates = jnp.sum(jax.nn.one_hot(top_idx, N_EXPERTS, dtype=jnp.float32) * top_w[..., None],
                    axis=-2).astype(h.dtype)
    out = jnp.zeros_like(h)
    for e in range(N_EXPERTS):
        out = out + gates[..., e:e + 1] * swiglu(h, w_gate[e], w_up[e], w_down[e])
    return out


def setup_inputs(seed: int = 0) -> dict:
    key = jax.random.key(seed)
    ks = jax.random.split(key, 20)
    D, F, FE, E = D_MODEL, D_FF, D_FF_EXPERT, N_EXPERTS

    def w(k, shape, fan_in, scale=1.0):
        return jax.random.normal(k, shape, jnp.float32) * (scale * fan_in ** -0.5)

    offsets = jax.random.randint(ks[2], (BATCH, 1), 0, 1024, dtype=jnp.int32)
    return {
        "x": jax.random.normal(ks[0], (BATCH, SEQ, D), jnp.float32),
        "c": jax.random.normal(ks[1], (BATCH, D), jnp.float32),
        "positions": offsets + jnp.arange(SEQ, dtype=jnp.int32)[None, :],
        "mod_w": w(ks[3], (DEPTH, 2, D, 3 * D), D, 0.5),
        "mod_b": 0.02 * jax.random.normal(ks[4], (DEPTH, 2, 3 * D), jnp.float32),
        "norm_g": 1.0 + 0.05 * jax.random.normal(ks[5], (DEPTH, 2, D), jnp.float32),
        "conv_w_in": w(ks[6], (N_EVEN, D, 3 * D), D),
        "conv_w": w(ks[7], (N_EVEN, CONV_WIDTH, D), CONV_WIDTH),
        "conv_w_out": w(ks[8], (N_EVEN, D, D), D),
        "ffn_w_gate": w(ks[9], (N_EVEN, D, F), D),
        "ffn_w_up": w(ks[10], (N_EVEN, D, F), D),
        "ffn_w_down": w(ks[11], (N_EVEN, F, D), F),
        "attn_w_qkv": w(ks[12], (N_ODD, D, 3 * ATTN_WIDTH), D),
        "attn_w_o": w(ks[13], (N_ODD, ATTN_WIDTH, D), ATTN_WIDTH),
        "router_w": w(ks[14], (N_ODD, D, E), D),
        "moe_w_gate": w(ks[15], (N_ODD, E, D, FE), D),
        "moe_w_up": w(ks[16], (N_ODD, E, D, FE), D),
        "moe_w_down": w(ks[17], (N_ODD, E, FE, D), FE),
        "final_g": 1.0 + 0.05 * jax.random.normal(ks[18], (D,), jnp.float32),
    }


def reference(x, c, positions, mod_w, mod_b, norm_g, conv_w_in, conv_w, conv_w_out,
              ffn_w_gate, ffn_w_up, ffn_w_down, attn_w_qkv, attn_w_o, router_w,
              moe_w_gate, moe_w_up, moe_w_down, final_g):
    c = c.astype(x.dtype)
    for i in range(DEPTH):
        j = i // N_MIXERS
        if i % N_MIXERS == 0:
            mixer = lambda h, j=j: short_conv_mixer(h, conv_w_in[j], conv_w[j], conv_w_out[j])
            channel = lambda h, j=j: swiglu(h, ffn_w_gate[j], ffn_w_up[j], ffn_w_down[j])
        else:
            mixer = lambda h, j=j: dilated_attention_mixer(h, positions, attn_w_qkv[j], attn_w_o[j])
            channel = lambda h, j=j: moe_swiglu(h, router_w[j], moe_w_gate[j], moe_w_up[j],
                                                moe_w_down[j])
        x = modulated_residual(x, c, norm_g[i, 0], mod_w[i, 0], mod_b[i, 0], mixer)
        x = modulated_residual(x, c, norm_g[i, 1], mod_w[i, 1], mod_b[i, 1], channel)
    return rms_norm(x, final_g)
```

```cpp
#include <hip/hip_runtime.h>
#include <cstdio>
#include <cstdint>

#ifndef DENSE_GU_FP8
#define DENSE_GU_FP8 1
#endif
#ifndef MOE_GU_WGM
#define MOE_GU_WGM 4
#endif
#ifndef MOE_I8
#define MOE_I8 0
#endif
#ifndef GU_I8
#define GU_I8 1
#endif
#ifndef CONVIN_I8
#define CONVIN_I8 0
#endif
#ifndef QKV_I8
#define QKV_I8 1
#endif
#ifndef WO_FP8
#define WO_FP8 1
#endif
#ifndef WOUT_FP8
#define WOUT_FP8 0
#endif
#ifndef DENSE_DOWN_FP8
#define DENSE_DOWN_FP8 1
#endif
#ifndef MK_PER_PHASE
#define MK_PER_PHASE 0
#endif

namespace pg8 {
#define PG8_LAS __attribute__((address_space(3)))
typedef unsigned short bf16_t;
typedef short bf16x8 __attribute__((ext_vector_type(8)));
typedef float f32x4 __attribute__((ext_vector_type(4)));
typedef unsigned u32x4 __attribute__((ext_vector_type(4)));
constexpr int BM = 256, BK = 64, HALF = 128, HTB = HALF * BK * 2, STAGE_BYTES = 8 * HTB, NXCD = 8, WGM = 8;

__host__ __device__ __forceinline__ int lds_byte(int r, int c) { const int st = (r >> 4) * 2 + (c >> 5), rr = r & 15, cc = c & 31, ob = rr * 64 + cc * 2; return st * 1024 + (ob ^ (((ob >> 9) & 1) << 5)); }
__host__ __device__ __forceinline__ void stage_rc(int b, int& R, int& C) { const int st = b / 1024, sb = b % 1024, swz = sb ^ (((sb >> 9) & 1) << 5); R = (st >> 1) * 16 + swz / 64; C = (st & 1) * 32 + (swz % 64) / 2; }
__host__ __device__ __forceinline__ int perm32(int rho) { const int n = rho >> 4, i = rho & 15; return 8 * (i >> 2) + 4 * n + (i & 3); }

struct Unit { int pm, pn, k, nv, g, sp; };
struct Gemm { const bf16_t* A; const bf16_t* Bt; int M, N, K; };

struct StaticOrder {
    static constexpr bool IDROWS = true;
    int nM, nN, nwg, G, c; const int* ident;
    __host__ __device__ void init(int M, int N, int G_, int c_, const int* id = nullptr) { nM = M / BM; nN = N / BM; nwg = nM * nN; G = G_; c = c_; ident = id; }
    __host__ __device__ bool next(int i, Unit& u) const {
        const long L = (long)i * G + c; if (L >= nwg) return false;
        int wgid = (int)L; { const int q = nwg / NXCD, r = nwg % NXCD, xcd = wgid % NXCD, off = wgid / NXCD; wgid = (xcd < r ? xcd * (q + 1) : r * (q + 1) + (xcd - r) * q) + off; }
        const int nig = WGM * nN, gid = wgid / nig, fm = gid * WGM, gsz = (nM - fm) < WGM ? (nM - fm) : WGM;
        u.pm = fm + ((wgid % nig) % gsz); u.pn = (wgid % nig) / gsz; u.nv = 256; return true;
    }
    __device__ __forceinline__ const int* tokens(const Unit& u) const { return ident + 256 * u.pm; }
    __device__ __forceinline__ void a_ready(const Unit&) const {}
    __device__ __forceinline__ void done(const Unit&) const {}
};
struct RepeatOrder : StaticOrder { int nrep;
    __host__ __device__ bool next(int i, Unit& u) const { if (i >= nrep) return false; return StaticOrder::next(0, u); } };
template <bool IDENT> struct MoeOrderT {
    static constexpr bool IDROWS = IDENT;
    int nM, nN, nwg, G, c; int nt[16]; const int* rowtok; bool ident;
    static constexpr int MTOK = 32768;
    __device__ __forceinline__ void init(unsigned* cnt, int nN_, int G_, int c_, const int* rt, bool ident_ = false) {
        ident = ident_;
        int b = 0;
#pragma unroll
        for (int q = 0; q < 16; ++q) { const int ne = __builtin_amdgcn_readfirstlane((int)__hip_atomic_load(cnt + q, __ATOMIC_RELAXED, __HIP_MEMORY_SCOPE_AGENT)); nt[q] = ne | (b << 16); b += (ne + 255) >> 8; }
        nM = b; nN = nN_; nwg = nM * nN; G = G_; c = c_; rowtok = rt;
    }
    __device__ __forceinline__ bool next(int i, Unit& u) const {
        const long L = (long)i * G + c; if (L >= nwg) return false;
        int wgid = (int)L; { const int q = nwg / NXCD, r = nwg % NXCD, xcd = wgid % NXCD, off = wgid / NXCD; wgid = (xcd < r ? xcd * (q + 1) : r * (q + 1) + (xcd - r) * q) + off; }
        constexpr int WG_ = IDENT ? WGM : MOE_GU_WGM;
        const int nig = WG_ * nN, gid = wgid / nig, fm = gid * WG_, gsz = (nM - fm) < WG_ ? (nM - fm) : WG_;
        const int pm = fm + ((wgid % nig) % gsz), pn = (wgid % nig) / gsz;
        int q0 = 0, sel = nt[0];
#pragma unroll
        for (int q = 1; q < 16; ++q) if (pm >= (nt[q] >> 16)) { q0 = q; sel = nt[q]; }
        u.pm = pm; u.pn = (q0 & 7) * nN + pn; u.g = q0; u.k = pm - (sel >> 16); const int rem = (sel & 0xffff) - 256 * u.k; u.nv = rem < 256 ? rem : 256; return true;
    }
    __device__ __forceinline__ const int* tokens(const Unit& u) const { return ident ? rowtok + 256 * u.pm : rowtok + (size_t)u.g * MTOK + 256 * u.k; }
    __device__ __forceinline__ void a_ready(const Unit&) const {}
    __device__ __forceinline__ void done(const Unit&) const {}
};
typedef MoeOrderT<false> MoeOrder; typedef MoeOrderT<true> MoeOrderId;

typedef int v8i_t __attribute__((ext_vector_type(8)));
typedef int v4i_t __attribute__((ext_vector_type(4)));
__device__ __forceinline__ v8i_t cat8(bf16x8 a, bf16x8 b) { const v4i_t x = __builtin_bit_cast(v4i_t, a), y = __builtin_bit_cast(v4i_t, b); return __builtin_shufflevector(x, y, 0, 1, 2, 3, 4, 5, 6, 7); }
__device__ __forceinline__ unsigned cvt_pk_bf16(float lo, float hi) { unsigned r; asm volatile("v_cvt_pk_bf16_f32 %0, %1, %2" : "=v"(r) : "v"(lo), "v"(hi)); return r; }

template <class Epi, class Sched, bool ALIGN_EPI = false, bool SP2 = false, bool GATHER = false, int ES = 2, bool I8 = false>
__device__ __forceinline__ void gemm_phase(PG8_LAS unsigned char* lds, const Gemm g, const Sched& S, const Epi& E, PG8_LAS unsigned char* tokslots = nullptr) {
    const int tid = threadIdx.x, wid = __builtin_amdgcn_readfirstlane(tid >> 6), lane = tid & 63, wr = wid >> 2, wc = wid & 3, fr = lane & 15, fq = lane >> 4;
    const int K = g.K, KB = K * ES  , nt = KB / (BK * 2);
    static_assert(!GATHER || SP2, "the gathering A path is written for the SP2 loop only");
    unsigned voffA[2], voffB[2];
#pragma unroll
    for (int i = 0; i < 2; ++i) { int R, C; stage_rc(tid * 16 + i * 8192, R, C); const int Rb = Epi::PERM ? ((R & ~31) + perm32(R & 31)) : R;
        voffA[i] = (unsigned)(R * KB + C * 2); voffB[i] = (unsigned)(Rb * KB + C * 2); }
    unsigned gcur[2][2] = {{0u, 0u}, {0u, 0u}};
    const size_t kstep = (size_t)(BK * 2);
    const size_t hstep = (size_t)HALF * KB;
    const size_t tstep = 2 * hstep;
    const unsigned ldsw = (unsigned)wid * 1024u;
    const int aoff = lds_byte(wr * 64 + fr, fq * 8), boff = lds_byte(wc * 32 + fr, fq * 8);
#define PG8_SA(b, h) (((b) * 2 + (h)) * HTB)
#define PG8_SB(b, h) ((4 + (b) * 2 + (h)) * HTB)
#define PG8_STAGE(bufoff, gbase, voff) do { _Pragma("unroll") for (int _i = 0; _i < 2; ++_i) \
        __builtin_amdgcn_global_load_lds((const unsigned*)((const char*)(gbase) + (voff)[_i]), (PG8_LAS unsigned*)(lds + (bufoff) + ldsw + _i * 8192), 16, 0, 0); } while (0)
#define PG8_STAGE_A(bufoff, kptr, half, ofs) do { if constexpr (GATHER) { _Pragma("unroll") for (int _i = 0; _i < 2; ++_i) \
        __builtin_amdgcn_global_load_lds((const unsigned*)((const char*)(kptr) + (ofs)[half][_i]), (PG8_LAS unsigned*)(lds + (bufoff) + ldsw + _i * 8192), 16, 0, 0); } \
        else { PG8_STAGE(bufoff, (const char*)(kptr) + (half) * hstep, voffA); } } while (0)
#define PG8_LDA(dst, b, h) do { _Pragma("unroll") for (int m = 0; m < 4; ++m) _Pragma("unroll") for (int k = 0; k < 2; ++k) dst[m][k] = *(const PG8_LAS bf16x8*)(lds + PG8_SA(b, h) + aoff + m * 2048 + k * 1024); } while (0)
#define PG8_LDB(dst, b, h) do { _Pragma("unroll") for (int n = 0; n < 2; ++n) _Pragma("unroll") for (int k = 0; k < 2; ++k) dst[n][k] = *(const PG8_LAS bf16x8*)(lds + PG8_SB(b, h) + boff + n * 2048 + k * 1024); } while (0)
#define PG8_MMA(ai, bj, At, Bt) do { __builtin_amdgcn_s_setprio(1); _Pragma("unroll") for (int m = 0; m < 4; ++m) _Pragma("unroll") for (int n = 0; n < 2; ++n) { \
        if constexpr (ES == 2) { _Pragma("unroll") for (int k = 0; k < 2; ++k) acc[ai][bj][m][n] = __builtin_amdgcn_mfma_f32_16x16x32_bf16(Bt[n][k], At[m][k], acc[ai][bj][m][n], 0, 0, 0); } \
        else if constexpr (I8) { _Pragma("unroll") for (int k = 0; k < 2; ++k) acc[ai][bj][m][n] = __builtin_bit_cast(f32x4, __builtin_amdgcn_mfma_i32_16x16x64_i8(__builtin_bit_cast(v4i_t, Bt[n][k]), __builtin_bit_cast(v4i_t, At[m][k]), __builtin_bit_cast(v4i_t, acc[ai][bj][m][n]), 0, 0, 0)); } \
        else { acc[ai][bj][m][n] = __builtin_amdgcn_mfma_scale_f32_16x16x128_f8f6f4(cat8(Bt[n][0], Bt[n][1]), cat8(At[m][0], At[m][1]), acc[ai][bj][m][n], 0, 0, 0, 0x7f7f7f7f, 0, 0x7f7f7f7f); } } \
        __builtin_amdgcn_s_setprio(0); } while (0)
#define PG8_WAIT_V(n) asm volatile("s_waitcnt vmcnt(" #n ")" ::: "memory")
#define PG8_WAIT_L(n) asm volatile("s_waitcnt lgkmcnt(" #n ")" ::: "memory")
#define PG8_BAR __builtin_amdgcn_s_barrier()
#define PG8_SCHED __builtin_amdgcn_sched_barrier(0)
    Unit cur, nxt; int ui = 0;
    if (!S.next(0, cur)) return;
    f32x4 acc[2][2][4][2];
#pragma unroll
    for (int a = 0; a < 2; ++a)
#pragma unroll
        for (int b = 0; b < 2; ++b)
#pragma unroll
            for (int m = 0; m < 4; ++m)
#pragma unroll
                for (int n = 0; n < 2; ++n) acc[a][b][m][n] = (f32x4){0.f, 0.f, 0.f, 0.f};
    bf16x8 At[4][2], B0[2][2], B1[2][2];
    const char* cA = GATHER ? (const char*)g.A : (const char*)g.A + (size_t)cur.pm * tstep; const char* cB = (const char*)g.Bt + (size_t)cur.pn * tstep;
    if constexpr (GATHER) { const int* tk = S.tokens(cur);
#pragma unroll
        for (int h = 0; h < 2; ++h)
#pragma unroll
            for (int i = 0; i < 2; ++i) { int R, C; stage_rc(tid * 16 + i * 8192, R, C); const int rl = h * HALF + R; int tok;
                if constexpr (Sched::IDROWS) tok = rl < cur.nv ? 256 * cur.pm + rl : 0; else tok = rl < cur.nv ? tk[rl] : 0;
                gcur[h][i] = (unsigned)tok * (unsigned)KB + (unsigned)C * 2u; } }
    S.a_ready(cur);
    if constexpr (SP2) {
        PG8_STAGE(PG8_SB(0, 0), cB, voffB); PG8_STAGE(PG8_SB(0, 1), cB + hstep, voffB); PG8_STAGE_A(PG8_SA(0, 0), cA, 0, gcur); PG8_STAGE_A(PG8_SA(0, 1), cA, 1, gcur);
        PG8_STAGE(PG8_SB(1, 0), cB + kstep, voffB); PG8_STAGE_A(PG8_SA(1, 0), cA + kstep, 0, gcur); PG8_STAGE(PG8_SB(1, 1), cB + hstep + kstep, voffB);
        if (wr == 1) PG8_BAR;
        PG8_WAIT_V(8); PG8_BAR;
        PG8_WAIT_V(6); PG8_BAR;
    } else {
        PG8_STAGE(PG8_SB(0, 0), cB, voffB); PG8_STAGE_A(PG8_SA(0, 0), cA, 0, gcur); PG8_STAGE(PG8_SB(0, 1), cB + hstep, voffB); PG8_STAGE_A(PG8_SA(0, 1), cA, 1, gcur);
        if (wr == 1) PG8_BAR;
        PG8_WAIT_V(4); PG8_BAR;
        PG8_STAGE(PG8_SB(1, 0), cB + kstep, voffB); PG8_STAGE_A(PG8_SA(1, 0), cA + kstep, 0, gcur); PG8_STAGE(PG8_SB(1, 1), cB + hstep + kstep, voffB);
        PG8_WAIT_V(6); PG8_BAR;
    }
    for (;;) {
        cur.sp = ui & 1;
        if constexpr (Epi::SIDE) E.side_issue(cur, wid, lane);
        const bool has_next = S.next(ui + 1, nxt);
        const char* nA = GATHER ? cA : (has_next ? (const char*)g.A + (size_t)nxt.pm * tstep : cA); const char* nB = has_next ? (const char*)g.Bt + (size_t)nxt.pn * tstep : cB;
        if constexpr (GATHER && !Sched::IDROWS) { if (has_next && wid < 4)
            __builtin_amdgcn_global_load_lds((const unsigned*)(S.tokens(nxt) + wid * 64 + lane), (PG8_LAS unsigned*)(tokslots + ((ui + 1) & 1) * 1024 + wid * 256), 4, 0, 0); }
#pragma unroll 1
        for (int t = 0; t < nt; t += 2) {
            const bool last = (t == nt - 2);
            const char* a1 = cA + (size_t)(t + 1) * kstep;
            const char* a2 = last ? nA : cA + (size_t)(t + 2) * kstep; const char* b2 = last ? nB : cB + (size_t)(t + 2) * kstep;
            const char* a3 = a2 + kstep; const char* b3 = b2 + kstep;
            if (last && has_next) S.a_ready(nxt);
            if constexpr (SP2) {
            PG8_LDB(B0, 0, 0); PG8_LDB(B1, 0, 1); PG8_SCHED; PG8_LDA(At, 0, 0); PG8_STAGE_A(PG8_SA(1, 1), a1, 1, gcur);
            if constexpr (GATHER) { if (last && has_next) {
#pragma unroll
                for (int h = 0; h < 2; ++h)
#pragma unroll
                    for (int i = 0; i < 2; ++i) { int R, C; stage_rc(tid * 16 + i * 8192, R, C); const int rl = h * HALF + R; int tok; if constexpr (Sched::IDROWS) tok = 256 * nxt.pm + rl; else tok = *(const PG8_LAS int*)(tokslots + ((ui + 1) & 1) * 1024 + rl * 4);
                        gcur[h][i] = (unsigned)(rl < nxt.nv ? tok : 0) * (unsigned)KB + (unsigned)C * 2u; } } }
            PG8_WAIT_V(8); PG8_WAIT_L(0); PG8_BAR; PG8_MMA(0, 0, At, B0); PG8_MMA(0, 1, At, B1); PG8_BAR; PG8_SCHED;
            PG8_LDA(At, 0, 1); PG8_STAGE(PG8_SB(0, 0), b2, voffB); PG8_STAGE(PG8_SB(0, 1), b2 + hstep, voffB); PG8_STAGE_A(PG8_SA(0, 0), a2, 0, gcur);
            PG8_WAIT_V(8); PG8_WAIT_L(0); PG8_BAR; PG8_MMA(1, 0, At, B0); PG8_MMA(1, 1, At, B1); PG8_BAR; PG8_SCHED;
            PG8_LDB(B0, 1, 0); PG8_LDB(B1, 1, 1); PG8_SCHED; PG8_LDA(At, 1, 0); PG8_STAGE_A(PG8_SA(0, 1), a2, 1, gcur);
            PG8_WAIT_V(8); PG8_WAIT_L(0); PG8_BAR; PG8_MMA(0, 0, At, B0); PG8_MMA(0, 1, At, B1); PG8_BAR; PG8_SCHED;
            PG8_LDA(At, 1, 1); PG8_STAGE(PG8_SB(1, 0), b3, voffB); PG8_STAGE(PG8_SB(1, 1), b3 + hstep, voffB); PG8_STAGE_A(PG8_SA(1, 0), a3, 0, gcur);
            PG8_WAIT_V(8); PG8_WAIT_L(0); PG8_BAR; PG8_MMA(1, 0, At, B0); PG8_MMA(1, 1, At, B1); PG8_BAR; PG8_SCHED;
            } else {
            PG8_LDB(B0, 0, 0); PG8_SCHED; PG8_LDA(At, 0, 0); PG8_STAGE_A(PG8_SA(1, 1), a1, 1, gcur);
            PG8_WAIT_L(8); PG8_BAR; PG8_WAIT_L(0); PG8_MMA(0, 0, At, B0); PG8_BAR; PG8_SCHED;
            PG8_LDB(B1, 0, 1); PG8_STAGE(PG8_SB(0, 0), b2, voffB);
            PG8_BAR; PG8_WAIT_L(0); PG8_MMA(0, 1, At, B1); PG8_BAR;
            PG8_LDA(At, 0, 1); PG8_STAGE_A(PG8_SA(0, 0), a2, 0, gcur);
            PG8_BAR; PG8_WAIT_L(0); PG8_MMA(1, 0, At, B0); PG8_BAR; PG8_SCHED;
            PG8_STAGE(PG8_SB(0, 1), b2 + hstep, voffB);
            PG8_WAIT_V(6); PG8_BAR; PG8_MMA(1, 1, At, B1); PG8_BAR;
            PG8_LDB(B0, 1, 0); PG8_SCHED; PG8_LDA(At, 1, 0); PG8_STAGE_A(PG8_SA(0, 1), a2, 1, gcur);
            PG8_WAIT_L(8); PG8_BAR; PG8_WAIT_L(0); PG8_MMA(0, 0, At, B0); PG8_BAR; PG8_SCHED;
            PG8_LDB(B1, 1, 1); PG8_STAGE(PG8_SB(1, 0), b3, voffB);
            PG8_BAR; PG8_WAIT_L(0); PG8_MMA(0, 1, At, B1); PG8_BAR;
            PG8_LDA(At, 1, 1); PG8_STAGE_A(PG8_SA(1, 0), a3, 0, gcur);
            PG8_BAR; PG8_WAIT_L(0); PG8_MMA(1, 0, At, B0); PG8_BAR; PG8_SCHED;
            PG8_STAGE(PG8_SB(1, 1), b3 + hstep, voffB);
            PG8_WAIT_V(6); PG8_BAR; PG8_MMA(1, 1, At, B1); PG8_BAR;
            }
        }
        if constexpr (ALIGN_EPI) { if (wr == 0) PG8_BAR; }
        E(acc, cur, wr, wc, fr, fq); S.done(cur);
        if (!has_next) break;
#pragma unroll
        for (int a = 0; a < 2; ++a)
#pragma unroll
            for (int b = 0; b < 2; ++b)
#pragma unroll
                for (int m = 0; m < 4; ++m)
#pragma unroll
                    for (int n = 0; n < 2; ++n) acc[a][b][m][n] = (f32x4){0.f, 0.f, 0.f, 0.f};
        cur = nxt; cA = nA; cB = nB; ++ui;

        if constexpr (ALIGN_EPI) { if (wr == 1) PG8_BAR; }
    }
    PG8_WAIT_V(0);
    if constexpr (!ALIGN_EPI) { if (wr == 0) PG8_BAR; }
    PG8_BAR;
#undef PG8_SA
#undef PG8_SB
#undef PG8_STAGE
#undef PG8_STAGE_A
#undef PG8_LDA
#undef PG8_LDB
#undef PG8_MMA
#undef PG8_WAIT_V
#undef PG8_WAIT_L
#undef PG8_BAR
#undef PG8_SCHED
}
}

constexpr int NWAVES = 8, NTHR = NWAVES * 64;
constexpr int NB = 4, SEQ = 8192, D = 1024, M = NB * SEQ;
constexpr int FF = 2816, NE = 8;
constexpr int NH = 15, NHQKV = 45, QKVP = 3072;
constexpr int RPAD = M + NE * 256;
constexpr int NCHUNK = M / 128;
constexpr float RMS_EPS = 1e-6f;
constexpr float I8_SA = 127.f / 8.f, I8_SW = 127.f * 32.f / 5.f;
constexpr float GU_SA = GU_I8 ? I8_SA : 16.f, GU_SW = GU_I8 ? I8_SW : 128.f;
constexpr float MOE_SA = MOE_I8 ? I8_SA : 16.f, MOE_SW = MOE_I8 ? I8_SW : 128.f;
constexpr float F8_SO = 32.f;
constexpr float F8_SA = 16.f, F8_SW = 128.f, F8_SH = 8.f;
constexpr float C2 = 0.125f * 1.4426950408889634f;

constexpr size_t MiB = 1u << 20;
constexpr size_t WS_CTL = 0, CTL_ZERO_BYTES = 64 * 1024;
constexpr size_t WS_MODP = 1 * MiB;
constexpr size_t WS_MODF = 3 * MiB;
constexpr size_t WS_IDENT = 4 * MiB + 512 * 1024;
constexpr size_t WS_ZG = WS_MODF + 256 * 1024;
constexpr size_t WS_SS = 4 * MiB;
constexpr size_t WS_BIASV = 5 * MiB;
constexpr size_t WS_XR = 448 * MiB;
constexpr size_t WS_ROPE = 6 * MiB;
constexpr size_t WS_LSE = 14 * MiB;
constexpr size_t WS_WCIN = 16 * MiB, WS_WCOUT = 22 * MiB, WS_WFGU = 24 * MiB, WS_WFD = 35 * MiB, WS_WQKV = 41 * MiB, WS_WO = 47 * MiB, WS_WMGU = 49 * MiB, WS_WMD = 137 * MiB;
constexpr size_t WS_H = 181 * MiB;
constexpr size_t WS_BIG = 245 * MiB;
constexpr size_t WS_BG = WS_BIG, WS_V = WS_BIG + 64 * MiB;
constexpr size_t WS_HID = WS_BIG;
constexpr size_t WS_QKV = WS_BIG;
constexpr size_t WS_RT2 = 10 * MiB, WS_RW2 = 12 * MiB;
constexpr size_t WS_MHID = WS_BIG;
constexpr size_t WS_Y1 = WS_H;
constexpr size_t WS_END = 512 * MiB;
static_assert(WS_MHID + (size_t)2 * RPAD * FF <= WS_XR && WS_QKV + (size_t)M * QKVP * 2 <= WS_XR && WS_HID + (size_t)M * FF * 2 <= WS_XR && WS_XR + (size_t)M * D * 2 <= WS_END, "d_ws map");
static_assert(WS_WMD + (size_t)NE * D * FF * 2 <= WS_H && WS_H + (size_t)M * D * 2 <= WS_BIG, "d_ws map 2");
constexpr int CW_CNT = 8192;
constexpr int CW_BAR = 4096;

constexpr int RING_BYTES = 131072;
constexpr int LDSCTL_OFF = RING_BYTES, MISC_OFF = LDSCTL_OFF + 320;
constexpr int RED_OFF = LDSCTL_OFF + 4096;
constexpr int TOKSLOT_OFF = LDSCTL_OFF + 1024;
constexpr int GATE_OFF = LDSCTL_OFF + 8192;
constexpr int LDS_BYTES = 155648;

#define GAS __attribute__((address_space(1)))
#define LAS __attribute__((address_space(3)))
typedef unsigned short bf16;
typedef unsigned v4u __attribute__((ext_vector_type(4)));
typedef unsigned v2u __attribute__((ext_vector_type(2)));
typedef float f32x4 __attribute__((ext_vector_type(4)));
#define LDS_WAIT() asm volatile("s_waitcnt lgkmcnt(0)" ::: "memory")
__device__ __forceinline__ unsigned f2bf(float f) { unsigned u = __builtin_bit_cast(unsigned, f); return (u + 0x7fffu + ((u >> 16) & 1u)) >> 16; }
__device__ __forceinline__ unsigned pk2(float lo, float hi) { return f2bf(lo) | (f2bf(hi) << 16); }
__device__ __forceinline__ float bflo(unsigned u) { return __builtin_bit_cast(float, u << 16); }
__device__ __forceinline__ float bfhi(unsigned u) { return __builtin_bit_cast(float, u & 0xffff0000u); }

__device__ __forceinline__ unsigned pk_fp8x4(f32x4 v) {
    const float a = __builtin_amdgcn_fmed3f(v.x, -448.f, 448.f), b = __builtin_amdgcn_fmed3f(v.y, -448.f, 448.f), c = __builtin_amdgcn_fmed3f(v.z, -448.f, 448.f), d = __builtin_amdgcn_fmed3f(v.w, -448.f, 448.f);
    int p = __builtin_amdgcn_cvt_pk_fp8_f32(a, b, 0, false); p = __builtin_amdgcn_cvt_pk_fp8_f32(c, d, p, true); return (unsigned)p; }
__device__ __forceinline__ unsigned pk_i8x4(f32x4 v) {
    const float mg = 12582912.0f;
    const unsigned a = __builtin_bit_cast(unsigned, __builtin_amdgcn_fmed3f(v.x, -127.f, 127.f) + mg), b = __builtin_bit_cast(unsigned, __builtin_amdgcn_fmed3f(v.y, -127.f, 127.f) + mg);
    const unsigned c = __builtin_bit_cast(unsigned, __builtin_amdgcn_fmed3f(v.z, -127.f, 127.f) + mg), d = __builtin_bit_cast(unsigned, __builtin_amdgcn_fmed3f(v.w, -127.f, 127.f) + mg);
    return __builtin_amdgcn_perm(__builtin_amdgcn_perm(d, c, 0x0c0c0400u), __builtin_amdgcn_perm(b, a, 0x0c0c0400u), 0x05040100u); }
__device__ __forceinline__ unsigned pk_q8x4(f32x4 v) { return GU_I8 ? pk_i8x4(v) : pk_fp8x4(v); }
#define XB_TMO      128
#define XB_XCNT(j)  (256  + 64 * (j))
#define XB_XSUB(j)  (1280 + 64 * (j))
#define XB_XGEN(j)  (2304 + 64 * (j))
#define XB_TOP      3328
#define XB_TOPGEN   3392
#define XCD_BAR_WORDS 3456
#define XB_SPIN_CAP (1u << 18)
__device__ __forceinline__ unsigned xb_ld(unsigned* p)              { return __hip_atomic_load(p, __ATOMIC_RELAXED, __HIP_MEMORY_SCOPE_AGENT); }
__device__ __forceinline__ unsigned xb_add(unsigned* p, unsigned v) { return __hip_atomic_fetch_add(p, v, __ATOMIC_RELAXED, __HIP_MEMORY_SCOPE_AGENT); }
__device__ __forceinline__ unsigned xb_xcc_id() { return (unsigned)__builtin_amdgcn_s_getreg((3 << 11) | 20) & 0xFu; }
#define XB_SPIN(cond, bar) do { unsigned _sp = 0; while (cond) { __builtin_amdgcn_s_sleep(1); \
    if ((++_sp & 255u) == 0u) { if (xb_ld(&(bar)[XB_TMO])) break; if (_sp > XB_SPIN_CAP) { atomicAdd(&(bar)[XB_TMO], 1u); break; } } } } while (0)
struct XcdBarrier { unsigned* bar; unsigned x; volatile LAS unsigned* st; };
__device__ __forceinline__ XcdBarrier xcd_barrier_post(unsigned* bar, volatile LAS unsigned* st) {
    XcdBarrier b; b.bar = bar; b.x = xb_xcc_id(); b.st = st;
    if (threadIdx.x == 0) (void)xb_add(&bar[XB_XCNT(b.x)], 1u);
    return b;
}
__device__ __forceinline__ void xcd_barrier_complete(unsigned* bar, unsigned x, unsigned& nloc, unsigned& nx) {
    const unsigned G = gridDim.x * gridDim.y * gridDim.z;
    unsigned sum, cnt, mine, sp = 0u;
    for (;;) {
        sum = 0u; cnt = 0u; mine = 0u;
#pragma unroll
        for (unsigned j = 0; j < 16; ++j) { const unsigned c = xb_ld(&bar[XB_XCNT(j)]); sum += c; cnt += (c > 0u) ? 1u : 0u; mine = (j == x) ? c : mine; }
        if (sum == G) break;
        __builtin_amdgcn_s_sleep(1);
        if ((++sp & 255u) == 0u) { if (xb_ld(&bar[XB_TMO])) break; if (sp > XB_SPIN_CAP) { atomicAdd(&bar[XB_TMO], 1u); break; } }
    }
    nloc = mine > 0u ? mine : 1u; nx = cnt > 0u ? cnt : 1u;
}
__device__ __forceinline__ void xcd_barrier(const XcdBarrier& b) {
    asm volatile("s_waitcnt vmcnt(0)" ::: "memory");
    __syncthreads();
    if (threadIdx.x == 0) {
        unsigned* bar = b.bar;
        __builtin_amdgcn_s_waitcnt(0);
        unsigned nloc = b.st[0], nx = b.st[1];
        if (nloc == 0u) { xcd_barrier_complete(bar, b.x, nloc, nx); b.st[0] = nloc; b.st[1] = nx; }
        const unsigned old = xb_add(&bar[XB_XSUB(b.x)], 1u);
        const unsigned gen = old / nloc;
        if (old + 1u == (gen + 1u) * nloc) {
            __builtin_amdgcn_fence(__ATOMIC_RELEASE, "agent");
            asm volatile("s_waitcnt vmcnt(0)" ::: "memory");
            const unsigned og = xb_add(&bar[XB_TOP], 1u);
            const unsigned tg = og / nx;
            if (og + 1u == (tg + 1u) * nx) xb_add(&bar[XB_TOPGEN], 1u);
            else XB_SPIN(xb_ld(&bar[XB_TOPGEN]) == tg, bar);
            __builtin_amdgcn_fence(__ATOMIC_ACQUIRE, "agent");
            xb_add(&bar[XB_XGEN(b.x)], 1u);
            asm volatile("s_waitcnt vmcnt(0)" ::: "memory");
        } else {
            XB_SPIN(xb_ld(&bar[XB_XGEN(b.x)]) == gen, bar);
            __builtin_amdgcn_fence(__ATOMIC_ACQUIRE, "agent");
            asm volatile("s_waitcnt vmcnt(0)" ::: "memory");
        }
    }
    __syncthreads();
}

__device__ __forceinline__ float wave_sum(float v) {
#pragma unroll
    for (int o = 1; o < 64; o <<= 1) v += __shfl_xor(v, o);
    return v;
}
__device__ __forceinline__ float wave_max(float v) {
#pragma unroll
    for (int o = 1; o < 64; o <<= 1) v = fmaxf(v, __shfl_xor(v, o));
    return v;
}
__device__ __forceinline__ float silu_f(float v) { return v * __builtin_amdgcn_rcpf(1.0f + __builtin_amdgcn_exp2f(-1.4426950408889634f * v)); }

struct Args {
    const float* x; const float* c; const int* pos; const float* mod_w; const float* mod_b; const float* norm_g;
    const float* conv_w_in; const float* conv_w; const float* conv_w_out; const float* ffn_g; const float* ffn_u; const float* ffn_d;
    const float* w_qkv; const float* w_o; const float* router_w; const float* moe_g; const float* moe_u; const float* moe_d; const float* final_g;
    float* out; unsigned char* ws; int ph_lo, ph_hi;
};

using pg8::Unit; using pg8::HALF; using pg8::BM;
#define PINV(x) asm volatile("" : "+v"(x))
#define ROWSTEP(k) (((k) == 3) ? 80u : 16u)
#ifndef STORE_AUX
#define STORE_AUX 0
#endif
__device__ __forceinline__ __amdgpu_buffer_rsrc_t mk_rsrc(const void* base) { return __builtin_amdgcn_make_buffer_rsrc(const_cast<void*>(base), 0, 0x7fffffff, 0x00020000); }
__device__ __forceinline__ void st16(__amdgpu_buffer_rsrc_t r, unsigned off, v4u v) { __builtin_amdgcn_raw_buffer_store_b128(v, r, (int)off, 0, STORE_AUX); }
__device__ __forceinline__ void st8(__amdgpu_buffer_rsrc_t r, unsigned off, v2u v) { __builtin_amdgcn_raw_buffer_store_b64(v, r, (int)off, 0, STORE_AUX); }
__device__ __forceinline__ void st16f(__amdgpu_buffer_rsrc_t r, unsigned off, f32x4 v) { __builtin_amdgcn_raw_buffer_store_b128(__builtin_bit_cast(v4u, v), r, (int)off, 0, STORE_AUX); }
template <class T> __device__ __forceinline__ T* at_off(T* base, unsigned byteoff) { return (T*)((char*)base + byteoff); }
template <class T> __device__ __forceinline__ const T* at_off(const T* base, unsigned byteoff) { return (const T*)((const char*)base + byteoff); }
__device__ __forceinline__ v4u pack8(const f32x4 a, const f32x4 b) { v4u w; w.x = pg8::cvt_pk_bf16(a[0], a[1]); w.y = pg8::cvt_pk_bf16(a[2], a[3]); w.z = pg8::cvt_pk_bf16(b[0], b[1]); w.w = pg8::cvt_pk_bf16(b[2], b[3]); return w; }
typedef int i32x4 __attribute__((ext_vector_type(4)));
__device__ __forceinline__ f32x4 acc_f32(const f32x4 a, bool i8) { return i8 ? __builtin_convertvector(__builtin_bit_cast(i32x4, a), f32x4) : a; }
template <bool I8> struct EpiConvInT {
    static constexpr bool PERM = true, SIDE = false;
    bf16* V; bf16* Bg;
    __device__ __forceinline__ void operator()(const f32x4 (&acc)[2][2][4][2], const Unit& u, int wr, int wc, int fr, int fq) const {
        PINV(fr); PINV(fq);
        const int row0 = u.pm * BM + wr * 64 + fr; const __amdgpu_buffer_rsrc_t rV = mk_rsrc(V), rB = mk_rsrc(Bg);
        constexpr float ci = I8 ? 1.0f / (GU_SA * GU_SW) : 1.0f;
        if (u.pn < 8) {
            unsigned ro = (unsigned)(row0 * D + u.pn * 128 + wc * 32 + 8 * fq) * 2u;
#pragma unroll
            for (int k = 0; k < 8; ++k) { const int ai = k >> 2, m = k & 3;
                st16(rV, ro, pack8(acc_f32(acc[ai][0][m][0], I8) * acc_f32(acc[ai][1][m][0], I8) * (ci * ci), acc_f32(acc[ai][0][m][1], I8) * acc_f32(acc[ai][1][m][1], I8) * (ci * ci)));
                ro += ROWSTEP(k) * (unsigned)(D * 2); PINV(ro); }
        } else {
            unsigned ro = (unsigned)(row0 * D + (u.pn - 8) * 256 + wc * 32 + 8 * fq) * 2u;
#pragma unroll
            for (int k = 0; k < 8; ++k) { const int ai = k >> 2, m = k & 3;
                st16(rB, ro, pack8(acc_f32(acc[ai][0][m][0], I8) * ci, acc_f32(acc[ai][0][m][1], I8) * ci));
                st16(rB, ro + HALF * 2, pack8(acc_f32(acc[ai][1][m][0], I8) * ci, acc_f32(acc[ai][1][m][1], I8) * ci));
                ro += ROWSTEP(k) * (unsigned)(D * 2); PINV(ro); }
        }
    }
};
typedef EpiConvInT<false> EpiConvIn;
typedef float f32x2 __attribute__((ext_vector_type(2)));
__device__ __forceinline__ f32x2 swiglu2(f32x2 g, f32x2 u, float cg, float cgu) {
    const f32x2 t = g * (-1.4426950408889634f * cg);
    f32x2 e; e.x = __builtin_amdgcn_exp2f(t.x); e.y = __builtin_amdgcn_exp2f(t.y);
    const float k = 1.0f / cgu;
    const f32x2 d = e * k + k;
    f32x2 r; r.x = __builtin_amdgcn_rcpf(d.x); r.y = __builtin_amdgcn_rcpf(d.y);
    return (g * u) * r;
}
__device__ __forceinline__ f32x4 swiglu4(f32x4 g, f32x4 u, float cg, float cgu) {
    const f32x2 a = swiglu2((f32x2){g.x, g.y}, (f32x2){u.x, u.y}, cg, cgu), b = swiglu2((f32x2){g.z, g.w}, (f32x2){u.z, u.w}, cg, cgu); return (f32x4){a.x, a.y, b.x, b.y}; }
__device__ __forceinline__ float rinv_of(const f32x4 s) { return __builtin_amdgcn_rsqf(((s.x + s.y) + (s.z + s.w)) * (1.0f / D) + RMS_EPS); }
constexpr int SIDE_BYTES = 5120;
template <bool NORM, bool F8 = false, bool F8O = F8> struct EpiSwiGLU {
    static constexpr bool PERM = true, SIDE = NORM;
    bf16* Hd; int nN; const float* SS; const float* bias; LAS unsigned char* side;
    __device__ __forceinline__ void side_issue(const Unit& u, int wid, int lane) const {
        LAS unsigned char* sl = side + u.sp * SIDE_BYTES;
        if (wid < 4) __builtin_amdgcn_global_load_lds((const unsigned*)(SS + ((size_t)(u.pm * BM + wid * 64 + lane)) * 4), (LAS unsigned*)(sl + wid * 1024), 16, 0, 0);
        else if (wid == 4) __builtin_amdgcn_global_load_lds((const unsigned*)(bias + (size_t)((u.pm * BM) / SEQ) * (2 * FF) + u.pn * BM + lane * 4), (LAS unsigned*)(sl + 4096), 16, 0, 0);
    }
    __device__ __forceinline__ void operator()(const f32x4 (&acc)[2][2][4][2], const Unit& u, int wr, int wc, int fr, int fq) const {
        PINV(fr); PINV(fq);
        const int row0 = u.pm * BM + wr * 64 + fr, pnl = u.pn % nN;
        f32x4 (&a)[2][2][4][2] = const_cast<f32x4 (&)[2][2][4][2]>(acc);
        if (NORM) {
            const LAS unsigned char* sl = side + u.sp * SIDE_BYTES;
            f32x4 bv[2][2];
#pragma unroll
            for (int bj = 0; bj < 2; ++bj)
#pragma unroll
                for (int n = 0; n < 2; ++n) bv[bj][n] = *(const LAS f32x4*)(sl + 4096 + (bj * HALF + wc * 32 + 8 * fq + 4 * n) * 4);
#pragma unroll
            for (int k = 0; k < 8; ++k) { const float r = rinv_of(*(const LAS f32x4*)(sl + ((k >> 2) * HALF + wr * 64 + (k & 3) * 16 + fr) * 16)) * (F8 ? 1.0f / (GU_SA * GU_SW) : 1.0f);
#pragma unroll
                for (int bj = 0; bj < 2; ++bj)
#pragma unroll
                    for (int n = 0; n < 2; ++n) a[k >> 2][bj][k & 3][n] = acc_f32(a[k >> 2][bj][k & 3][n], F8 && GU_I8) * r + bv[bj][n]; }
        }
        unsigned ro = (unsigned)(row0 * FF + pnl * 128 + wc * 32 + 8 * fq) * (F8O ? 1u : 2u); const __amdgpu_buffer_rsrc_t rH = mk_rsrc(Hd);
#pragma unroll
        for (int k = 0; k < 8; ++k) { const int ai = k >> 2, m = k & 3;
            const f32x4 g0 = a[ai][0][m][0], g1 = a[ai][0][m][1], u0 = a[ai][1][m][0], u1 = a[ai][1][m][1];
            const f32x4 v0 = swiglu4(g0, u0, 1.0f, F8O ? F8_SH : 1.0f), v1 = swiglu4(g1, u1, 1.0f, F8O ? F8_SH : 1.0f);
            if (F8O) { v2u w8; w8.x = pk_fp8x4(v0); w8.y = pk_fp8x4(v1); st8(rH, ro, w8); } else st16(rH, ro, pack8(v0, v1));
            ro += ROWSTEP(k) * (unsigned)(FF * (F8O ? 1 : 2)); PINV(ro); }
    }
};
struct EpiSwiGLU8 {
    static constexpr bool PERM = true, SIDE = false;
    unsigned char* Hd; int nN;
    __device__ __forceinline__ void operator()(const f32x4 (&acc)[2][2][4][2], const Unit& u, int wr, int wc, int fr, int fq) const {
        PINV(fr); PINV(fq);
        const int row0 = u.pm * BM + wr * 64 + fr, pnl = u.pn % nN;
        unsigned ro = (unsigned)(row0 * FF + pnl * 128 + wc * 32 + 8 * fq); const __amdgpu_buffer_rsrc_t rH = mk_rsrc(Hd);
        constexpr float ci = 1.0f / (MOE_SA * MOE_SW);
#pragma unroll
        for (int k = 0; k < 8; ++k) { const int ai = k >> 2, m = k & 3;
            const f32x4 v0 = swiglu4(acc_f32(acc[ai][0][m][0], MOE_I8), acc_f32(acc[ai][1][m][0], MOE_I8), ci, ci * ci * F8_SH), v1 = swiglu4(acc_f32(acc[ai][0][m][1], MOE_I8), acc_f32(acc[ai][1][m][1], MOE_I8), ci, ci * ci * F8_SH);
            v2u w; w.x = pk_fp8x4(v0); w.y = pk_fp8x4(v1); st8(rH, ro, w);
            ro += ROWSTEP(k) * (unsigned)FF; PINV(ro); }
    }
};
template <bool I8> struct EpiQkvRopeT {
    static constexpr bool PERM = true, SIDE = true;
    bf16* QKV; const unsigned* rope; const float* SS; const float* bias; LAS unsigned char* side;
    __device__ __forceinline__ void side_issue(const Unit& u, int wid, int lane) const {
        LAS unsigned char* sl = side + u.sp * SIDE_BYTES;
        if (wid < 4) __builtin_amdgcn_global_load_lds((const unsigned*)(SS + ((size_t)(u.pm * BM + wid * 64 + lane)) * 4), (LAS unsigned*)(sl + wid * 1024), 16, 0, 0);
        else if (wid == 4) __builtin_amdgcn_global_load_lds((const unsigned*)(bias + (size_t)((u.pm * BM) / SEQ) * (2 * FF) + u.pn * BM + lane * 4), (LAS unsigned*)(sl + 4096), 16, 0, 0);
    }
    __device__ __forceinline__ void operator()(const f32x4 (&acc)[2][2][4][2], const Unit& u, int wr, int wc, int fr, int fq) const {
        PINV(fr); PINV(fq);
        const int hd = 4 * u.pn + wc; if (hd >= NHQKV) return;
        const int row0 = u.pm * BM + wr * 64 + fr;
        const float sc = hd < NH ? C2 : 1.0f;
        f32x4 (&a)[2][2][4][2] = const_cast<f32x4 (&)[2][2][4][2]>(acc);
        { const LAS unsigned char* sl = side + u.sp * SIDE_BYTES;
            f32x4 bv[2][2];
#pragma unroll
            for (int bj = 0; bj < 2; ++bj)
#pragma unroll
                for (int n = 0; n < 2; ++n) bv[bj][n] = *(const LAS f32x4*)(sl + 4096 + (bj * HALF + wc * 32 + 8 * fq + 4 * n) * 4);
#pragma unroll
            for (int k = 0; k < 8; ++k) { const float r = rinv_of(*(const LAS f32x4*)(sl + ((k >> 2) * HALF + wr * 64 + (k & 3) * 16 + fr) * 16)) * (I8 ? 1.0f / (GU_SA * GU_SW) : 1.0f);
#pragma unroll
                for (int bj = 0; bj < 2; ++bj)
#pragma unroll
                    for (int n = 0; n < 2; ++n) a[k >> 2][bj][k & 3][n] = acc_f32(a[k >> 2][bj][k & 3][n], I8) * r + bv[bj][n]; } }
        const bool rot = hd < 2 * NH; const __amdgpu_buffer_rsrc_t rQ = mk_rsrc(QKV);
        v4u cs[2][2];
        unsigned co = (unsigned)(row0 * 32 + 8 * fq) * 4u, ro = (unsigned)(row0 * QKVP + hd * 64 + 8 * fq) * 2u;
#define RP_H2F(u, hi) ((float)__builtin_bit_cast(_Float16, (unsigned short)((hi) ? ((u) >> 16) : ((u) & 0xffffu))))
        cs[0][0] = *at_off((const v4u*)rope, co); cs[0][1] = *at_off((const v4u*)rope, co + 16);
#pragma unroll
        for (int k = 0; k < 8; ++k) { const int ai = k >> 2, m = k & 3, cb_ = k & 1;
            co += ROWSTEP(k) * 128u; PINV(co);
            if (k < 7) { cs[cb_ ^ 1][0] = *at_off((const v4u*)rope, co); cs[cb_ ^ 1][1] = *at_off((const v4u*)rope, co + 16); }
#pragma unroll
            for (int n = 0; n < 2; ++n) {
                const f32x4 x1 = a[ai][0][m][n], x2 = a[ai][1][m][n]; f32x4 c, s;
#pragma unroll
                for (int i = 0; i < 4; ++i) { const float cf = RP_H2F(cs[cb_][n][i], 0), sf = RP_H2F(cs[cb_][n][i], 1); c[i] = rot ? cf : 1.0f; s[i] = rot ? sf : 0.0f; }
                const f32x4 o1 = (x1 * c - x2 * s) * sc, o2 = (x2 * c + x1 * s) * sc;
                v2u w; w.x = pg8::cvt_pk_bf16(o1[0], o1[1]); w.y = pg8::cvt_pk_bf16(o1[2], o1[3]); st8(rQ, ro + 8 * n, w);
                w.x = pg8::cvt_pk_bf16(o2[0], o2[1]); w.y = pg8::cvt_pk_bf16(o2[2], o2[3]); st8(rQ, ro + 64 + 8 * n, w); }
            ro += ROWSTEP(k) * (unsigned)(QKVP * 2); PINV(ro); }
#undef RP_H2F
    }
};
typedef EpiQkvRopeT<false> EpiQkvRope;
__device__ __forceinline__ void unpack8(const v4u u, f32x4& a, f32x4& b) { a = (f32x4){bflo(u.x), bfhi(u.x), bflo(u.y), bfhi(u.y)}; b = (f32x4){bflo(u.z), bfhi(u.z), bflo(u.w), bfhi(u.w)}; }
template <bool BASE_F32, bool NEXT, bool XB8 = false> struct EpiResidB {
    static constexpr bool PERM = true, SIDE = false;
    const void* base; bf16* XR; const float* gate; bf16* XB; float* SS; const float* scl; const float* ng; LAS float* red; float ascale;
    __device__ __forceinline__ void operator()(const f32x4 (&acc)[2][2][4][2], const Unit& u, int wr, int wc, int fr, int fq) const {
        PINV(fr); PINV(fq);
        const int row0 = u.pm * BM + wr * 64 + fr, col0 = u.pn * BM + wc * 32 + 8 * fq, b = (u.pm * BM) / SEQ;
        f32x4 gv[2][2], can[2][2];
#pragma unroll
        for (int bj = 0; bj < 2; ++bj)
#pragma unroll
            for (int n = 0; n < 2; ++n) { gv[bj][n] = *(const f32x4*)(gate + (size_t)b * 3072 + col0 + bj * HALF + 4 * n) * ascale;
                if (NEXT) can[bj][n] = *(const f32x4*)(ng + col0 + bj * HALF + 4 * n) * (*(const f32x4*)(scl + (size_t)b * 3072 + col0 + bj * HALF + 4 * n) + 1.0f); }
        const __amdgpu_buffer_rsrc_t rR = mk_rsrc(XR), rX = mk_rsrc(XB);
        f32x4 bf[2][2][2]; v4u bh[2][2];
        unsigned lo = (unsigned)(row0 * D + col0) * (BASE_F32 ? 4u : 2u), so = (unsigned)(row0 * D + col0) * 2u; int rl = wr * 64 + fr;
#define ER_LOAD(buf) do { if (BASE_F32) { _Pragma("unroll") for (int bj = 0; bj < 2; ++bj) _Pragma("unroll") for (int n = 0; n < 2; ++n) bf[buf][bj][n] = *at_off((const f32x4*)base, lo + (bj * HALF + 4 * n) * 4); } \
        else { _Pragma("unroll") for (int bj = 0; bj < 2; ++bj) bh[buf][bj] = *at_off((const v4u*)base, lo + bj * HALF * 2); } } while (0)
        ER_LOAD(0);
#pragma unroll
        for (int k = 0; k < 8; ++k) { const int ai = k >> 2, m = k & 3, cb_ = k & 1;
            lo += ROWSTEP(k) * (unsigned)(D * (BASE_F32 ? 4 : 2)); PINV(lo);
            if (k < 7) { if (cb_) ER_LOAD(0); else ER_LOAD(1); }
            float s = 0.f;
#pragma unroll
            for (int bj = 0; bj < 2; ++bj) { f32x4 x0, x1;
                if (BASE_F32) { x0 = bf[cb_][bj][0]; x1 = bf[cb_][bj][1]; } else unpack8(bh[cb_][bj], x0, x1);
                x0 = x0 + gv[bj][0] * acc[ai][bj][m][0]; x1 = x1 + gv[bj][1] * acc[ai][bj][m][1];
                st16(rR, so + bj * HALF * 2, pack8(x0, x1));
                if (NEXT) { s += ((x0.x * x0.x + x0.y * x0.y) + (x0.z * x0.z + x0.w * x0.w)) + ((x1.x * x1.x + x1.y * x1.y) + (x1.z * x1.z + x1.w * x1.w));
                    if (XB8) { v2u w8; w8.x = pk_q8x4(x0 * can[bj][0] * GU_SA); w8.y = pk_q8x4(x1 * can[bj][1] * GU_SA); st8(rX, (so >> 1) + bj * HALF, w8); }
                    else st16(rX, so + bj * HALF * 2, pack8(x0 * can[bj][0], x1 * can[bj][1])); } }
            if (NEXT) { s += __shfl_xor(s, 16); s += __shfl_xor(s, 32); if (fq == 0) red[rl * 4 + wc] = s; }
            so += ROWSTEP(k) * (unsigned)(D * 2); PINV(so); rl += (int)ROWSTEP(k); }
#undef ER_LOAD
        if (NEXT) {
            asm volatile("s_waitcnt lgkmcnt(0)" ::: "memory"); __builtin_amdgcn_s_barrier(); asm volatile("" ::: "memory");
            if (threadIdx.x < 256) { const f32x4 t = *(const LAS f32x4*)(red + threadIdx.x * 4); SS[(size_t)(u.pm * BM + threadIdx.x) * 4 + u.pn] = (t.x + t.y) + (t.z + t.w); }
        }
    }
};
struct EpiMoeDown {
    static constexpr bool PERM = true, SIDE = true;
    bf16* XR; bf16* Y1; const int* rowtok; const float* roww; const LAS float* gate; float oscale; LAS unsigned char* side;
    __device__ __forceinline__ void side_issue(const Unit& u, int wid, int lane) const {
        LAS unsigned char* sl = side + u.sp * 2048; const size_t lb = (size_t)u.g * M + 256 * u.k;
        if (wid < 4) __builtin_amdgcn_global_load_lds((const unsigned*)(rowtok + lb + wid * 64 + lane), (LAS unsigned*)(sl + wid * 256), 4, 0, 0);
        else __builtin_amdgcn_global_load_lds((const unsigned*)(roww + lb + (wid - 4) * 64 + lane), (LAS unsigned*)(sl + 1024 + (wid - 4) * 256), 4, 0, 0);
    }
    __device__ __forceinline__ void operator()(const f32x4 (&acc)[2][2][4][2], const Unit& u, int wr, int wc, int fr, int fq) const {
        PINV(fr); PINV(fq);
        const int col0 = (u.pn & 3) * BM + wc * 32 + 8 * fq; const LAS unsigned char* sl = side + u.sp * 2048;
        int tok[8]; float w[8];
#pragma unroll
        for (int k = 0; k < 8; ++k) { const int rl = (k >> 2) * HALF + wr * 64 + (k & 3) * 16 + fr; const bool ok = rl < u.nv; const int t_ = *(const LAS int*)(sl + rl * 4); const float w_ = *(const LAS float*)(sl + 1024 + rl * 4);
            tok[k] = ok ? t_ : -1; w[k] = ok ? w_ * oscale : 0.f; }
        if (u.g < 8) {
            const __amdgpu_buffer_rsrc_t rR = mk_rsrc(XR);
            v4u bh[2][2];
#define ER_LOAD(buf, kk) do { const unsigned o_ = (unsigned)((tok[kk] < 0 ? 0 : tok[kk]) * D + col0) * 2u; \
            _Pragma("unroll") for (int bj = 0; bj < 2; ++bj) bh[buf][bj] = *at_off((const v4u*)XR, o_ + bj * HALF * 2); } while (0)
            ER_LOAD(0, 0);
#pragma unroll
            for (int k = 0; k < 8; ++k) { const int ai = k >> 2, m = k & 3, cb_ = k & 1;
                if (k < 7) { if (cb_) ER_LOAD(0, (k + 1) & 7); else ER_LOAD(1, (k + 1) & 7); }
#pragma unroll
                for (int bj = 0; bj < 2; ++bj) PINV(bh[cb_][bj]);
                if (tok[k] >= 0) { const unsigned o_ = (unsigned)(tok[k] * D + col0) * 2u; const LAS float* g_ = gate + (tok[k] >> 13) * D + col0; const float w_ = w[k];
#pragma unroll
                    for (int bj = 0; bj < 2; ++bj) { f32x4 x0, x1; unpack8(bh[cb_][bj], x0, x1);
                        x0 = x0 + *(const LAS f32x4*)(g_ + bj * HALF) * w_ * acc[ai][bj][m][0]; x1 = x1 + *(const LAS f32x4*)(g_ + bj * HALF + 4) * w_ * acc[ai][bj][m][1];
                        st16(rR, o_ + bj * HALF * 2, pack8(x0, x1)); } } }
#undef ER_LOAD
        } else {
            const __amdgpu_buffer_rsrc_t rY = mk_rsrc(Y1);
#pragma unroll
            for (int k = 0; k < 8; ++k) { const int ai = k >> 2, m = k & 3;
                if (tok[k] >= 0) { const unsigned o_ = (unsigned)(tok[k] * D + col0) * 2u; const LAS float* g_ = gate + (tok[k] >> 13) * D + col0; const float w_ = w[k];
#pragma unroll
                    for (int bj = 0; bj < 2; ++bj) st16(rY, o_ + bj * HALF * 2, pack8(*(const LAS f32x4*)(g_ + bj * HALF) * w_ * acc[ai][bj][m][0], *(const LAS f32x4*)(g_ + bj * HALF + 4) * w_ * acc[ai][bj][m][1])); } }
        }
    }
};
struct EpiNull { static constexpr bool PERM = true, SIDE = false;
    __device__ __forceinline__ void operator()(const f32x4 (&acc)[2][2][4][2], const Unit& u, int wr, int wc, int fr, int fq) const {
        PINV(fr); PINV(fq);
#pragma unroll
        for (int ai = 0; ai < 2; ++ai)
#pragma unroll
            for (int bj = 0; bj < 2; ++bj)
                asm volatile("" :: "v"(acc[ai][bj][0][0]), "v"(acc[ai][bj][0][1]), "v"(acc[ai][bj][1][0]), "v"(acc[ai][bj][1][1]), "v"(acc[ai][bj][2][0]), "v"(acc[ai][bj][2][1]), "v"(acc[ai][bj][3][0]), "v"(acc[ai][bj][3][1])); } };
__constant__ float INVF[32] = {
    1.0f, 0.7498942093324559f, 0.5623413251903491f, 0.4216965034285822f, 0.31622776601683794f, 0.23713737056616552f, 0.1778279410038923f, 0.1333521432163324f,
    0.1f, 0.07498942093324558f, 0.05623413251903491f, 0.04216965034285822f, 0.03162277660168379f, 0.023713737056616554f, 0.01778279410038923f, 0.01333521432163324f,
    0.01f, 0.007498942093324558f, 0.005623413251903491f, 0.004216965034285823f, 0.0031622776601683794f, 0.0023713737056616554f, 0.0017782794100389228f, 0.001333521432163324f,
    0.001f, 0.0007498942093324559f, 0.0005623413251903491f, 0.0004216965034285823f, 0.00031622776601683794f, 0.00023713737056616554f, 0.00017782794100389227f, 0.0001333521432163324f };

template <int MAP, int FMT  >
__device__ __forceinline__ void conv_block(const float* W, int ld, int ncol, int kvalid, int k0, int c0, unsigned char* dst, int Kp  , int rowoff, float sc, int wave, int lane) {
    const int col = c0 + 4 * lane, kb = k0 + 16 * wave; const bool act = col < ncol;
    f32x4 v[16];
#pragma unroll
    for (int i = 0; i < 16; ++i) v[i] = (act && kb + i < kvalid) ? *(const f32x4*)(W + (size_t)(kb + i) * ld + col) : (f32x4){0.f, 0.f, 0.f, 0.f};
    if (!act) return;
    int nrow;
    if (MAP == 0) nrow = col;
    else if (MAP == 1) { if (col < 1024) nrow = 2048 + col; else { const int cc = (col - 1024) & 1023, up = col >= 2048; nrow = 256 * (cc >> 7) + (cc & 127) + (up ? 128 : 0); } }
    else if (MAP == 2) nrow = 256 * (col >> 7) + (col & 127);
    else { const int head = col >> 6, bj = (col >> 5) & 1, dd = col & 31; nrow = 256 * (head >> 2) + 128 * bj + 32 * (head & 3) + dd; }
    nrow += rowoff;
#pragma unroll
    for (int j = 0; j < 4; ++j) {
        if (FMT != 0) { v4u o;
#pragma unroll
            for (int q = 0; q < 4; ++q) { const f32x4 t = (f32x4){v[4 * q][j], v[4 * q + 1][j], v[4 * q + 2][j], v[4 * q + 3][j]} * sc; o[q] = FMT == 2 ? pk_i8x4(t) : pk_fp8x4(t); }
            *(v4u*)(dst + (size_t)(nrow + j) * Kp + kb) = o; }
        else { v4u o0, o1;
#pragma unroll
            for (int q = 0; q < 4; ++q) { o0[q] = pk2(v[2 * q][j], v[2 * q + 1][j]); o1[q] = pk2(v[8 + 2 * q][j], v[8 + 2 * q + 1][j]); }
            bf16* p = (bf16*)dst + (size_t)(nrow + j) * Kp + kb; *(v4u*)p = o0; *(v4u*)(p + 8) = o1; }
    }
}
__device__ __forceinline__ void p0_prologue(const Args& a, LAS unsigned char* lds, int gw, int NGW, int wave, int lane, int tid) {
    unsigned char* ws = a.ws;
    LAS float* sc = (LAS float*)(lds + 69632);
    for (int i = tid; i < NB * D; i += NTHR) sc[i] = silu_f(a.c[i]);
    if (blockIdx.x == 0) for (int i = tid; i < 16 * 3072; i += NTHR) ((float*)(ws + WS_ZG))[i] = 0.f;
    if (blockIdx.x == 1) for (int i = tid; i < 2 * RPAD; i += NTHR) ((int*)(ws + WS_IDENT))[i] = i;
    if (blockIdx.x == 2) {
        for (int i = tid; i < 192 * (D / 8); i += NTHR) { const int rr = i / (D / 8), c8 = i % (D / 8), bj = rr / 96, q = rr % 96;
            if (QKV_I8) { if (c8 < D / 16) *(v4u*)(ws + WS_WQKV + (size_t)(2816 + 128 * bj + 32 + q) * D + 16 * c8) = (v4u){0u, 0u, 0u, 0u}; }
            else *(v4u*)((bf16*)(ws + WS_WQKV) + (size_t)(2816 + 128 * bj + 32 + q) * D + 8 * c8) = (v4u){0u, 0u, 0u, 0u}; } }
    __syncthreads();
    constexpr int B_CIN = 8 * 12, B_COUT = 8 * 4, B_FG = 8 * 11, B_FD = 22 * 4, B_QKV = 8 * 12, B_WO = 8 * 4, B_MG = NE * B_FG, B_MD = NE * B_FD;
    constexpr int NBLK = B_CIN + B_COUT + 2 * B_FG + B_FD + B_QKV + B_WO + 2 * B_MG + B_MD;
    for (int it = blockIdx.x; it < NBLK; it += gridDim.x) {
        int r = it;
        if (r < B_CIN) { conv_block<1, CONVIN_I8 ? 2 : 0>(a.conv_w_in, 3072, 3072, D, 128 * (r / 12), 256 * (r % 12), ws + WS_WCIN, D, 0, GU_SW, wave, lane); continue; } r -= B_CIN;
        if (r < B_COUT) { conv_block<0, WOUT_FP8 ? 1 : 0>(a.conv_w_out, D, D, D, 128 * (r / 4), 256 * (r % 4), ws + WS_WCOUT, D, 0, F8_SW, wave, lane); continue; } r -= B_COUT;
        if (r < 2 * B_FG) { const int up = r >= B_FG, q = up ? r - B_FG : r;
            conv_block<2, DENSE_GU_FP8 ? (GU_I8 ? 2 : 1) : 0>(up ? a.ffn_u : a.ffn_g, FF, FF, D, 128 * (q / 11), 256 * (q % 11), ws + WS_WFGU, D, up ? 128 : 0, GU_SW, wave, lane); continue; } r -= 2 * B_FG;
        if (r < B_FD) { conv_block<0, DENSE_DOWN_FP8 ? 1 : 0>(a.ffn_d, D, D, FF, 128 * (r / 4), 256 * (r % 4), ws + WS_WFD, FF, 0, F8_SW, wave, lane); continue; } r -= B_FD;
        if (r < B_QKV) { conv_block<3, QKV_I8 ? 2 : 0>(a.w_qkv, 2880, 2880, D, 128 * (r / 12), 256 * (r % 12), ws + WS_WQKV, D, 0, GU_SW, wave, lane); continue; } r -= B_QKV;
        if (r < B_WO) { conv_block<0, WO_FP8 ? 1 : 0>(a.w_o, D, D, 960, 128 * (r / 4), 256 * (r % 4), ws + WS_WO, D, 0, F8_SW, wave, lane); continue; } r -= B_WO;
        if (r < 2 * B_MG) { const int up = r >= B_MG, q = up ? r - B_MG : r, e = q / B_FG, qq = q % B_FG;
            conv_block<2, MOE_I8 ? 2 : 1>((up ? a.moe_u : a.moe_g) + (size_t)e * D * FF, FF, FF, D, 128 * (qq / 11), 256 * (qq % 11), ws + WS_WMGU, D, e * 2 * FF + (up ? 128 : 0), MOE_SW, wave, lane); continue; } r -= 2 * B_MG;
        { const int e = r / B_FD, qq = r % B_FD;
            conv_block<0, 1>(a.moe_d + (size_t)e * FF * D, D, D, FF, 128 * (qq / 4), 256 * (qq % 4), ws + WS_WMD, FF, e * D, F8_SW, wave, lane); }
    }
    constexpr int I_ADA = 4 * 12 * 8, I_ROPE = M / 2;
    for (int it = gw; it < I_ADA + I_ROPE; it += NGW) {
        int r = it;
        if (r < I_ADA) {
            const int ls = r / 96, q = r % 96, cg = q / 8, kc = q % 8;
            const float* W = a.mod_w + (size_t)ls * D * 3072 + (size_t)(kc * 128) * 3072 + cg * 256 + 4 * lane;
            f32x4 acc[NB];
#pragma unroll
            for (int b = 0; b < NB; ++b) acc[b] = (f32x4){0.f, 0.f, 0.f, 0.f};
#pragma unroll 8
            for (int k = 0; k < 128; ++k) { const f32x4 w = *(const f32x4*)(W + (size_t)k * 3072);
#pragma unroll
                for (int b = 0; b < NB; ++b) acc[b] += w * sc[b * D + kc * 128 + k]; }
            float* P = (float*)(ws + WS_MODP);
#pragma unroll
            for (int b = 0; b < NB; ++b) *(f32x4*)(P + (size_t)(kc * 16 + ls * 4 + b) * 3072 + cg * 256 + 4 * lane) = acc[b];
            continue;
        }
        r -= I_ADA;
        {
            const int tok = 2 * r + (lane >> 5), i = lane & 31;
            const float ang = (float)a.pos[tok] * INVF[i];
            double rev = (double)ang * 0.15915494309189535; rev -= __builtin_rint(rev);
            const float fr = (float)rev;
            unsigned* R = (unsigned*)(ws + WS_ROPE) + (size_t)tok * 32;
            const _Float16 hc = (_Float16)__builtin_amdgcn_cosf(fr), hs = (_Float16)__builtin_amdgcn_sinf(fr);
            R[i] = (unsigned)__builtin_bit_cast(unsigned short, hc) | ((unsigned)__builtin_bit_cast(unsigned short, hs) << 16);
        }
    }
}

template <bool FROM_PARTIALS, bool ROUTE, bool SRC16 = false, bool OUT8 = ROUTE>
__device__ __forceinline__ void norm_phase(const Args& a, const void* xsrc, int ls, LAS unsigned char* lds, int G, int wave, int lane, int tid) {
    unsigned char* ws = a.ws;
    LAS float* cA = (LAS float*)lds;
    LAS float* cB = (LAS float*)(lds + 4096);
    LAS float* rwT = (LAS float*)(lds + 8192);
    bf16* H = (bf16*)(ws + WS_H);
    const float* P = (const float*)(ws + WS_MODP); const float* MF = (const float*)(ws + WS_MODF);
    if (ROUTE) { for (int i = tid; i < D * NE; i += NTHR) { const int k = i >> 3, e = i & 7; rwT[e * D + k] = a.router_w[i]; } }
    for (int ch = blockIdx.x; ch < NCHUNK; ch += G) {
        const int b = ch / (SEQ / 128);
        __syncthreads();
        for (int k = tid; k < D; k += NTHR) {
            float sh, scl;
            if (FROM_PARTIALS) { sh = a.mod_b[ls * 3072 + k]; scl = a.mod_b[ls * 3072 + D + k];
#pragma unroll
                for (int kc = 0; kc < 8; ++kc) { sh += P[(size_t)(kc * 16 + ls * 4 + b) * 3072 + k]; scl += P[(size_t)(kc * 16 + ls * 4 + b) * 3072 + D + k]; } }
            else { sh = MF[(size_t)(ls * 4 + b) * 3072 + k]; scl = MF[(size_t)(ls * 4 + b) * 3072 + D + k]; }
            cA[k] = a.norm_g[ls * D + k] * (1.0f + scl); cB[k] = sh;
        }
        int my_e0 = -1, my_e1 = -1; float my_w0 = 0.f, my_w1 = 0.f;
        __syncthreads();
        v2u nb16[2][4]; f32x4 nb32[2][4];
#define NP_LOAD(buf, ii) do { const int row_ = ch * 128 + wave * 16 + (ii); \
            if (SRC16) { const v2u* xr = (const v2u*)((const bf16*)xsrc + (size_t)row_ * D) + lane; _Pragma("unroll") for (int j = 0; j < 4; ++j) nb16[buf][j] = xr[64 * j]; } \
            else { const f32x4* xr = (const f32x4*)((const float*)xsrc + (size_t)row_ * D) + lane; _Pragma("unroll") for (int j = 0; j < 4; ++j) nb32[buf][j] = xr[64 * j]; } } while (0)
        NP_LOAD(0, 0);
        for (int i2 = 0; i2 < 16; i2 += 2) {
#pragma unroll
          for (int pb = 0; pb < 2; ++pb) {
            const int i = i2 + pb;
            if (pb == 0) NP_LOAD(1, i + 1); else if (i + 1 < 16) NP_LOAD(0, i + 1);
            const int row = ch * 128 + wave * 16 + i;
            f32x4 v[4]; float s = 0.f;
#pragma unroll
            for (int j = 0; j < 4; ++j) { if (SRC16) { const v2u t = nb16[pb][j]; v[j] = (f32x4){bflo(t.x), bfhi(t.x), bflo(t.y), bfhi(t.y)}; } else v[j] = nb32[pb][j]; }
#pragma unroll
            for (int j = 0; j < 4; ++j) s += (v[j].x * v[j].x + v[j].y * v[j].y) + (v[j].z * v[j].z + v[j].w * v[j].w);
            const float rinv = 1.0f / sqrtf(wave_sum(s) * (1.0f / D) + RMS_EPS);
            if (FROM_PARTIALS) { unsigned long long* x8 = (unsigned long long*)((bf16*)(ws + WS_XR) + (size_t)row * D) + lane;
#pragma unroll
                for (int j = 0; j < 4; ++j) x8[64 * j] = (unsigned long long)pk2(v[j].x, v[j].y) | ((unsigned long long)pk2(v[j].z, v[j].w) << 32); }
            unsigned long long* o8 = (unsigned long long*)(H + (size_t)row * D) + lane;
#pragma unroll
            for (int j = 0; j < 4; ++j) { const f32x4 ca = *(const LAS f32x4*)(cA + 4 * lane + 256 * j), cb = *(const LAS f32x4*)(cB + 4 * lane + 256 * j);
                v[j] = v[j] * rinv * ca + cb;
                if (OUT8) ((unsigned*)((unsigned char*)H + (size_t)row * D))[lane + 64 * j] = MOE_I8 ? pk_i8x4(v[j] * MOE_SA) : pk_fp8x4(v[j] * MOE_SA);
                else o8[64 * j] = (unsigned long long)pk2(v[j].x, v[j].y) | ((unsigned long long)pk2(v[j].z, v[j].w) << 32); }
            if (ROUTE) {
                float pe[NE];
#pragma unroll
                for (int e = 0; e < NE; ++e) pe[e] = 0.f;
#pragma unroll
                for (int j = 0; j < 4; ++j) {
#pragma unroll
                    for (int e = 0; e < NE; ++e) { const f32x4 w = *(const LAS f32x4*)(rwT + e * D + 4 * lane + 256 * j); pe[e] += (v[j].x * w.x + v[j].y * w.y) + (v[j].z * w.z + v[j].w * w.w); }
                    asm volatile("" ::: "memory"); }
                float lg[NE];
#pragma unroll
                for (int e = 0; e < NE; ++e) lg[e] = wave_sum(pe[e]);
                int i0 = 0; float v0 = lg[0];
#pragma unroll
                for (int e = 1; e < NE; ++e) if (lg[e] > v0) { v0 = lg[e]; i0 = e; }
                int i1 = -1; float v1 = -INFINITY;
#pragma unroll
                for (int e = 0; e < NE; ++e) if (e != i0 && lg[e] > v1) { v1 = lg[e]; i1 = e; }
                const float w0 = 1.0f / (1.0f + expf(v1 - v0)), w1 = 1.0f - w0;
                if (lane == i) { my_e0 = i0; my_e1 = i1; my_w0 = w0; my_w1 = w1; }
            }
          }
        }
#undef NP_LOAD
        if (ROUTE) {
            unsigned* CNT = (unsigned*)(ws + WS_CTL) + CW_CNT; int* RT2 = (int*)(ws + WS_RT2); float* RW2 = (float*)(ws + WS_RW2);
#pragma unroll
            for (int s = 0; s < 2; ++s) {
                const int me = lane < 16 ? (s ? my_e1 : my_e0) : -1; int rank = 0, mycount = 0;
#pragma unroll
                for (int e = 0; e < NE; ++e) { const unsigned long long mask = __ballot(me == e); if (lane == e) mycount = __popcll(mask); if (me == e) rank = __popcll(mask & ((1ull << lane) - 1ull)); }
                int base = 0; if (lane < NE && mycount > 0) base = (int)__hip_atomic_fetch_add(CNT + s * 8 + lane, (unsigned)mycount, __ATOMIC_RELAXED, __HIP_MEMORY_SCOPE_AGENT);
                const int bs = __shfl(base, me < 0 ? 0 : me);
                if (lane < 16) { const size_t p = (size_t)(s * 8 + me) * M + bs + rank; RT2[p] = ch * 128 + wave * 16 + lane; RW2[p] = s ? my_w1 : my_w0; }
            }
        }
    }
    if (FROM_PARTIALS) {
        float* MFw = (float*)(ws + WS_MODF);
        for (int idx = blockIdx.x * NTHR + tid; idx < 16 * 3072; idx += G * NTHR) { const int lsb = idx / 3072, n = idx % 3072; float s = a.mod_b[(lsb >> 2) * 3072 + n];
#pragma unroll
            for (int kc = 0; kc < 8; ++kc) s += P[(size_t)(kc * 16 + lsb) * 3072 + n];
            MFw[idx] = s; }
    }
}

__device__ __forceinline__ void conv_phase(const Args& a, int G, int tid) {
    unsigned char* ws = a.ws;
    const bf16* V = (const bf16*)(ws + WS_V); const bf16* Bg = (const bf16*)(ws + WS_BG); bf16* Y = (bf16*)(ws + WS_H);
    const int cg = tid & 127, rs = tid >> 7;
    float w0[8], w1[8], w2[8];
#pragma unroll
    for (int i = 0; i < 8; ++i) { w0[i] = a.conv_w[8 * cg + i]; w1[i] = a.conv_w[D + 8 * cg + i]; w2[i] = a.conv_w[2 * D + 8 * cg + i]; }
    for (int ch = blockIdx.x; ch < NCHUNK; ch += G) {
        const int r0 = ch * 128 + rs * 32, t0 = r0 & (SEQ - 1);
        v4u zz = (v4u){0u, 0u, 0u, 0u};
        v4u vm2 = t0 >= 2 ? *(const v4u*)(V + (size_t)(r0 - 2) * D + 8 * cg) : zz;
        v4u vm1 = t0 >= 1 ? *(const v4u*)(V + (size_t)(r0 - 1) * D + 8 * cg) : zz;
#pragma unroll 4
        for (int i = 0; i < 32; ++i) {
            const size_t off = (size_t)(r0 + i) * D + 8 * cg;
            const v4u v = *(const v4u*)(V + off), bg = *(const v4u*)(Bg + off);
            v4u o; float ylo8[4], yhi8[4];
#pragma unroll
            for (int q = 0; q < 4; ++q) {
                const float ylo = bflo(bg[q]) * (w0[2 * q] * bflo(vm2[q]) + w1[2 * q] * bflo(vm1[q]) + w2[2 * q] * bflo(v[q]));
                const float yhi = bfhi(bg[q]) * (w0[2 * q + 1] * bfhi(vm2[q]) + w1[2 * q + 1] * bfhi(vm1[q]) + w2[2 * q + 1] * bfhi(v[q]));
                o[q] = pk2(ylo, yhi); if (WOUT_FP8) { ylo8[q] = ylo; yhi8[q] = yhi; } }
            if (WOUT_FP8) { v2u w8; w8.x = pk_fp8x4((f32x4){ylo8[0], yhi8[0], ylo8[1], yhi8[1]} * F8_SH); w8.y = pk_fp8x4((f32x4){ylo8[2], yhi8[2], ylo8[3], yhi8[3]} * F8_SH); *(v2u*)((unsigned char*)Y + off) = w8; }
            else *(v4u*)(Y + off) = o;
            vm2 = vm1; vm1 = v;
        }
    }
}

__device__ __forceinline__ void bias_gemv(const Args& a, int gw, int NGW, int lane) {
    unsigned char* ws = a.ws; const float* MF = (const float*)(ws + WS_MODF); float* BV = (float*)(ws + WS_BIASV);
    constexpr int NROW = 2 * FF + QKVP, RPW = 5;
    for (int base = 0; base < NROW; base += RPW * NGW) {
    float res[RPW][NB];
#pragma unroll
    for (int i = 0; i < RPW; ++i) {
        const int r = base + gw + i * NGW; const bool ok = r < NROW; const int rr = ok ? r : 0;
        const int ls = rr < 2 * FF ? 1 : 2, np = ls == 1 ? rr : rr - 2 * FF;
        float wf[16];
        if ((ls == 1 && DENSE_GU_FP8) || (ls == 2 && QKV_I8)) { const v4u w8 = *(const v4u*)(ws + (ls == 1 ? WS_WFGU : WS_WQKV) + (size_t)np * D + 16 * lane);
#pragma unroll
            for (int q = 0; q < 4; ++q) {
                if (GU_I8 || ls == 2) { const int w = (int)w8[q]; wf[4 * q] = (float)((w << 24) >> 24) * (1.0f / GU_SW); wf[4 * q + 1] = (float)((w << 16) >> 24) * (1.0f / GU_SW); wf[4 * q + 2] = (float)((w << 8) >> 24) * (1.0f / GU_SW); wf[4 * q + 3] = (float)(w >> 24) * (1.0f / GU_SW); }
                else { wf[4 * q] = __builtin_amdgcn_cvt_f32_fp8((int)w8[q], 0) * (1.0f / GU_SW); wf[4 * q + 1] = __builtin_amdgcn_cvt_f32_fp8((int)w8[q], 1) * (1.0f / GU_SW);
                    wf[4 * q + 2] = __builtin_amdgcn_cvt_f32_fp8((int)w8[q], 2) * (1.0f / GU_SW); wf[4 * q + 3] = __builtin_amdgcn_cvt_f32_fp8((int)w8[q], 3) * (1.0f / GU_SW); } } }
        else { const bf16* wrow = (ls == 1 ? (const bf16*)(ws + WS_WFGU) : (const bf16*)(ws + WS_WQKV)) + (size_t)np * D + 16 * lane;
            const v4u w0 = *(const v4u*)wrow, w1 = *(const v4u*)(wrow + 8);
#pragma unroll
            for (int q = 0; q < 4; ++q) { wf[2 * q] = bflo(w0[q]); wf[2 * q + 1] = bfhi(w0[q]); wf[8 + 2 * q] = bflo(w1[q]); wf[8 + 2 * q + 1] = bfhi(w1[q]); } }
#pragma unroll
        for (int b = 0; b < NB; ++b) { const float* sh = MF + (size_t)(ls * 4 + b) * 3072 + 16 * lane; float p = 0.f;
#pragma unroll
            for (int q = 0; q < 4; ++q) { const f32x4 s4 = *(const f32x4*)(sh + 4 * q); p += (wf[4 * q] * s4.x + wf[4 * q + 1] * s4.y) + (wf[4 * q + 2] * s4.z + wf[4 * q + 3] * s4.w); }
            res[i][b] = wave_sum(p); }
    }
#pragma unroll
    for (int i = 0; i < RPW; ++i) { const int r = base + gw + i * NGW;
        if (r < NROW && lane == 0) { const int ls = r < 2 * FF ? 1 : 2, np = ls == 1 ? r : r - 2 * FF;
#pragma unroll
            for (int b = 0; b < NB; ++b) BV[(size_t)((ls - 1) * 4 + b) * (2 * FF) + np] = res[i][b]; } }
    }
}
typedef float f32x16 __attribute__((ext_vector_type(16)));
typedef short bf16x8 __attribute__((ext_vector_type(8)));
typedef short v4i16_t __attribute__((ext_vector_type(4)));
constexpr int ATT_TILES = NB * NH * 256;
constexpr int KROWB = 144;
constexpr int VROWB = 192;
template <int PASS>
__device__ __forceinline__ void attn_mfma(const Args& a, LAS unsigned char* lds, int gw, int NGW, int wave, int lane) {
    unsigned char* ws = a.ws;
    const bf16* QKV = (const bf16*)(ws + WS_QKV); bf16* AO = (bf16*)(ws + WS_H); float* LSE = (float*)(ws + WS_LSE);
    const int r32 = lane & 31, hi = lane >> 5;
    LAS unsigned char* vbuf = lds + wave * (32 * VROWB + 32 * KROWB);
    LAS unsigned char* kbuf = vbuf + 32 * VROWB;
    const int L16 = lane & 15, tq = L16 >> 2, tp = L16 & 3, gi = (lane >> 4) & 1;
    LAS unsigned char* trbase = vbuf + (4 * hi + tq) * VROWB + (16 * gi + 4 * tp) * 2;
    for (int tile = gw; tile < ATT_TILES; tile += NGW) {
        const int ti = tile & 255, bh = tile >> 8, b = bh / NH, hq = bh - b * NH, g = hq / 5, slot = hq - g * 5;
        const int sh = 2 * g, r = 1 << sh, nblk = 256 >> sh, rho = ti >> (8 - sh), blk = ti & (nblk - 1), i0 = 32 * blk;
        const size_t tok0 = (size_t)b * SEQ + rho;
        const bf16* Qp = QKV + (tok0 + (size_t)r * (i0 + r32)) * QKVP + hq * 64 + 8 * hi;
        bf16x8 qf[4];
#pragma unroll
        for (int ds = 0; ds < 4; ++ds) qf[ds] = *(const bf16x8*)(Qp + 16 * ds);
        const int nkb = blk + 1 < 5 ? blk + 1 : 5;
        float m_run = -1e30f, l_run = 0.f, LT = 0.f;
        f32x16 o0 = {}, o1 = {};
        if (PASS == 1) { const float* lp = LSE + (tok0 + (size_t)r * (i0 + r32)) * 16 + slot; const float l0 = lp[0], l1 = lp[5], l2 = lp[10];
            const float mm = fmaxf(fmaxf(l0, l1), l2);
            LT = mm + __builtin_amdgcn_logf(__builtin_amdgcn_exp2f(l0 - mm) + __builtin_amdgcn_exp2f(l1 - mm) + __builtin_amdgcn_exp2f(l2 - mm)); }
        v4u krn[4], vrn[4];
#define ATT_LOAD(jj) do { const int p0_ = i0 + 32 * ((jj) - (nkb - 1)); \
            _Pragma("unroll") for (int c = 0; c < 4; ++c) { const int pi = lane + 64 * c, row = pi >> 3, chunk = pi & 7; const bf16* rp_ = QKV + (tok0 + (size_t)r * (p0_ + row)) * QKVP + 8 * chunk; \
                krn[c] = *(const v4u*)(rp_ + (NH + hq) * 64); if (PASS == 1) vrn[c] = *(const v4u*)(rp_ + (2 * NH + hq) * 64); } } while (0)
        ATT_LOAD(0);
        for (int j = 0; j < nkb; ++j) {
            const int kb = j - (nkb - 1);
            bf16x8 kf[4]; v4u vraw[4];
#pragma unroll
            for (int c = 0; c < 4; ++c) { const int pi = lane + 64 * c, row = pi >> 3, chunk = pi & 7; *(LAS v4u*)(kbuf + row * KROWB + chunk * 16) = krn[c]; }
            if (PASS == 1) {
#pragma unroll
                for (int c = 0; c < 4; ++c) vraw[c] = vrn[c]; }
            if (j + 1 < nkb) ATT_LOAD(j + 1);
#pragma unroll
            for (int ds = 0; ds < 4; ++ds) kf[ds] = *(const LAS bf16x8*)(kbuf + r32 * KROWB + (16 * ds + 8 * hi) * 2);
            f32x16 s = {};
#pragma unroll
            for (int ds = 0; ds < 4; ++ds) s = __builtin_amdgcn_mfma_f32_32x32x16_bf16(kf[ds], qf[ds], s, 0, 0, 0);
            if (kb == 0) {
#pragma unroll
                for (int q = 0; q < 16; ++q) { const int c = (q & 3) + 8 * (q >> 2) + 4 * hi; if (c > r32) s[q] = -1e30f; }
            } else if (kb == -4) {
#pragma unroll
                for (int q = 0; q < 16; ++q) { const int c = (q & 3) + 8 * (q >> 2) + 4 * hi; if (c < r32) s[q] = -1e30f; }
            }
            if (PASS == 0) {
                float bm = s[0];
#pragma unroll
                for (int q = 1; q < 16; ++q) bm = fmaxf(bm, s[q]);
                const float mn = fmaxf(m_run, bm); float acc = 0.f;
#pragma unroll
                for (int q = 0; q < 16; ++q) acc += __builtin_amdgcn_exp2f(s[q] - mn);
                l_run = l_run * __builtin_amdgcn_exp2f(m_run - mn) + acc; m_run = mn;
            } else {
#pragma unroll
                for (int c = 0; c < 4; ++c) { const int pi = lane + 64 * c, row = pi >> 3, chunk = pi & 7; *(LAS v4u*)(vbuf + row * VROWB + chunk * 16) = vraw[c]; }
                v4u pw0, pw1;
                { float p[16];
#pragma unroll
                  for (int q = 0; q < 16; ++q) p[q] = __builtin_amdgcn_exp2f(s[q] - LT);
                  pw0.x = pg8::cvt_pk_bf16(p[0], p[1]); pw0.y = pg8::cvt_pk_bf16(p[2], p[3]); pw0.z = pg8::cvt_pk_bf16(p[4], p[5]); pw0.w = pg8::cvt_pk_bf16(p[6], p[7]);
                  pw1.x = pg8::cvt_pk_bf16(p[8], p[9]); pw1.y = pg8::cvt_pk_bf16(p[10], p[11]); pw1.z = pg8::cvt_pk_bf16(p[12], p[13]); pw1.w = pg8::cvt_pk_bf16(p[14], p[15]); }
                const bf16x8 pa0 = __builtin_bit_cast(bf16x8, pw0), pa1 = __builtin_bit_cast(bf16x8, pw1);
#pragma unroll
                for (int db = 0; db < 2; ++db) {
                    bf16x8 vb[2];
#pragma unroll
                    for (int s2 = 0; s2 < 2; ++s2) {
                        const v4i16_t lo = __builtin_amdgcn_ds_read_tr16_b64_v4i16((LAS v4i16_t*)(trbase + (16 * s2) * VROWB + 64 * db));
                        const v4i16_t hh = __builtin_amdgcn_ds_read_tr16_b64_v4i16((LAS v4i16_t*)(trbase + (16 * s2 + 8) * VROWB + 64 * db));
                        vb[s2] = (bf16x8){lo[0], lo[1], lo[2], lo[3], hh[0], hh[1], hh[2], hh[3]};
                    }
                    if (db == 0) { o0 = __builtin_amdgcn_mfma_f32_32x32x16_bf16(pa0, vb[0], o0, 0, 0, 0); o0 = __builtin_amdgcn_mfma_f32_32x32x16_bf16(pa1, vb[1], o0, 0, 0, 0); }
                    else         { o1 = __builtin_amdgcn_mfma_f32_32x32x16_bf16(pa0, vb[0], o1, 0, 0, 0); o1 = __builtin_amdgcn_mfma_f32_32x32x16_bf16(pa1, vb[1], o1, 0, 0, 0); }
                }
            }
        }
        if (PASS == 0) {
            const float m2 = __shfl_xor(m_run, 32), l2 = __shfl_xor(l_run, 32);
            const float mt = fmaxf(m_run, m2), lt = l_run * __builtin_amdgcn_exp2f(m_run - mt) + l2 * __builtin_amdgcn_exp2f(m2 - mt);
            if (hi == 0) LSE[(tok0 + (size_t)r * (i0 + r32)) * 16 + hq] = mt + __builtin_amdgcn_logf(lt);
        } else {
#pragma unroll
            for (int q = 0; q < 16; ++q) { const int c = (q & 3) + 8 * (q >> 2) + 4 * hi;
                if (WO_FP8) { unsigned char* op8 = (unsigned char*)AO + (tok0 + (size_t)r * (i0 + c)) * D + hq * 64 + r32;
                    op8[0] = (unsigned char)(pk_fp8x4((f32x4){o0[q] * F8_SO, 0.f, 0.f, 0.f}) & 0xffu); op8[32] = (unsigned char)(pk_fp8x4((f32x4){o1[q] * F8_SO, 0.f, 0.f, 0.f}) & 0xffu); }
                else { bf16* op = AO + (tok0 + (size_t)r * (i0 + c)) * D + hq * 64 + r32; op[0] = (bf16)f2bf(o0[q]); op[32] = (bf16)f2bf(o1[q]); } }
            if (hq == 0) {
#pragma unroll
                for (int c = 0; c < 4; ++c) { const int pi = lane + 64 * c, row = pi >> 3, chunk = pi & 7;
                    if (WO_FP8) { if (chunk < 4) *(v4u*)((unsigned char*)AO + (tok0 + i0 + row) * D + 960 + 16 * chunk) = (v4u){0u, 0u, 0u, 0u}; }
                    else *(v4u*)(AO + (tok0 + i0 + row) * D + 960 + 8 * chunk) = (v4u){0u, 0u, 0u, 0u}; }
            }
        }
    }
}

__device__ __forceinline__ void final_norm_phase(const Args& a, int gw, int NGW, int lane) {
    const bf16* XR = (const bf16*)(a.ws + WS_XR); const bf16* Y1 = (const bf16*)(a.ws + WS_Y1);
    f32x4 g[4];
#pragma unroll
    for (int j = 0; j < 4; ++j) g[j] = *((const f32x4*)a.final_g + lane + 64 * j);
    for (int row0 = gw; row0 < M; row0 += 2 * NGW) {
        v2u vv[2][4], yy[2][4];
#pragma unroll
        for (int q = 0; q < 2; ++q) { const int row = row0 + q * NGW; if (row < M) { const v2u* xr = (const v2u*)(XR + (size_t)row * D) + lane; const v2u* yr = (const v2u*)(Y1 + (size_t)row * D) + lane;
#pragma unroll
            for (int j = 0; j < 4; ++j) { vv[q][j] = xr[64 * j]; yy[q][j] = yr[64 * j]; } } }
#pragma unroll
        for (int q = 0; q < 2; ++q) { const int row = row0 + q * NGW; if (row < M) { f32x4* xo = (f32x4*)(a.out + (size_t)row * D) + lane; f32x4 v[4]; float s = 0.f;
#pragma unroll
            for (int j = 0; j < 4; ++j) { v[j] = (f32x4){bflo(vv[q][j].x) + bflo(yy[q][j].x), bfhi(vv[q][j].x) + bfhi(yy[q][j].x), bflo(vv[q][j].y) + bflo(yy[q][j].y), bfhi(vv[q][j].y) + bfhi(yy[q][j].y)};
                s += (v[j].x * v[j].x + v[j].y * v[j].y) + (v[j].z * v[j].z + v[j].w * v[j].w); }
            const float rinv = 1.0f / sqrtf(wave_sum(s) * (1.0f / D) + RMS_EPS);
#pragma unroll
            for (int j = 0; j < 4; ++j) xo[64 * j] = v[j] * rinv * g[j]; } }
    }
}

constexpr int NPHASE = 15;
__global__ void __launch_bounds__(NTHR, 2) trunk_fwd(Args args) {
    extern __shared__ __attribute__((aligned(16))) unsigned char lds_raw[];
    LAS unsigned char* lds = (LAS unsigned char*)lds_raw;
    volatile LAS unsigned* MISC = (volatile LAS unsigned*)(lds + MISC_OFF);
    const int tid = threadIdx.x, lane = tid & 63, wave = __builtin_amdgcn_readfirstlane(tid >> 6);
    const int G = gridDim.x; const int bx = blockIdx.x; const int vcu = (G % 8 == 0) ? (bx % 8) * (G / 8) + bx / 8 : bx;
    const int gw = vcu * NWAVES + wave, NGW = G * NWAVES;
    unsigned char* ws = args.ws;
    unsigned* ctl = (unsigned*)(ws + WS_CTL);
    if (tid < 256) ((LAS unsigned*)(lds + LDSCTL_OFF))[tid] = 0u;
    __syncthreads();
    XcdBarrier bar; bar.bar = ctl + CW_BAR; bar.x = 0; bar.st = nullptr;
    if (!MK_PER_PHASE) bar = xcd_barrier_post(ctl + CW_BAR, MISC + 8);
    const int lo = args.ph_lo, hi = args.ph_hi;
#define IN(k) (lo <= (k) && (k) < hi)
#define SEAM(k) do { if (IN(k) && IN((k) + 1)) xcd_barrier(bar); } while (0)
#define Hb ((bf16*)(ws + WS_H))
#define MF ((const float*)(ws + WS_MODF))

#ifndef PROBE_DUP
#define PROBE_DUP 0u
#endif
#ifndef PROBE_REP
#define PROBE_REP 1
#endif
#ifndef NOPH_MASK
#define NOPH_MASK 0u
#endif
#define RUN(k, body) do { if (IN(k) && !((NOPH_MASK >> (k)) & 1u)) { body; if ((PROBE_DUP >> (k)) & 1u) { _Pragma("unroll") for (int rep_ = 0; rep_ < PROBE_REP; ++rep_) { xcd_barrier(bar); body; } } } SEAM(k); } while (0)
#define COMMA ,
#define PH_GEMM(EPI, ORD, Aptr, Bptr, Mv, Nv, Kv, ...) do { pg8::Gemm g{Aptr, Bptr, Mv, Nv, Kv}; pg8::StaticOrder S; S.init(Mv, Nv, G, bx); EPI E{__VA_ARGS__}; \
        pg8::gemm_phase<EPI, pg8::StaticOrder, true, true>(lds, g, S, E); } while (0)
#define MOE_GU() do { pg8::MoeOrder S; S.init(ctl + CW_CNT, 2 * FF / 256, G, bx, (const int*)(ws + WS_RT2)); \
        pg8::Gemm g{Hb, (const bf16*)(ws + WS_WMGU), 0, 0, D}; EpiSwiGLU8 E{ws + WS_MHID, 2 * FF / 256}; \
        pg8::gemm_phase<EpiSwiGLU8, pg8::MoeOrder, true, true, true, 1, (MOE_I8 != 0)>(lds, g, S, E, lds + TOKSLOT_OFF); } while (0)
#define ZGp ((const float*)(ws + WS_ZG))
#define MOE_DN() do { pg8::MoeOrderId S; S.init(ctl + CW_CNT, D / 256, G, bx, (const int*)(ws + WS_IDENT), true); \
        LAS float* gt = (LAS float*)(lds + GATE_OFF); for (int i_ = tid; i_ < NB * D; i_ += NTHR) gt[i_] = MF[(size_t)(3 * 4 + (i_ >> 10)) * 3072 + 2048 + (i_ & (D - 1))]; __syncthreads(); \
        pg8::Gemm g{(const bf16*)(ws + WS_MHID), (const bf16*)(ws + WS_WMD), 0, 0, FF}; \
        EpiMoeDown E{XRp, (bf16*)(ws + WS_Y1), (const int*)(ws + WS_RT2), (const float*)(ws + WS_RW2), gt, 1.0f / (F8_SH * F8_SW), lds + RED_OFF}; \
        pg8::gemm_phase<EpiMoeDown, pg8::MoeOrderId, true, true, true, 1>(lds, g, S, E, lds + TOKSLOT_OFF); } while (0)
#define PH_GEMM8(EPI, I8v, Aptr, Bptr, Mv, Nv, Kv, ...) do { pg8::Gemm g{Aptr, Bptr, Mv, Nv, Kv}; pg8::StaticOrder S; S.init(Mv, Nv, G, bx, (const int*)(ws + WS_IDENT)); EPI E{__VA_ARGS__}; \
        pg8::gemm_phase<EPI, pg8::StaticOrder, true, true, true, 1, I8v>(lds, g, S, E, lds + TOKSLOT_OFF); } while (0)
#define SSb ((float*)(ws + WS_SS))
#define BV ((const float*)(ws + WS_BIASV))
    RUN(0, p0_prologue(args, lds, gw, NGW, wave, lane, tid));
    RUN(1, (norm_phase<true, false, false, (CONVIN_I8 != 0)>(args, args.x, 0, lds, G, wave, lane, tid)));
#if CONVIN_I8
    RUN(2, PH_GEMM8(EpiConvInT<true>, true, Hb, (const bf16*)(ws + WS_WCIN), M, 3072, D, (bf16*)(ws + WS_V), (bf16*)(ws + WS_BG)));
#else
    RUN(2, PH_GEMM(EpiConvIn, 0, Hb, (const bf16*)(ws + WS_WCIN), M, 3072, D, (bf16*)(ws + WS_V), (bf16*)(ws + WS_BG)));
#endif
#ifdef PROBE_NULLGEMM_K
    if (IN(2)) { xcd_barrier(bar); PH_GEMM(EpiNull, 0, Hb, (const bf16*)(ws + WS_WCIN), M, PROBE_NULLGEMM_N, PROBE_NULLGEMM_K); xcd_barrier(bar); }
#endif
    RUN(3, { conv_phase(args, G, tid); bias_gemv(args, gw, NGW, lane); });
#define XRp ((bf16*)(ws + WS_XR))
#define XB4p ((bf16*)args.out)
#if WOUT_FP8
    RUN(4, PH_GEMM8(EpiResidB<false COMMA true COMMA (DENSE_GU_FP8 != 0)>, false, Hb, (const bf16*)(ws + WS_WCOUT), M, D, D, XRp, XRp, MF + 0 * 4 * 3072 + 2048, XB4p, SSb, MF + 1 * 4 * 3072 + 1024, args.norm_g + 1 * D, (LAS float*)(lds + RED_OFF), 1.0f / (F8_SH * F8_SW)));
#else
    RUN(4, PH_GEMM(EpiResidB<false COMMA true COMMA (DENSE_GU_FP8 != 0)>, 0, Hb, (const bf16*)(ws + WS_WCOUT), M, D, D, XRp, XRp, MF + 0 * 4 * 3072 + 2048, XB4p, SSb, MF + 1 * 4 * 3072 + 1024, args.norm_g + 1 * D, (LAS float*)(lds + RED_OFF), 1.0f));
#endif
#if DENSE_GU_FP8
    RUN(5, PH_GEMM8(EpiSwiGLU<true COMMA true COMMA (DENSE_DOWN_FP8 != 0)>, (GU_I8 != 0), XB4p, (const bf16*)(ws + WS_WFGU), M, 2 * FF, D, (bf16*)(ws + WS_HID), 2 * FF / 256, SSb, BV, lds + GATE_OFF));
#else
    RUN(5, PH_GEMM(EpiSwiGLU<true COMMA false COMMA (DENSE_DOWN_FP8 != 0)>, 0, XB4p, (const bf16*)(ws + WS_WFGU), M, 2 * FF, D, (bf16*)(ws + WS_HID), 2 * FF / 256, SSb, BV, lds + GATE_OFF));
#endif
#if DENSE_DOWN_FP8
    RUN(6, PH_GEMM8(EpiResidB<false COMMA true COMMA (QKV_I8 != 0)>, false, (const bf16*)(ws + WS_HID), (const bf16*)(ws + WS_WFD), M, D, FF, XRp, XRp, MF + 1 * 4 * 3072 + 2048, Hb, SSb, MF + 2 * 4 * 3072 + 1024, args.norm_g + 2 * D, (LAS float*)(lds + RED_OFF), 1.0f / (F8_SH * F8_SW)));
#else
    RUN(6, PH_GEMM(EpiResidB<false COMMA true>, 0, (const bf16*)(ws + WS_HID), (const bf16*)(ws + WS_WFD), M, D, FF, XRp, XRp, MF + 1 * 4 * 3072 + 2048, Hb, SSb, MF + 2 * 4 * 3072 + 1024, args.norm_g + 2 * D, (LAS float*)(lds + RED_OFF), 1.0f));
#endif
#if QKV_I8
    RUN(7, PH_GEMM8(EpiQkvRopeT<true>, true, Hb, (const bf16*)(ws + WS_WQKV), M, QKVP, D, (bf16*)(ws + WS_QKV), (const unsigned*)(ws + WS_ROPE), SSb, BV + 4 * 2 * FF, lds + GATE_OFF));
#else
    RUN(7, PH_GEMM(EpiQkvRope, 0, Hb, (const bf16*)(ws + WS_WQKV), M, QKVP, D, (bf16*)(ws + WS_QKV), (const unsigned*)(ws + WS_ROPE), SSb, BV + 4 * 2 * FF, lds + GATE_OFF));
#endif
    RUN(8, attn_mfma<0>(args, lds, gw, NGW, wave, lane));
    RUN(9, attn_mfma<1>(args, lds, gw, NGW, wave, lane));
#if WO_FP8
    RUN(10, PH_GEMM8(EpiResidB<false COMMA false>, false, Hb, (const bf16*)(ws + WS_WO), M, D, D, XRp, XRp, MF + 2 * 4 * 3072 + 2048, nullptr, nullptr, nullptr, nullptr, nullptr, 1.0f / (F8_SO * F8_SW)));
#else
    RUN(10, PH_GEMM(EpiResidB<false COMMA false>, 0, Hb, (const bf16*)(ws + WS_WO), M, D, D, XRp, XRp, MF + 2 * 4 * 3072 + 2048, nullptr, nullptr, nullptr, nullptr, nullptr, 1.0f));
#endif
    RUN(11, (norm_phase<false, true, true>(args, XRp, 3, lds, G, wave, lane, tid)));
    RUN(12, MOE_GU());
    RUN(13, MOE_DN());
    RUN(14, final_norm_phase(args, gw, NGW, lane));
#ifdef PROBE_XBAR
    for (int q = 0; q < PROBE_XBAR; ++q) xcd_barrier(bar);
#endif
#undef IN
#undef SEAM
}

extern "C" void kernel_launch(void* const* d_in, const int* in_sizes, int n_in, void* d_out, int out_size, void* d_ws, size_t ws_size, hipStream_t stream) {
    static int grid = 0;
    if (grid == 0) {
        if (n_in != 19 || out_size != M * D || ws_size < WS_END) { fprintf(stderr, "kernel_launch: unexpected shapes (n_in %d out %d ws %zu)\n", n_in, out_size, ws_size); grid = -1; return; }
        int dev = 0, cus = 0, per_cu = 0;
        if (hipGetDevice(&dev) != hipSuccess || hipDeviceGetAttribute(&cus, hipDeviceAttributeMultiprocessorCount, dev) != hipSuccess) { grid = -1; return; }
        if (hipFuncSetAttribute((const void*)trunk_fwd, hipFuncAttributeMaxDynamicSharedMemorySize, LDS_BYTES) != hipSuccess) { fprintf(stderr, "kernel_launch: hipFuncSetAttribute failed\n"); grid = -1; return; }
        if (hipOccupancyMaxActiveBlocksPerMultiprocessor(&per_cu, (const void*)trunk_fwd, NTHR, LDS_BYTES) != hipSuccess || per_cu < 1) fprintf(stderr, "kernel_launch: occupancy query reports %d\n", per_cu);
        (void)hipGetLastError();
        grid = cus;
    }
    if (grid < 0) return;
    (void)hipMemsetAsync((char*)d_ws + WS_CTL, 0, CTL_ZERO_BYTES, stream);
    Args a{};
    a.x = (const float*)d_in[0]; a.c = (const float*)d_in[1]; a.pos = (const int*)d_in[2]; a.mod_w = (const float*)d_in[3]; a.mod_b = (const float*)d_in[4]; a.norm_g = (const float*)d_in[5];
    a.conv_w_in = (const float*)d_in[6]; a.conv_w = (const float*)d_in[7]; a.conv_w_out = (const float*)d_in[8]; a.ffn_g = (const float*)d_in[9]; a.ffn_u = (const float*)d_in[10]; a.ffn_d = (const float*)d_in[11];
    a.w_qkv = (const float*)d_in[12]; a.w_o = (const float*)d_in[13]; a.router_w = (const float*)d_in[14]; a.moe_g = (const float*)d_in[15]; a.moe_u = (const float*)d_in[16]; a.moe_d = (const float*)d_in[17]; a.final_g = (const float*)d_in[18];
    a.out = (float*)d_out; a.ws = (unsigned char*)d_ws;
#if MK_PER_PHASE
    for (int p = 0; p < NPHASE; ++p) { a.ph_lo = p; a.ph_hi = p + 1; hipLaunchKernelGGL(trunk_fwd, dim3(grid), dim3(NTHR), LDS_BYTES, stream, a); }
#else
    a.ph_lo = 0; a.ph_hi = NPHASE; hipLaunchKernelGGL(trunk_fwd, dim3(grid), dim3(NTHR), LDS_BYTES, stream, a);
#endif
}
```

```cpp
#include <hip/hip_runtime.h>
#include <cstdio>
#include <cstdint>

#ifndef DENSE_GU_FP8
#define DENSE_GU_FP8 1
#endif
#ifndef MOE_I8
#define MOE_I8 0
#endif
#ifndef GU_I8
#define GU_I8 1
#endif
#ifndef CONVIN_I8
#define CONVIN_I8 0
#endif
#ifndef QKV_I8
#define QKV_I8 1
#endif
#ifndef WO_FP8
#define WO_FP8 1
#endif
#ifndef WOUT_FP8
#define WOUT_FP8 0
#endif
#ifndef DENSE_DOWN_FP8
#define DENSE_DOWN_FP8 1
#endif
#ifndef MK_PER_PHASE
#define MK_PER_PHASE 0
#endif

namespace pg8 {
#define PG8_LAS __attribute__((address_space(3)))
typedef unsigned short bf16_t;
typedef short bf16x8 __attribute__((ext_vector_type(8)));
typedef float f32x4 __attribute__((ext_vector_type(4)));
typedef unsigned u32x4 __attribute__((ext_vector_type(4)));
constexpr int BM = 256, BK = 64, HALF = 128, HTB = HALF * BK * 2, STAGE_BYTES = 8 * HTB, NXCD = 8, WGM = 8;

__host__ __device__ __forceinline__ int lds_byte(int r, int c) { const int st = (r >> 4) * 2 + (c >> 5), rr = r & 15, cc = c & 31, ob = rr * 64 + cc * 2; return st * 1024 + (ob ^ (((ob >> 9) & 1) << 5)); }
__host__ __device__ __forceinline__ void stage_rc(int b, int& R, int& C) { const int st = b / 1024, sb = b % 1024, swz = sb ^ (((sb >> 9) & 1) << 5); R = (st >> 1) * 16 + swz / 64; C = (st & 1) * 32 + (swz % 64) / 2; }
__host__ __device__ __forceinline__ int perm32(int rho) { const int n = rho >> 4, i = rho & 15; return 8 * (i >> 2) + 4 * n + (i & 3); }

struct Unit { int pm, pn, k, nv, g, sp; };
struct Gemm { const bf16_t* A; const bf16_t* Bt; int M, N, K; };

struct StaticOrder {
    static constexpr bool IDROWS = true;
    int nM, nN, nwg, G, c; const int* ident;
    __host__ __device__ void init(int M, int N, int G_, int c_, const int* id = nullptr) { nM = M / BM; nN = N / BM; nwg = nM * nN; G = G_; c = c_; ident = id; }
    __host__ __device__ bool next(int i, Unit& u) const {
        const long L = (long)i * G + c; if (L >= nwg) return false;
        int wgid = (int)L; { const int q = nwg / NXCD, r = nwg % NXCD, xcd = wgid % NXCD, off = wgid / NXCD; wgid = (xcd < r ? xcd * (q + 1) : r * (q + 1) + (xcd - r) * q) + off; }
        const int nig = WGM * nN, gid = wgid / nig, fm = gid * WGM, gsz = (nM - fm) < WGM ? (nM - fm) : WGM;
        u.pm = fm + ((wgid % nig) % gsz); u.pn = (wgid % nig) / gsz; u.nv = 256; return true;
    }
    __device__ __forceinline__ const int* tokens(const Unit& u) const { return ident + 256 * u.pm; }
    __device__ __forceinline__ void a_ready(const Unit&) const {}
    __device__ __forceinline__ void done(const Unit&) const {}
};
struct RepeatOrder : StaticOrder { int nrep;
    __host__ __device__ bool next(int i, Unit& u) const { if (i >= nrep) return false; return StaticOrder::next(0, u); } };
template <bool IDENT> struct MoeOrderT {
    static constexpr bool IDROWS = IDENT;
    int nM, nN, nwg, G, c; int nt[16]; const int* rowtok; bool ident;
    static constexpr int MTOK = 32768;
    __device__ __forceinline__ void init(unsigned* cnt, int nN_, int G_, int c_, const int* rt, bool ident_ = false) {
        ident = ident_;
        int b = 0;
#pragma unroll
        for (int q = 0; q < 16; ++q) { const int ne = __builtin_amdgcn_readfirstlane((int)__hip_atomic_load(cnt + q, __ATOMIC_RELAXED, __HIP_MEMORY_SCOPE_AGENT)); nt[q] = ne | (b << 16); b += (ne + 255) >> 8; }
        nM = b; nN = nN_; nwg = nM * nN; G = G_; c = c_; rowtok = rt;
    }
    __device__ __forceinline__ bool next(int i, Unit& u) const {
        const long L = (long)i * G + c; if (L >= nwg) return false;
        int wgid = (int)L; { const int q = nwg / NXCD, r = nwg % NXCD, xcd = wgid % NXCD, off = wgid / NXCD; wgid = (xcd < r ? xcd * (q + 1) : r * (q + 1) + (xcd - r) * q) + off; }
        const int nig = WGM * nN, gid = wgid / nig, fm = gid * WGM, gsz = (nM - fm) < WGM ? (nM - fm) : WGM;
        const int pm = fm + ((wgid % nig) % gsz), pn = (wgid % nig) / gsz;
        int q0 = 0, sel = nt[0];
#pragma unroll
        for (int q = 1; q < 16; ++q) if (pm >= (nt[q] >> 16)) { q0 = q; sel = nt[q]; }
        u.pm = pm; u.pn = (q0 & 7) * nN + pn; u.g = q0; u.k = pm - (sel >> 16); const int rem = (sel & 0xffff) - 256 * u.k; u.nv = rem < 256 ? rem : 256; return true;
    }
    __device__ __forceinline__ const int* tokens(const Unit& u) const { return ident ? rowtok + 256 * u.pm : rowtok + (size_t)u.g * MTOK + 256 * u.k; }
    __device__ __forceinline__ void a_ready(const Unit&) const {}
    __device__ __forceinline__ void done(const Unit&) const {}
};
typedef MoeOrderT<false> MoeOrder; typedef MoeOrderT<true> MoeOrderId;

typedef int v8i_t __attribute__((ext_vector_type(8)));
typedef int v4i_t __attribute__((ext_vector_type(4)));
__device__ __forceinline__ v8i_t cat8(bf16x8 a, bf16x8 b) { const v4i_t x = __builtin_bit_cast(v4i_t, a), y = __builtin_bit_cast(v4i_t, b); return __builtin_shufflevector(x, y, 0, 1, 2, 3, 4, 5, 6, 7); }
__device__ __forceinline__ unsigned cvt_pk_bf16(float lo, float hi) { unsigned r; asm volatile("v_cvt_pk_bf16_f32 %0, %1, %2" : "=v"(r) : "v"(lo), "v"(hi)); return r; }

template <class Epi, class Sched, bool ALIGN_EPI = false, bool SP2 = false, bool GATHER = false, int ES = 2, bool I8 = false>
__device__ __forceinline__ void gemm_phase(PG8_LAS unsigned char* lds, const Gemm g, const Sched& S, const Epi& E, PG8_LAS unsigned char* tokslots = nullptr) {
    const int tid = threadIdx.x, wid = __builtin_amdgcn_readfirstlane(tid >> 6), lane = tid & 63, wr = wid >> 2, wc = wid & 3, fr = lane & 15, fq = lane >> 4;
    const int K = g.K, KB = K * ES  , nt = KB / (BK * 2);
    static_assert(!GATHER || SP2, "the gathering A path is written for the SP2 loop only");
    unsigned voffA[2], voffB[2];
#pragma unroll
    for (int i = 0; i < 2; ++i) { int R, C; stage_rc(tid * 16 + i * 8192, R, C); const int Rb = Epi::PERM ? ((R & ~31) + perm32(R & 31)) : R;
        voffA[i] = (unsigned)(R * KB + C * 2); voffB[i] = (unsigned)(Rb * KB + C * 2); }
    unsigned gcur[2][2] = {{0u, 0u}, {0u, 0u}};
    const size_t kstep = (size_t)(BK * 2);
    const size_t hstep = (size_t)HALF * KB;
    const size_t tstep = 2 * hstep;
    const unsigned ldsw = (unsigned)wid * 1024u;
    const int aoff = lds_byte(wr * 64 + fr, fq * 8), boff = lds_byte(wc * 32 + fr, fq * 8);
#define PG8_SA(b, h) (((b) * 2 + (h)) * HTB)
#define PG8_SB(b, h) ((4 + (b) * 2 + (h)) * HTB)
#define PG8_STAGE(bufoff, gbase, voff) do { _Pragma("unroll") for (int _i = 0; _i < 2; ++_i) \
        __builtin_amdgcn_global_load_lds((const unsigned*)((const char*)(gbase) + (voff)[_i]), (PG8_LAS unsigned*)(lds + (bufoff) + ldsw + _i * 8192), 16, 0, 0); } while (0)
#define PG8_STAGE_A(bufoff, kptr, half, ofs) do { if constexpr (GATHER) { _Pragma("unroll") for (int _i = 0; _i < 2; ++_i) \
        __builtin_amdgcn_global_load_lds((const unsigned*)((const char*)(kptr) + (ofs)[half][_i]), (PG8_LAS unsigned*)(lds + (bufoff) + ldsw + _i * 8192), 16, 0, 0); } \
        else { PG8_STAGE(bufoff, (const char*)(kptr) + (half) * hstep, voffA); } } while (0)
#define PG8_LDA(dst, b, h) do { _Pragma("unroll") for (int m = 0; m < 4; ++m) _Pragma("unroll") for (int k = 0; k < 2; ++k) dst[m][k] = *(const PG8_LAS bf16x8*)(lds + PG8_SA(b, h) + aoff + m * 2048 + k * 1024); } while (0)
#define PG8_LDB(dst, b, h) do { _Pragma("unroll") for (int n = 0; n < 2; ++n) _Pragma("unroll") for (int k = 0; k < 2; ++k) dst[n][k] = *(const PG8_LAS bf16x8*)(lds + PG8_SB(b, h) + boff + n * 2048 + k * 1024); } while (0)
#define PG8_MMA(ai, bj, At, Bt) do { __builtin_amdgcn_s_setprio(1); _Pragma("unroll") for (int m = 0; m < 4; ++m) _Pragma("unroll") for (int n = 0; n < 2; ++n) { \
        if constexpr (ES == 2) { _Pragma("unroll") for (int k = 0; k < 2; ++k) acc[ai][bj][m][n] = __builtin_amdgcn_mfma_f32_16x16x32_bf16(Bt[n][k], At[m][k], acc[ai][bj][m][n], 0, 0, 0); } \
        else if constexpr (I8) { _Pragma("unroll") for (int k = 0; k < 2; ++k) acc[ai][bj][m][n] = __builtin_bit_cast(f32x4, __builtin_amdgcn_mfma_i32_16x16x64_i8(__builtin_bit_cast(v4i_t, Bt[n][k]), __builtin_bit_cast(v4i_t, At[m][k]), __builtin_bit_cast(v4i_t, acc[ai][bj][m][n]), 0, 0, 0)); } \
        else { acc[ai][bj][m][n] = __builtin_amdgcn_mfma_scale_f32_16x16x128_f8f6f4(cat8(Bt[n][0], Bt[n][1]), cat8(At[m][0], At[m][1]), acc[ai][bj][m][n], 0, 0, 0, 0x7f7f7f7f, 0, 0x7f7f7f7f); } } \
        __builtin_amdgcn_s_setprio(0); } while (0)
#define PG8_WAIT_V(n) asm volatile("s_waitcnt vmcnt(" #n ")" ::: "memory")
#define PG8_WAIT_L(n) asm volatile("s_waitcnt lgkmcnt(" #n ")" ::: "memory")
#define PG8_BAR __builtin_amdgcn_s_barrier()
#define PG8_SCHED __builtin_amdgcn_sched_barrier(0)
    Unit cur, nxt; int ui = 0;
    if (!S.next(0, cur)) return;
    f32x4 acc[2][2][4][2];
#pragma unroll
    for (int a = 0; a < 2; ++a)
#pragma unroll
        for (int b = 0; b < 2; ++b)
#pragma unroll
            for (int m = 0; m < 4; ++m)
#pragma unroll
                for (int n = 0; n < 2; ++n) acc[a][b][m][n] = (f32x4){0.f, 0.f, 0.f, 0.f};
    bf16x8 At[4][2], B0[2][2], B1[2][2];
    const char* cA = GATHER ? (const char*)g.A : (const char*)g.A + (size_t)cur.pm * tstep; const char* cB = (const char*)g.Bt + (size_t)cur.pn * tstep;
    if constexpr (GATHER) { const int* tk = S.tokens(cur);
#pragma unroll
        for (int h = 0; h < 2; ++h)
#pragma unroll
            for (int i = 0; i < 2; ++i) { int R, C; stage_rc(tid * 16 + i * 8192, R, C); const int rl = h * HALF + R; int tok;
                if constexpr (Sched::IDROWS) tok = rl < cur.nv ? 256 * cur.pm + rl : 0; else tok = rl < cur.nv ? tk[rl] : 0;
                gcur[h][i] = (unsigned)tok * (unsigned)KB + (unsigned)C * 2u; } }
    S.a_ready(cur);
    if constexpr (SP2) {
        PG8_STAGE(PG8_SB(0, 0), cB, voffB); PG8_STAGE(PG8_SB(0, 1), cB + hstep, voffB); PG8_STAGE_A(PG8_SA(0, 0), cA, 0, gcur); PG8_STAGE_A(PG8_SA(0, 1), cA, 1, gcur);
        PG8_STAGE(PG8_SB(1, 0), cB + kstep, voffB); PG8_STAGE_A(PG8_SA(1, 0), cA + kstep, 0, gcur); PG8_STAGE(PG8_SB(1, 1), cB + hstep + kstep, voffB);
        if (wr == 1) PG8_BAR;
        PG8_WAIT_V(8); PG8_BAR;
        PG8_WAIT_V(6); PG8_BAR;
    } else {
        PG8_STAGE(PG8_SB(0, 0), cB, voffB); PG8_STAGE_A(PG8_SA(0, 0), cA, 0, gcur); PG8_STAGE(PG8_SB(0, 1), cB + hstep, voffB); PG8_STAGE_A(PG8_SA(0, 1), cA, 1, gcur);
        if (wr == 1) PG8_BAR;
        PG8_WAIT_V(4); PG8_BAR;
        PG8_STAGE(PG8_SB(1, 0), cB + kstep, voffB); PG8_STAGE_A(PG8_SA(1, 0), cA + kstep, 0, gcur); PG8_STAGE(PG8_SB(1, 1), cB + hstep + kstep, voffB);
        PG8_WAIT_V(6); PG8_BAR;
    }
    for (;;) {
        cur.sp = ui & 1;
        if constexpr (Epi::SIDE) E.side_issue(cur, wid, lane);
        const bool has_next = S.next(ui + 1, nxt);
        const char* nA = GATHER ? cA : (has_next ? (const char*)g.A + (size_t)nxt.pm * tstep : cA); const char* nB = has_next ? (const char*)g.Bt + (size_t)nxt.pn * tstep : cB;
        if constexpr (GATHER && !Sched::IDROWS) { if (has_next && wid < 4)
            __builtin_amdgcn_global_load_lds((const unsigned*)(S.tokens(nxt) + wid * 64 + lane), (PG8_LAS unsigned*)(tokslots + ((ui + 1) & 1) * 1024 + wid * 256), 4, 0, 0); }
#pragma unroll 1
        for (int t = 0; t < nt; t += 2) {
            const bool last = (t == nt - 2);
            const char* a1 = cA + (size_t)(t + 1) * kstep;
            const char* a2 = last ? nA : cA + (size_t)(t + 2) * kstep; const char* b2 = last ? nB : cB + (size_t)(t + 2) * kstep;
            const char* a3 = a2 + kstep; const char* b3 = b2 + kstep;
            if (last && has_next) S.a_ready(nxt);
            if constexpr (SP2) {
            PG8_LDB(B0, 0, 0); PG8_LDB(B1, 0, 1); PG8_SCHED; PG8_LDA(At, 0, 0); PG8_STAGE_A(PG8_SA(1, 1), a1, 1, gcur);
            if constexpr (GATHER) { if (last && has_next) {
#pragma unroll
                for (int h = 0; h < 2; ++h)
#pragma unroll
                    for (int i = 0; i < 2; ++i) { int R, C; stage_rc(tid * 16 + i * 8192, R, C); const int rl = h * HALF + R; int tok; if constexpr (Sched::IDROWS) tok = 256 * nxt.pm + rl; else tok = *(const PG8_LAS int*)(tokslots + ((ui + 1) & 1) * 1024 + rl * 4);
                        gcur[h][i] = (unsigned)(rl < nxt.nv ? tok : 0) * (unsigned)KB + (unsigned)C * 2u; } } }
            PG8_WAIT_V(8); PG8_WAIT_L(0); PG8_BAR; PG8_MMA(0, 0, At, B0); PG8_MMA(0, 1, At, B1); PG8_BAR; PG8_SCHED;
            PG8_LDA(At, 0, 1); PG8_STAGE(PG8_SB(0, 0), b2, voffB); PG8_STAGE(PG8_SB(0, 1), b2 + hstep, voffB); PG8_STAGE_A(PG8_SA(0, 0), a2, 0, gcur);
            PG8_WAIT_V(8); PG8_WAIT_L(0); PG8_BAR; PG8_MMA(1, 0, At, B0); PG8_MMA(1, 1, At, B1); PG8_BAR; PG8_SCHED;
            PG8_LDB(B0, 1, 0); PG8_LDB(B1, 1, 1); PG8_SCHED; PG8_LDA(At, 1, 0); PG8_STAGE_A(PG8_SA(0, 1), a2, 1, gcur);
            PG8_WAIT_V(8); PG8_WAIT_L(0); PG8_BAR; PG8_MMA(0, 0, At, B0); PG8_MMA(0, 1, At, B1); PG8_BAR; PG8_SCHED;
            PG8_LDA(At, 1, 1); PG8_STAGE(PG8_SB(1, 0), b3, voffB); PG8_STAGE(PG8_SB(1, 1), b3 + hstep, voffB); PG8_STAGE_A(PG8_SA(1, 0), a3, 0, gcur);
            PG8_WAIT_V(8); PG8_WAIT_L(0); PG8_BAR; PG8_MMA(1, 0, At, B0); PG8_MMA(1, 1, At, B1); PG8_BAR; PG8_SCHED;
            } else {
            PG8_LDB(B0, 0, 0); PG8_SCHED; PG8_LDA(At, 0, 0); PG8_STAGE_A(PG8_SA(1, 1), a1, 1, gcur);
            PG8_WAIT_L(8); PG8_BAR; PG8_WAIT_L(0); PG8_MMA(0, 0, At, B0); PG8_BAR; PG8_SCHED;
            PG8_LDB(B1, 0, 1); PG8_STAGE(PG8_SB(0, 0), b2, voffB);
            PG8_BAR; PG8_WAIT_L(0); PG8_MMA(0, 1, At, B1); PG8_BAR;
            PG8_LDA(At, 0, 1); PG8_STAGE_A(PG8_SA(0, 0), a2, 0, gcur);
            PG8_BAR; PG8_WAIT_L(0); PG8_MMA(1, 0, At, B0); PG8_BAR; PG8_SCHED;
            PG8_STAGE(PG8_SB(0, 1), b2 + hstep, voffB);
            PG8_WAIT_V(6); PG8_BAR; PG8_MMA(1, 1, At, B1); PG8_BAR;
            PG8_LDB(B0, 1, 0); PG8_SCHED; PG8_LDA(At, 1, 0); PG8_STAGE_A(PG8_SA(0, 1), a2, 1, gcur);
            PG8_WAIT_L(8); PG8_BAR; PG8_WAIT_L(0); PG8_MMA(0, 0, At, B0); PG8_BAR; PG8_SCHED;
            PG8_LDB(B1, 1, 1); PG8_STAGE(PG8_SB(1, 0), b3, voffB);
            PG8_BAR; PG8_WAIT_L(0); PG8_MMA(0, 1, At, B1); PG8_BAR;
            PG8_LDA(At, 1, 1); PG8_STAGE_A(PG8_SA(1, 0), a3, 0, gcur);
            PG8_BAR; PG8_WAIT_L(0); PG8_MMA(1, 0, At, B0); PG8_BAR; PG8_SCHED;
            PG8_STAGE(PG8_SB(1, 1), b3 + hstep, voffB);
            PG8_WAIT_V(6); PG8_BAR; PG8_MMA(1, 1, At, B1); PG8_BAR;
            }
        }
        if constexpr (ALIGN_EPI) { if (wr == 0) PG8_BAR; }
        E(acc, cur, wr, wc, fr, fq); S.done(cur);
        if (!has_next) break;
#pragma unroll
        for (int a = 0; a < 2; ++a)
#pragma unroll
            for (int b = 0; b < 2; ++b)
#pragma unroll
                for (int m = 0; m < 4; ++m)
#pragma unroll
                    for (int n = 0; n < 2; ++n) acc[a][b][m][n] = (f32x4){0.f, 0.f, 0.f, 0.f};
        cur = nxt; cA = nA; cB = nB; ++ui;

        if constexpr (ALIGN_EPI) { if (wr == 1) PG8_BAR; }
    }
    PG8_WAIT_V(0);
    if constexpr (!ALIGN_EPI) { if (wr == 0) PG8_BAR; }
    PG8_BAR;
#undef PG8_SA
#undef PG8_SB
#undef PG8_STAGE
#undef PG8_STAGE_A
#undef PG8_LDA
#undef PG8_LDB
#undef PG8_MMA
#undef PG8_WAIT_V
#undef PG8_WAIT_L
#undef PG8_BAR
#undef PG8_SCHED
}
}

constexpr int NWAVES = 8, NTHR = NWAVES * 64;
constexpr int NB = 4, SEQ = 8192, D = 1024, M = NB * SEQ;
constexpr int FF = 2816, NE = 8;
constexpr int NH = 15, NHQKV = 45, QKVP = 3072;
constexpr int RPAD = M + NE * 256;
constexpr int NCHUNK = M / 128;
constexpr float RMS_EPS = 1e-6f;
constexpr float I8_SA = 127.f / 8.f, I8_SW = 127.f * 32.f / 5.f;
constexpr float GU_SA = GU_I8 ? I8_SA : 16.f, GU_SW = GU_I8 ? I8_SW : 128.f;
constexpr float MOE_SA = MOE_I8 ? I8_SA : 16.f, MOE_SW = MOE_I8 ? I8_SW : 128.f;
constexpr float F8_SO = 32.f;
constexpr float F8_SA = 16.f, F8_SW = 128.f, F8_SH = 8.f;
constexpr float C2 = 0.125f * 1.4426950408889634f;

constexpr size_t MiB = 1u << 20;
constexpr size_t WS_CTL = 0, CTL_ZERO_BYTES = 64 * 1024;
constexpr size_t WS_MODP = 1 * MiB;
constexpr size_t WS_MODF = 3 * MiB;
constexpr size_t WS_IDENT = 4 * MiB + 512 * 1024;
constexpr size_t WS_ZG = WS_MODF + 256 * 1024;
constexpr size_t WS_SS = 4 * MiB;
constexpr size_t WS_BIASV = 5 * MiB;
constexpr size_t WS_XR = 448 * MiB;
constexpr size_t WS_ROPE = 6 * MiB;
constexpr size_t WS_LSE = 14 * MiB;
constexpr size_t WS_WCIN = 16 * MiB, WS_WCOUT = 22 * MiB, WS_WFGU = 24 * MiB, WS_WFD = 35 * MiB, WS_WQKV = 41 * MiB, WS_WO = 47 * MiB, WS_WMGU = 49 * MiB, WS_WMD = 137 * MiB;
constexpr size_t WS_H = 181 * MiB;
constexpr size_t WS_BIG = 245 * MiB;
constexpr size_t WS_BG = WS_BIG, WS_V = WS_BIG + 64 * MiB;
constexpr size_t WS_HID = WS_BIG;
constexpr size_t WS_QKV = WS_BIG;
constexpr size_t WS_RT2 = 10 * MiB, WS_RW2 = 12 * MiB;
constexpr size_t WS_MHID = WS_BIG;
constexpr size_t WS_Y1 = WS_H;
constexpr size_t WS_END = 512 * MiB;
static_assert(WS_MHID + (size_t)2 * RPAD * FF <= WS_XR && WS_QKV + (size_t)M * QKVP * 2 <= WS_XR && WS_HID + (size_t)M * FF * 2 <= WS_XR && WS_XR + (size_t)M * D * 2 <= WS_END, "d_ws map");
static_assert(WS_WMD + (size_t)NE * D * FF * 2 <= WS_H && WS_H + (size_t)M * D * 2 <= WS_BIG, "d_ws map 2");
constexpr int CW_XMAP = 8320;
constexpr int CW_CNT = 8192;
constexpr int CW_BAR = 4096;

constexpr int RING_BYTES = 131072;
constexpr int LDSCTL_OFF = RING_BYTES, MISC_OFF = LDSCTL_OFF + 320;
constexpr int RED_OFF = LDSCTL_OFF + 4096;
constexpr int TOKSLOT_OFF = LDSCTL_OFF + 1024;
constexpr int GATE_OFF = LDSCTL_OFF + 8192;
constexpr int LDS_BYTES = 155648;

#define GAS __attribute__((address_space(1)))
#define LAS __attribute__((address_space(3)))
typedef unsigned short bf16;
typedef unsigned v4u __attribute__((ext_vector_type(4)));
typedef unsigned v2u __attribute__((ext_vector_type(2)));
typedef float f32x4 __attribute__((ext_vector_type(4)));
#define LDS_WAIT() asm volatile("s_waitcnt lgkmcnt(0)" ::: "memory")
__device__ __forceinline__ unsigned f2bf(float f) { unsigned u = __builtin_bit_cast(unsigned, f); return (u + 0x7fffu + ((u >> 16) & 1u)) >> 16; }
__device__ __forceinline__ unsigned pk2(float lo, float hi) { return f2bf(lo) | (f2bf(hi) << 16); }
__device__ __forceinline__ float bflo(unsigned u) { return __builtin_bit_cast(float, u << 16); }
__device__ __forceinline__ float bfhi(unsigned u) { return __builtin_bit_cast(float, u & 0xffff0000u); }

__device__ __forceinline__ unsigned pk_fp8x4(f32x4 v) {
    const float a = __builtin_amdgcn_fmed3f(v.x, -448.f, 448.f), b = __builtin_amdgcn_fmed3f(v.y, -448.f, 448.f), c = __builtin_amdgcn_fmed3f(v.z, -448.f, 448.f), d = __builtin_amdgcn_fmed3f(v.w, -448.f, 448.f);
    int p = __builtin_amdgcn_cvt_pk_fp8_f32(a, b, 0, false); p = __builtin_amdgcn_cvt_pk_fp8_f32(c, d, p, true); return (unsigned)p; }
__device__ __forceinline__ unsigned pk_i8x4(f32x4 v) {
    const float mg = 12582912.0f;
    const unsigned a = __builtin_bit_cast(unsigned, __builtin_amdgcn_fmed3f(v.x, -127.f, 127.f) + mg), b = __builtin_bit_cast(unsigned, __builtin_amdgcn_fmed3f(v.y, -127.f, 127.f) + mg);
    const unsigned c = __builtin_bit_cast(unsigned, __builtin_amdgcn_fmed3f(v.z, -127.f, 127.f) + mg), d = __builtin_bit_cast(unsigned, __builtin_amdgcn_fmed3f(v.w, -127.f, 127.f) + mg);
    return __builtin_amdgcn_perm(__builtin_amdgcn_perm(d, c, 0x0c0c0400u), __builtin_amdgcn_perm(b, a, 0x0c0c0400u), 0x05040100u); }
__device__ __forceinline__ unsigned pk_q8x4(f32x4 v) { return GU_I8 ? pk_i8x4(v) : pk_fp8x4(v); }
#define XB_TMO      128
#define XB_XCNT(j)  (256  + 64 * (j))
#define XB_XSUB(j)  (1280 + 64 * (j))
#define XB_XGEN(j)  (2304 + 64 * (j))
#define XB_TOP      3328
#define XB_TOPGEN   3392
#define XCD_BAR_WORDS 3456
#define XB_SPIN_CAP (1u << 18)
__device__ __forceinline__ unsigned xb_ld(unsigned* p)              { return __hip_atomic_load(p, __ATOMIC_RELAXED, __HIP_MEMORY_SCOPE_AGENT); }
__device__ __forceinline__ unsigned xb_add(unsigned* p, unsigned v) { return __hip_atomic_fetch_add(p, v, __ATOMIC_RELAXED, __HIP_MEMORY_SCOPE_AGENT); }
__device__ __forceinline__ unsigned xb_xcc_id() { return (unsigned)__builtin_amdgcn_s_getreg((3 << 11) | 20) & 0xFu; }
#define XB_SPIN(cond, bar) do { unsigned _sp = 0; while (cond) { __builtin_amdgcn_s_sleep(1); \
    if ((++_sp & 255u) == 0u) { if (xb_ld(&(bar)[XB_TMO])) break; if (_sp > XB_SPIN_CAP) { atomicAdd(&(bar)[XB_TMO], 1u); break; } } } } while (0)
struct XcdBarrier { unsigned* bar; unsigned x; volatile LAS unsigned* st; };
__device__ __forceinline__ XcdBarrier xcd_barrier_post(unsigned* bar, volatile LAS unsigned* st) {
    XcdBarrier b; b.bar = bar; b.x = xb_xcc_id(); b.st = st;
    if (threadIdx.x == 0) (void)xb_add(&bar[XB_XCNT(b.x)], 1u);
    return b;
}
__device__ __forceinline__ void xcd_barrier_complete(unsigned* bar, unsigned x, unsigned& nloc, unsigned& nx) {
    const unsigned G = gridDim.x * gridDim.y * gridDim.z;
    unsigned sum, cnt, mine, sp = 0u;
    for (;;) {
        sum = 0u; cnt = 0u; mine = 0u;
#pragma unroll
        for (unsigned j = 0; j < 16; ++j) { const unsigned c = xb_ld(&bar[XB_XCNT(j)]); sum += c; cnt += (c > 0u) ? 1u : 0u; mine = (j == x) ? c : mine; }
        if (sum == G) break;
        __builtin_amdgcn_s_sleep(1);
        if ((++sp & 255u) == 0u) { if (xb_ld(&bar[XB_TMO])) break; if (sp > XB_SPIN_CAP) { atomicAdd(&bar[XB_TMO], 1u); break; } }
    }
    nloc = mine > 0u ? mine : 1u; nx = cnt > 0u ? cnt : 1u;
}
__device__ __forceinline__ void xcd_barrier(const XcdBarrier& b) {
    asm volatile("s_waitcnt vmcnt(0)" ::: "memory");
    __syncthreads();
    if (threadIdx.x == 0) {
        unsigned* bar = b.bar;
        __builtin_amdgcn_s_waitcnt(0);
        unsigned nloc = b.st[0], nx = b.st[1];
        if (nloc == 0u) { xcd_barrier_complete(bar, b.x, nloc, nx); b.st[0] = nloc; b.st[1] = nx; }
        const unsigned old = xb_add(&bar[XB_XSUB(b.x)], 1u);
        const unsigned gen = old / nloc;
        if (old + 1u == (gen + 1u) * nloc) {
            __builtin_amdgcn_fence(__ATOMIC_RELEASE, "agent");
            asm volatile("s_waitcnt vmcnt(0)" ::: "memory");
            const unsigned og = xb_add(&bar[XB_TOP], 1u);
            const unsigned tg = og / nx;
            if (og + 1u == (tg + 1u) * nx) xb_add(&bar[XB_TOPGEN], 1u);
            else XB_SPIN(xb_ld(&bar[XB_TOPGEN]) == tg, bar);
            __builtin_amdgcn_fence(__ATOMIC_ACQUIRE, "agent");
            xb_add(&bar[XB_XGEN(b.x)], 1u);
            asm volatile("s_waitcnt vmcnt(0)" ::: "memory");
        } else {
            XB_SPIN(xb_ld(&bar[XB_XGEN(b.x)]) == gen, bar);
            __builtin_amdgcn_fence(__ATOMIC_ACQUIRE, "agent");
            asm volatile("s_waitcnt vmcnt(0)" ::: "memory");
        }
    }
    __syncthreads();
}

#define XB_LSUB(j)  (3456 + 16 * (j))
#define XB_LGEN(j)  (3712 + 16 * (j))
__device__ __forceinline__ void xcd_barrier_local(const XcdBarrier& b) {
    asm volatile("s_waitcnt vmcnt(0)" ::: "memory");
    __syncthreads();
    if (threadIdx.x == 0) {
        unsigned* bar = b.bar;
        __builtin_amdgcn_s_waitcnt(0);
        const unsigned nloc = b.st[0];
        const unsigned old = xb_add(&bar[XB_LSUB(b.x)], 1u);
        const unsigned gen = old / nloc;
        if (old + 1u == (gen + 1u) * nloc) xb_add(&bar[XB_LGEN(b.x)], 1u);
        else XB_SPIN(xb_ld(&bar[XB_LGEN(b.x)]) == gen, bar);
        __builtin_amdgcn_fence(__ATOMIC_ACQUIRE, "agent");
        asm volatile("s_waitcnt vmcnt(0)" ::: "memory");
    }
    __syncthreads();
}

__device__ __forceinline__ float wave_sum(float v) {
#pragma unroll
    for (int o = 1; o < 64; o <<= 1) v += __shfl_xor(v, o);
    return v;
}
__device__ __forceinline__ float wave_max(float v) {
#pragma unroll
    for (int o = 1; o < 64; o <<= 1) v = fmaxf(v, __shfl_xor(v, o));
    return v;
}
__device__ __forceinline__ float silu_f(float v) { return v * __builtin_amdgcn_rcpf(1.0f + __builtin_amdgcn_exp2f(-1.4426950408889634f * v)); }

struct Args {
    const float* x; const float* c; const int* pos; const float* mod_w; const float* mod_b; const float* norm_g;
    const float* conv_w_in; const float* conv_w; const float* conv_w_out; const float* ffn_g; const float* ffn_u; const float* ffn_d;
    const float* w_qkv; const float* w_o; const float* router_w; const float* moe_g; const float* moe_u; const float* moe_d; const float* final_g;
    float* out; unsigned char* ws; int ph_lo, ph_hi;
};

using pg8::Unit; using pg8::HALF; using pg8::BM;
#define PINV(x) asm volatile("" : "+v"(x))
#define ROWSTEP(k) (((k) == 3) ? 80u : 16u)
#ifndef STORE_AUX
#define STORE_AUX 0
#endif
__device__ __forceinline__ __amdgpu_buffer_rsrc_t mk_rsrc(const void* base) { return __builtin_amdgcn_make_buffer_rsrc(const_cast<void*>(base), 0, 0x7fffffff, 0x00020000); }
__device__ __forceinline__ void st16(__amdgpu_buffer_rsrc_t r, unsigned off, v4u v) { __builtin_amdgcn_raw_buffer_store_b128(v, r, (int)off, 0, STORE_AUX); }
__device__ __forceinline__ void st8(__amdgpu_buffer_rsrc_t r, unsigned off, v2u v) { __builtin_amdgcn_raw_buffer_store_b64(v, r, (int)off, 0, STORE_AUX); }
__device__ __forceinline__ void st16f(__amdgpu_buffer_rsrc_t r, unsigned off, f32x4 v) { __builtin_amdgcn_raw_buffer_store_b128(__builtin_bit_cast(v4u, v), r, (int)off, 0, STORE_AUX); }
template <class T> __device__ __forceinline__ T* at_off(T* base, unsigned byteoff) { return (T*)((char*)base + byteoff); }
template <class T> __device__ __forceinline__ const T* at_off(const T* base, unsigned byteoff) { return (const T*)((const char*)base + byteoff); }
__device__ __forceinline__ v4u pack8(const f32x4 a, const f32x4 b) { v4u w; w.x = pg8::cvt_pk_bf16(a[0], a[1]); w.y = pg8::cvt_pk_bf16(a[2], a[3]); w.z = pg8::cvt_pk_bf16(b[0], b[1]); w.w = pg8::cvt_pk_bf16(b[2], b[3]); return w; }
typedef int i32x4 __attribute__((ext_vector_type(4)));
__device__ __forceinline__ f32x4 acc_f32(const f32x4 a, bool i8) { return i8 ? __builtin_convertvector(__builtin_bit_cast(i32x4, a), f32x4) : a; }
template <bool I8> struct EpiConvInT {
    static constexpr bool PERM = true, SIDE = false;
    bf16* V; bf16* Bg;
    __device__ __forceinline__ void operator()(const f32x4 (&acc)[2][2][4][2], const Unit& u, int wr, int wc, int fr, int fq) const {
        PINV(fr); PINV(fq);
        const int row0 = u.pm * BM + wr * 64 + fr; const __amdgpu_buffer_rsrc_t rV = mk_rsrc(V), rB = mk_rsrc(Bg);
        constexpr float ci = I8 ? 1.0f / (GU_SA * GU_SW) : 1.0f;
        if (u.pn < 8) {
            unsigned ro = (unsigned)(row0 * D + u.pn * 128 + wc * 32 + 8 * fq) * 2u;
#pragma unroll
            for (int k = 0; k < 8; ++k) { const int ai = k >> 2, m = k & 3;
                st16(rV, ro, pack8(acc_f32(acc[ai][0][m][0], I8) * acc_f32(acc[ai][1][m][0], I8) * (ci * ci), acc_f32(acc[ai][0][m][1], I8) * acc_f32(acc[ai][1][m][1], I8) * (ci * ci)));
                ro += ROWSTEP(k) * (unsigned)(D * 2); PINV(ro); }
        } else {
            unsigned ro = (unsigned)(row0 * D + (u.pn - 8) * 256 + wc * 32 + 8 * fq) * 2u;
#pragma unroll
            for (int k = 0; k < 8; ++k) { const int ai = k >> 2, m = k & 3;
                st16(rB, ro, pack8(acc_f32(acc[ai][0][m][0], I8) * ci, acc_f32(acc[ai][0][m][1], I8) * ci));
                st16(rB, ro + HALF * 2, pack8(acc_f32(acc[ai][1][m][0], I8) * ci, acc_f32(acc[ai][1][m][1], I8) * ci));
                ro += ROWSTEP(k) * (unsigned)(D * 2); PINV(ro); }
        }
    }
};
typedef EpiConvInT<false> EpiConvIn;
typedef float f32x2 __attribute__((ext_vector_type(2)));
__device__ __forceinline__ f32x2 swiglu2(f32x2 g, f32x2 u, float cg, float cgu) {
    const f32x2 t = g * (-1.4426950408889634f * cg);
    f32x2 e; e.x = __builtin_amdgcn_exp2f(t.x); e.y = __builtin_amdgcn_exp2f(t.y);
    const float k = 1.0f / cgu;
    const f32x2 d = e * k + k;
    f32x2 r; r.x = __builtin_amdgcn_rcpf(d.x); r.y = __builtin_amdgcn_rcpf(d.y);
    return (g * u) * r;
}
__device__ __forceinline__ f32x4 swiglu4(f32x4 g, f32x4 u, float cg, float cgu) {
    const f32x2 a = swiglu2((f32x2){g.x, g.y}, (f32x2){u.x, u.y}, cg, cgu), b = swiglu2((f32x2){g.z, g.w}, (f32x2){u.z, u.w}, cg, cgu); return (f32x4){a.x, a.y, b.x, b.y}; }
__device__ __forceinline__ float rinv_of(const f32x4 s) { return __builtin_amdgcn_rsqf(((s.x + s.y) + (s.z + s.w)) * (1.0f / D) + RMS_EPS); }
constexpr int SIDE_BYTES = 5120;
template <bool NORM, bool F8 = false, bool F8O = F8> struct EpiSwiGLU {
    static constexpr bool PERM = true, SIDE = NORM;
    bf16* Hd; int nN; const float* SS; const float* bias; LAS unsigned char* side;
    __device__ __forceinline__ void side_issue(const Unit& u, int wid, int lane) const {
        LAS unsigned char* sl = side + u.sp * SIDE_BYTES;
        if (wid < 4) __builtin_amdgcn_global_load_lds((const unsigned*)(SS + ((size_t)(u.pm * BM + wid * 64 + lane)) * 4), (LAS unsigned*)(sl + wid * 1024), 16, 0, 0);
        else if (wid == 4) __builtin_amdgcn_global_load_lds((const unsigned*)(bias + (size_t)((u.pm * BM) / SEQ) * (2 * FF) + u.pn * BM + lane * 4), (LAS unsigned*)(sl + 4096), 16, 0, 0);
    }
    __device__ __forceinline__ void operator()(const f32x4 (&acc)[2][2][4][2], const Unit& u, int wr, int wc, int fr, int fq) const {
        PINV(fr); PINV(fq);
        const int row0 = u.pm * BM + wr * 64 + fr, pnl = u.pn % nN;
        f32x4 (&a)[2][2][4][2] = const_cast<f32x4 (&)[2][2][4][2]>(acc);
        if (NORM) {
            const LAS unsigned char* sl = side + u.sp * SIDE_BYTES;
            f32x4 bv[2][2];
#pragma unroll
            for (int bj = 0; bj < 2; ++bj)
#pragma unroll
                for (int n = 0; n < 2; ++n) bv[bj][n] = *(const LAS f32x4*)(sl + 4096 + (bj * HALF + wc * 32 + 8 * fq + 4 * n) * 4);
#pragma unroll
            for (int k = 0; k < 8; ++k) { const float r = rinv_of(*(const LAS f32x4*)(sl + ((k >> 2) * HALF + wr * 64 + (k & 3) * 16 + fr) * 16)) * (F8 ? 1.0f / (GU_SA * GU_SW) : 1.0f);
#pragma unroll
                for (int bj = 0; bj < 2; ++bj)
#pragma unroll
                    for (int n = 0; n < 2; ++n) a[k >> 2][bj][k & 3][n] = acc_f32(a[k >> 2][bj][k & 3][n], F8 && GU_I8) * r + bv[bj][n]; }
        }
        unsigned ro = (unsigned)(row0 * FF + pnl * 128 + wc * 32 + 8 * fq) * (F8O ? 1u : 2u); const __amdgpu_buffer_rsrc_t rH = mk_rsrc(Hd);
#pragma unroll
        for (int k = 0; k < 8; ++k) { const int ai = k >> 2, m = k & 3;
            const f32x4 g0 = a[ai][0][m][0], g1 = a[ai][0][m][1], u0 = a[ai][1][m][0], u1 = a[ai][1][m][1];
            const f32x4 v0 = swiglu4(g0, u0, 1.0f, F8O ? F8_SH : 1.0f), v1 = swiglu4(g1, u1, 1.0f, F8O ? F8_SH : 1.0f);
            if (F8O) { v2u w8; w8.x = pk_fp8x4(v0); w8.y = pk_fp8x4(v1); st8(rH, ro, w8); } else st16(rH, ro, pack8(v0, v1));
            ro += ROWSTEP(k) * (unsigned)(FF * (F8O ? 1 : 2)); PINV(ro); }
    }
};
struct EpiSwiGLU8 {
    static constexpr bool PERM = true, SIDE = false;
    unsigned char* Hd; int nN;
    __device__ __forceinline__ void operator()(const f32x4 (&acc)[2][2][4][2], const Unit& u, int wr, int wc, int fr, int fq) const {
        PINV(fr); PINV(fq);
        const int row0 = u.pm * BM + wr * 64 + fr, pnl = u.pn % nN;
        unsigned ro = (unsigned)(row0 * FF + pnl * 128 + wc * 32 + 8 * fq); const __amdgpu_buffer_rsrc_t rH = mk_rsrc(Hd);
        constexpr float ci = 1.0f / (MOE_SA * MOE_SW);
#pragma unroll
        for (int k = 0; k < 8; ++k) { const int ai = k >> 2, m = k & 3;
            const f32x4 v0 = swiglu4(acc_f32(acc[ai][0][m][0], MOE_I8), acc_f32(acc[ai][1][m][0], MOE_I8), ci, ci * ci * F8_SH), v1 = swiglu4(acc_f32(acc[ai][0][m][1], MOE_I8), acc_f32(acc[ai][1][m][1], MOE_I8), ci, ci * ci * F8_SH);
            v2u w; w.x = pk_fp8x4(v0); w.y = pk_fp8x4(v1); st8(rH, ro, w);
            ro += ROWSTEP(k) * (unsigned)FF; PINV(ro); }
    }
};
template <bool I8> struct EpiQkvRopeT {
    static constexpr bool PERM = true, SIDE = true;
    bf16* QKV; const unsigned* rope; const float* SS; const float* bias; LAS unsigned char* side;
    __device__ __forceinline__ void side_issue(const Unit& u, int wid, int lane) const {
        LAS unsigned char* sl = side + u.sp * SIDE_BYTES;
        if (wid < 4) __builtin_amdgcn_global_load_lds((const unsigned*)(SS + ((size_t)(u.pm * BM + wid * 64 + lane)) * 4), (LAS unsigned*)(sl + wid * 1024), 16, 0, 0);
        else if (wid == 4) __builtin_amdgcn_global_load_lds((const unsigned*)(bias + (size_t)((u.pm * BM) / SEQ) * (2 * FF) + u.pn * BM + lane * 4), (LAS unsigned*)(sl + 4096), 16, 0, 0);
    }
    __device__ __forceinline__ void operator()(const f32x4 (&acc)[2][2][4][2], const Unit& u, int wr, int wc, int fr, int fq) const {
        PINV(fr); PINV(fq);
        const int hd = 4 * u.pn + wc; if (hd >= NHQKV) return;
        const int row0 = u.pm * BM + wr * 64 + fr;
        const float sc = hd < NH ? C2 : 1.0f;
        f32x4 (&a)[2][2][4][2] = const_cast<f32x4 (&)[2][2][4][2]>(acc);
        { const LAS unsigned char* sl = side + u.sp * SIDE_BYTES;
            f32x4 bv[2][2];
#pragma unroll
            for (int bj = 0; bj < 2; ++bj)
#pragma unroll
                for (int n = 0; n < 2; ++n) bv[bj][n] = *(const LAS f32x4*)(sl + 4096 + (bj * HALF + wc * 32 + 8 * fq + 4 * n) * 4);
#pragma unroll
            for (int k = 0; k < 8; ++k) { const float r = rinv_of(*(const LAS f32x4*)(sl + ((k >> 2) * HALF + wr * 64 + (k & 3) * 16 + fr) * 16)) * (I8 ? 1.0f / (GU_SA * GU_SW) : 1.0f);
#pragma unroll
                for (int bj = 0; bj < 2; ++bj)
#pragma unroll
                    for (int n = 0; n < 2; ++n) a[k >> 2][bj][k & 3][n] = acc_f32(a[k >> 2][bj][k & 3][n], I8) * r + bv[bj][n]; } }
        const bool rot = hd < 2 * NH; const __amdgpu_buffer_rsrc_t rQ = mk_rsrc(QKV);
        v4u cs[2][2];
        unsigned co = (unsigned)(row0 * 32 + 8 * fq) * 4u, ro = (unsigned)(row0 * QKVP + hd * 64 + 8 * fq) * 2u;
#define RP_H2F(u, hi) ((float)__builtin_bit_cast(_Float16, (unsigned short)((hi) ? ((u) >> 16) : ((u) & 0xffffu))))
        cs[0][0] = *at_off((const v4u*)rope, co); cs[0][1] = *at_off((const v4u*)rope, co + 16);
#pragma unroll
        for (int k = 0; k < 8; ++k) { const int ai = k >> 2, m = k & 3, cb_ = k & 1;
            co += ROWSTEP(k) * 128u; PINV(co);
            if (k < 7) { cs[cb_ ^ 1][0] = *at_off((const v4u*)rope, co); cs[cb_ ^ 1][1] = *at_off((const v4u*)rope, co + 16); }
#pragma unroll
            for (int n = 0; n < 2; ++n) {
                const f32x4 x1 = a[ai][0][m][n], x2 = a[ai][1][m][n]; f32x4 c, s;
#pragma unroll
                for (int i = 0; i < 4; ++i) { const float cf = RP_H2F(cs[cb_][n][i], 0), sf = RP_H2F(cs[cb_][n][i], 1); c[i] = rot ? cf : 1.0f; s[i] = rot ? sf : 0.0f; }
                const f32x4 o1 = (x1 * c - x2 * s) * sc, o2 = (x2 * c + x1 * s) * sc;
                v2u w; w.x = pg8::cvt_pk_bf16(o1[0], o1[1]); w.y = pg8::cvt_pk_bf16(o1[2], o1[3]); st8(rQ, ro + 8 * n, w);
                w.x = pg8::cvt_pk_bf16(o2[0], o2[1]); w.y = pg8::cvt_pk_bf16(o2[2], o2[3]); st8(rQ, ro + 64 + 8 * n, w); }
            ro += ROWSTEP(k) * (unsigned)(QKVP * 2); PINV(ro); }
#undef RP_H2F
    }
};
typedef EpiQkvRopeT<false> EpiQkvRope;
__device__ __forceinline__ void unpack8(const v4u u, f32x4& a, f32x4& b) { a = (f32x4){bflo(u.x), bfhi(u.x), bflo(u.y), bfhi(u.y)}; b = (f32x4){bflo(u.z), bfhi(u.z), bflo(u.w), bfhi(u.w)}; }
template <bool BASE_F32, bool NEXT, bool XB8 = false> struct EpiResidB {
    static constexpr bool PERM = true, SIDE = false;
    const void* base; bf16* XR; const float* gate; bf16* XB; float* SS; const float* scl; const float* ng; LAS float* red; float ascale;
    __device__ __forceinline__ void operator()(const f32x4 (&acc)[2][2][4][2], const Unit& u, int wr, int wc, int fr, int fq) const {
        PINV(fr); PINV(fq);
        const int row0 = u.pm * BM + wr * 64 + fr, col0 = u.pn * BM + wc * 32 + 8 * fq, b = (u.pm * BM) / SEQ;
        f32x4 gv[2][2], can[2][2];
#pragma unroll
        for (int bj = 0; bj < 2; ++bj)
#pragma unroll
            for (int n = 0; n < 2; ++n) { gv[bj][n] = *(const f32x4*)(gate + (size_t)b * 3072 + col0 + bj * HALF + 4 * n) * ascale;
                if (NEXT) can[bj][n] = *(const f32x4*)(ng + col0 + bj * HALF + 4 * n) * (*(const f32x4*)(scl + (size_t)b * 3072 + col0 + bj * HALF + 4 * n) + 1.0f); }
        const __amdgpu_buffer_rsrc_t rR = mk_rsrc(XR), rX = mk_rsrc(XB);
        f32x4 bf[2][2][2]; v4u bh[2][2];
        unsigned lo = (unsigned)(row0 * D + col0) * (BASE_F32 ? 4u : 2u), so = (unsigned)(row0 * D + col0) * 2u; int rl = wr * 64 + fr;
#define ER_LOAD(buf) do { if (BASE_F32) { _Pragma("unroll") for (int bj = 0; bj < 2; ++bj) _Pragma("unroll") for (int n = 0; n < 2; ++n) bf[buf][bj][n] = *at_off((const f32x4*)base, lo + (bj * HALF + 4 * n) * 4); } \
        else { _Pragma("unroll") for (int bj = 0; bj < 2; ++bj) bh[buf][bj] = *at_off((const v4u*)base, lo + bj * HALF * 2); } } while (0)
        ER_LOAD(0);
#pragma unroll
        for (int k = 0; k < 8; ++k) { const int ai = k >> 2, m = k & 3, cb_ = k & 1;
            lo += ROWSTEP(k) * (unsigned)(D * (BASE_F32 ? 4 : 2)); PINV(lo);
            if (k < 7) { if (cb_) ER_LOAD(0); else ER_LOAD(1); }
            float s = 0.f;
#pragma unroll
            for (int bj = 0; bj < 2; ++bj) { f32x4 x0, x1;
                if (BASE_F32) { x0 = bf[cb_][bj][0]; x1 = bf[cb_][bj][1]; } else unpack8(bh[cb_][bj], x0, x1);
                x0 = x0 + gv[bj][0] * acc[ai][bj][m][0]; x1 = x1 + gv[bj][1] * acc[ai][bj][m][1];
                st16(rR, so + bj * HALF * 2, pack8(x0, x1));
                if (NEXT) { s += ((x0.x * x0.x + x0.y * x0.y) + (x0.z * x0.z + x0.w * x0.w)) + ((x1.x * x1.x + x1.y * x1.y) + (x1.z * x1.z + x1.w * x1.w));
                    if (XB8) { v2u w8; w8.x = pk_q8x4(x0 * can[bj][0] * GU_SA); w8.y = pk_q8x4(x1 * can[bj][1] * GU_SA); st8(rX, (so >> 1) + bj * HALF, w8); }
                    else st16(rX, so + bj * HALF * 2, pack8(x0 * can[bj][0], x1 * can[bj][1])); } }
            if (NEXT) { s += __shfl_xor(s, 16); s += __shfl_xor(s, 32); if (fq == 0) red[rl * 4 + wc] = s; }
            so += ROWSTEP(k) * (unsigned)(D * 2); PINV(so); rl += (int)ROWSTEP(k); }
#undef ER_LOAD
        if (NEXT) {
            asm volatile("s_waitcnt lgkmcnt(0)" ::: "memory"); __builtin_amdgcn_s_barrier(); asm volatile("" ::: "memory");
            if (threadIdx.x < 256) { const f32x4 t = *(const LAS f32x4*)(red + threadIdx.x * 4); SS[(size_t)(u.pm * BM + threadIdx.x) * 4 + u.pn] = (t.x + t.y) + (t.z + t.w); }
        }
    }
};
struct EpiMoeDown {
    static constexpr bool PERM = true, SIDE = true;
    bf16* XR; bf16* Y1; const int* rowtok; const float* roww; const LAS float* gate; float oscale; LAS unsigned char* side;
    __device__ __forceinline__ void side_issue(const Unit& u, int wid, int lane) const {
        LAS unsigned char* sl = side + u.sp * 2048; const size_t lb = (size_t)u.g * M + 256 * u.k;
        if (wid < 4) __builtin_amdgcn_global_load_lds((const unsigned*)(rowtok + lb + wid * 64 + lane), (LAS unsigned*)(sl + wid * 256), 4, 0, 0);
        else __builtin_amdgcn_global_load_lds((const unsigned*)(roww + lb + (wid - 4) * 64 + lane), (LAS unsigned*)(sl + 1024 + (wid - 4) * 256), 4, 0, 0);
    }
    __device__ __forceinline__ void operator()(const f32x4 (&acc)[2][2][4][2], const Unit& u, int wr, int wc, int fr, int fq) const {
        PINV(fr); PINV(fq);
        const int col0 = (u.pn & 3) * BM + wc * 32 + 8 * fq; const LAS unsigned char* sl = side + u.sp * 2048;
        int tok[8]; float w[8];
#pragma unroll
        for (int k = 0; k < 8; ++k) { const int rl = (k >> 2) * HALF + wr * 64 + (k & 3) * 16 + fr; const bool ok = rl < u.nv; const int t_ = *(const LAS int*)(sl + rl * 4); const float w_ = *(const LAS float*)(sl + 1024 + rl * 4);
            tok[k] = ok ? t_ : -1; w[k] = ok ? w_ * oscale : 0.f; }
        if (u.g < 8) {
            const __amdgpu_buffer_rsrc_t rR = mk_rsrc(XR);
            v4u bh[2][2];
#define ER_LOAD(buf, kk) do { const unsigned o_ = (unsigned)((tok[kk] < 0 ? 0 : tok[kk]) * D + col0) * 2u; \
            _Pragma("unroll") for (int bj = 0; bj < 2; ++bj) bh[buf][bj] = *at_off((const v4u*)XR, o_ + bj * HALF * 2); } while (0)
            ER_LOAD(0, 0);
#pragma unroll
            for (int k = 0; k < 8; ++k) { const int ai = k >> 2, m = k & 3, cb_ = k & 1;
                if (k < 7) { if (cb_) ER_LOAD(0, (k + 1) & 7); else ER_LOAD(1, (k + 1) & 7); }
#pragma unroll
                for (int bj = 0; bj < 2; ++bj) PINV(bh[cb_][bj]);
                if (tok[k] >= 0) { const unsigned o_ = (unsigned)(tok[k] * D + col0) * 2u; const LAS float* g_ = gate + (tok[k] >> 13) * D + col0; const float w_ = w[k];
#pragma unroll
                    for (int bj = 0; bj < 2; ++bj) { f32x4 x0, x1; unpack8(bh[cb_][bj], x0, x1);
                        x0 = x0 + *(const LAS f32x4*)(g_ + bj * HALF) * w_ * acc[ai][bj][m][0]; x1 = x1 + *(const LAS f32x4*)(g_ + bj * HALF + 4) * w_ * acc[ai][bj][m][1];
                        st16(rR, o_ + bj * HALF * 2, pack8(x0, x1)); } } }
#undef ER_LOAD
        } else {
            const __amdgpu_buffer_rsrc_t rY = mk_rsrc(Y1);
#pragma unroll
            for (int k = 0; k < 8; ++k) { const int ai = k >> 2, m = k & 3;
                if (tok[k] >= 0) { const unsigned o_ = (unsigned)(tok[k] * D + col0) * 2u; const LAS float* g_ = gate + (tok[k] >> 13) * D + col0; const float w_ = w[k];
#pragma unroll
                    for (int bj = 0; bj < 2; ++bj) st16(rY, o_ + bj * HALF * 2, pack8(*(const LAS f32x4*)(g_ + bj * HALF) * w_ * acc[ai][bj][m][0], *(const LAS f32x4*)(g_ + bj * HALF + 4) * w_ * acc[ai][bj][m][1])); } }
        }
    }
};
struct EpiNull { static constexpr bool PERM = true, SIDE = false;
    __device__ __forceinline__ void operator()(const f32x4 (&acc)[2][2][4][2], const Unit& u, int wr, int wc, int fr, int fq) const {
        PINV(fr); PINV(fq);
#pragma unroll
        for (int ai = 0; ai < 2; ++ai)
#pragma unroll
            for (int bj = 0; bj < 2; ++bj)
                asm volatile("" :: "v"(acc[ai][bj][0][0]), "v"(acc[ai][bj][0][1]), "v"(acc[ai][bj][1][0]), "v"(acc[ai][bj][1][1]), "v"(acc[ai][bj][2][0]), "v"(acc[ai][bj][2][1]), "v"(acc[ai][bj][3][0]), "v"(acc[ai][bj][3][1])); } };
__constant__ float INVF[32] = {
    1.0f, 0.7498942093324559f, 0.5623413251903491f, 0.4216965034285822f, 0.31622776601683794f, 0.23713737056616552f, 0.1778279410038923f, 0.1333521432163324f,
    0.1f, 0.07498942093324558f, 0.05623413251903491f, 0.04216965034285822f, 0.03162277660168379f, 0.023713737056616554f, 0.01778279410038923f, 0.01333521432163324f,
    0.01f, 0.007498942093324558f, 0.005623413251903491f, 0.004216965034285823f, 0.0031622776601683794f, 0.0023713737056616554f, 0.0017782794100389228f, 0.001333521432163324f,
    0.001f, 0.0007498942093324559f, 0.0005623413251903491f, 0.0004216965034285823f, 0.00031622776601683794f, 0.00023713737056616554f, 0.00017782794100389227f, 0.0001333521432163324f };

template <int MAP, int FMT  >
__device__ __forceinline__ void conv_block(const float* W, int ld, int ncol, int kvalid, int k0, int c0, unsigned char* dst, int Kp  , int rowoff, float sc, int wave, int lane) {
    const int col = c0 + 4 * lane, kb = k0 + 16 * wave; const bool act = col < ncol;
    f32x4 v[16];
#pragma unroll
    for (int i = 0; i < 16; ++i) v[i] = (act && kb + i < kvalid) ? *(const f32x4*)(W + (size_t)(kb + i) * ld + col) : (f32x4){0.f, 0.f, 0.f, 0.f};
    if (!act) return;
    int nrow;
    if (MAP == 0) nrow = col;
    else if (MAP == 1) { if (col < 1024) nrow = 2048 + col; else { const int cc = (col - 1024) & 1023, up = col >= 2048; nrow = 256 * (cc >> 7) + (cc & 127) + (up ? 128 : 0); } }
    else if (MAP == 2) nrow = 256 * (col >> 7) + (col & 127);
    else { const int head = col >> 6, bj = (col >> 5) & 1, dd = col & 31; nrow = 256 * (head >> 2) + 128 * bj + 32 * (head & 3) + dd; }
    nrow += rowoff;
#pragma unroll
    for (int j = 0; j < 4; ++j) {
        if (FMT != 0) { v4u o;
#pragma unroll
            for (int q = 0; q < 4; ++q) { const f32x4 t = (f32x4){v[4 * q][j], v[4 * q + 1][j], v[4 * q + 2][j], v[4 * q + 3][j]} * sc; o[q] = FMT == 2 ? pk_i8x4(t) : pk_fp8x4(t); }
            *(v4u*)(dst + (size_t)(nrow + j) * Kp + kb) = o; }
        else { v4u o0, o1;
#pragma unroll
            for (int q = 0; q < 4; ++q) { o0[q] = pk2(v[2 * q][j], v[2 * q + 1][j]); o1[q] = pk2(v[8 + 2 * q][j], v[8 + 2 * q + 1][j]); }
            bf16* p = (bf16*)dst + (size_t)(nrow + j) * Kp + kb; *(v4u*)p = o0; *(v4u*)(p + 8) = o1; }
    }
}
__device__ __forceinline__ void p0_prologue(const Args& a, LAS unsigned char* lds, int gw, int NGW, int wave, int lane, int tid) {
    unsigned char* ws = a.ws;
    LAS float* sc = (LAS float*)(lds + 69632);
    for (int i = tid; i < NB * D; i += NTHR) sc[i] = silu_f(a.c[i]);
    if (blockIdx.x == 0) for (int i = tid; i < 16 * 3072; i += NTHR) ((float*)(ws + WS_ZG))[i] = 0.f;
    if (blockIdx.x == 1) for (int i = tid; i < 2 * RPAD; i += NTHR) ((int*)(ws + WS_IDENT))[i] = i;
    if (blockIdx.x == 2) {
        for (int i = tid; i < 192 * (D / 8); i += NTHR) { const int rr = i / (D / 8), c8 = i % (D / 8), bj = rr / 96, q = rr % 96;
            if (QKV_I8) { if (c8 < D / 16) *(v4u*)(ws + WS_WQKV + (size_t)(2816 + 128 * bj + 32 + q) * D + 16 * c8) = (v4u){0u, 0u, 0u, 0u}; }
            else *(v4u*)((bf16*)(ws + WS_WQKV) + (size_t)(2816 + 128 * bj + 32 + q) * D + 8 * c8) = (v4u){0u, 0u, 0u, 0u}; } }
    __syncthreads();
    constexpr int B_CIN = 8 * 12, B_COUT = 8 * 4, B_FG = 8 * 11, B_FD = 22 * 4, B_QKV = 8 * 12, B_WO = 8 * 4, B_MG = NE * B_FG, B_MD = NE * B_FD;
    constexpr int NBLK = B_CIN + B_COUT + 2 * B_FG + B_FD + B_QKV + B_WO + 2 * B_MG + B_MD;
    for (int it = blockIdx.x; it < NBLK; it += gridDim.x) {
        int r = it;
        if (r < B_CIN) { conv_block<1, CONVIN_I8 ? 2 : 0>(a.conv_w_in, 3072, 3072, D, 128 * (r / 12), 256 * (r % 12), ws + WS_WCIN, D, 0, GU_SW, wave, lane); continue; } r -= B_CIN;
        if (r < B_COUT) { conv_block<0, WOUT_FP8 ? 1 : 0>(a.conv_w_out, D, D, D, 128 * (r / 4), 256 * (r % 4), ws + WS_WCOUT, D, 0, F8_SW, wave, lane); continue; } r -= B_COUT;
        if (r < 2 * B_FG) { const int up = r >= B_FG, q = up ? r - B_FG : r;
            conv_block<2, DENSE_GU_FP8 ? (GU_I8 ? 2 : 1) : 0>(up ? a.ffn_u : a.ffn_g, FF, FF, D, 128 * (q / 11), 256 * (q % 11), ws + WS_WFGU, D, up ? 128 : 0, GU_SW, wave, lane); continue; } r -= 2 * B_FG;
        if (r < B_FD) { conv_block<0, DENSE_DOWN_FP8 ? 1 : 0>(a.ffn_d, D, D, FF, 128 * (r / 4), 256 * (r % 4), ws + WS_WFD, FF, 0, F8_SW, wave, lane); continue; } r -= B_FD;
        if (r < B_QKV) { conv_block<3, QKV_I8 ? 2 : 0>(a.w_qkv, 2880, 2880, D, 128 * (r / 12), 256 * (r % 12), ws + WS_WQKV, D, 0, GU_SW, wave, lane); continue; } r -= B_QKV;
        if (r < B_WO) { conv_block<0, WO_FP8 ? 1 : 0>(a.w_o, D, D, 960, 128 * (r / 4), 256 * (r % 4), ws + WS_WO, D, 0, F8_SW, wave, lane); continue; } r -= B_WO;
        if (r < 2 * B_MG) { const int up = r >= B_MG, q = up ? r - B_MG : r, e = q / B_FG, qq = q % B_FG;
            conv_block<2, MOE_I8 ? 2 : 1>((up ? a.moe_u : a.moe_g) + (size_t)e * D * FF, FF, FF, D, 128 * (qq / 11), 256 * (qq % 11), ws + WS_WMGU, D, e * 2 * FF + (up ? 128 : 0), MOE_SW, wave, lane); continue; } r -= 2 * B_MG;
        { const int e = r / B_FD, qq = r % B_FD;
            conv_block<0, 1>(a.moe_d + (size_t)e * FF * D, D, D, FF, 128 * (qq / 4), 256 * (qq % 4), ws + WS_WMD, FF, e * D, F8_SW, wave, lane); }
    }
    constexpr int I_ADA = 4 * 12 * 8, I_ROPE = M / 2;
    for (int it = gw; it < I_ADA + I_ROPE; it += NGW) {
        int r = it;
        if (r < I_ADA) {
            const int ls = r / 96, q = r % 96, cg = q / 8, kc = q % 8;
            const float* W = a.mod_w + (size_t)ls * D * 3072 + (size_t)(kc * 128) * 3072 + cg * 256 + 4 * lane;
            f32x4 acc[NB];
#pragma unroll
            for (int b = 0; b < NB; ++b) acc[b] = (f32x4){0.f, 0.f, 0.f, 0.f};
#pragma unroll 8
            for (int k = 0; k < 128; ++k) { const f32x4 w = *(const f32x4*)(W + (size_t)k * 3072);
#pragma unroll
                for (int b = 0; b < NB; ++b) acc[b] += w * sc[b * D + kc * 128 + k]; }
            float* P = (float*)(ws + WS_MODP);
#pragma unroll
            for (int b = 0; b < NB; ++b) *(f32x4*)(P + (size_t)(kc * 16 + ls * 4 + b) * 3072 + cg * 256 + 4 * lane) = acc[b];
            continue;
        }
        r -= I_ADA;
        {
            const int tok = 2 * r + (lane >> 5), i = lane & 31;
            const float ang = (float)a.pos[tok] * INVF[i];
            double rev = (double)ang * 0.15915494309189535; rev -= __builtin_rint(rev);
            const float fr = (float)rev;
            unsigned* R = (unsigned*)(ws + WS_ROPE) + (size_t)tok * 32;
            const _Float16 hc = (_Float16)__builtin_amdgcn_cosf(fr), hs = (_Float16)__builtin_amdgcn_sinf(fr);
            R[i] = (unsigned)__builtin_bit_cast(unsigned short, hc) | ((unsigned)__builtin_bit_cast(unsigned short, hs) << 16);
        }
    }
}

template <bool FROM_PARTIALS, bool ROUTE, bool SRC16 = false, bool OUT8 = ROUTE>
__device__ __forceinline__ void norm_phase(const Args& a, const void* xsrc, int ls, LAS unsigned char* lds, int G, int wave, int lane, int tid) {
    unsigned char* ws = a.ws;
    LAS float* cA = (LAS float*)lds;
    LAS float* cB = (LAS float*)(lds + 4096);
    LAS float* rwT = (LAS float*)(lds + 8192);
    bf16* H = (bf16*)(ws + WS_H);
    const float* P = (const float*)(ws + WS_MODP); const float* MF = (const float*)(ws + WS_MODF);
    if (ROUTE) { for (int i = tid; i < D * NE; i += NTHR) { const int k = i >> 3, e = i & 7; rwT[e * D + k] = a.router_w[i]; } }
    for (int ch = (G % 8 == 0) ? (blockIdx.x % 8) * (G / 8) + blockIdx.x / 8 : blockIdx.x; ch < NCHUNK; ch += G) {
        const int b = ch / (SEQ / 128);
        __syncthreads();
        for (int k = tid; k < D; k += NTHR) {
            float sh, scl;
            if (FROM_PARTIALS) { sh = a.mod_b[ls * 3072 + k]; scl = a.mod_b[ls * 3072 + D + k];
#pragma unroll
                for (int kc = 0; kc < 8; ++kc) { sh += P[(size_t)(kc * 16 + ls * 4 + b) * 3072 + k]; scl += P[(size_t)(kc * 16 + ls * 4 + b) * 3072 + D + k]; } }
            else { sh = MF[(size_t)(ls * 4 + b) * 3072 + k]; scl = MF[(size_t)(ls * 4 + b) * 3072 + D + k]; }
            cA[k] = a.norm_g[ls * D + k] * (1.0f + scl); cB[k] = sh;
        }
        int my_e0 = -1, my_e1 = -1; float my_w0 = 0.f, my_w1 = 0.f;
        __syncthreads();
        v2u nb16[2][4]; f32x4 nb32[2][4];
#define NP_LOAD(buf, ii) do { const int row_ = ch * 128 + wave * 16 + (ii); \
            if (SRC16) { const v2u* xr = (const v2u*)((const bf16*)xsrc + (size_t)row_ * D) + lane; _Pragma("unroll") for (int j = 0; j < 4; ++j) nb16[buf][j] = xr[64 * j]; } \
            else { const f32x4* xr = (const f32x4*)((const float*)xsrc + (size_t)row_ * D) + lane; _Pragma("unroll") for (int j = 0; j < 4; ++j) nb32[buf][j] = xr[64 * j]; } } while (0)
        NP_LOAD(0, 0);
        for (int i2 = 0; i2 < 16; i2 += 2) {
#pragma unroll
          for (int pb = 0; pb < 2; ++pb) {
            const int i = i2 + pb;
            if (pb == 0) NP_LOAD(1, i + 1); else if (i + 1 < 16) NP_LOAD(0, i + 1);
            const int row = ch * 128 + wave * 16 + i;
            f32x4 v[4]; float s = 0.f;
#pragma unroll
            for (int j = 0; j < 4; ++j) { if (SRC16) { const v2u t = nb16[pb][j]; v[j] = (f32x4){bflo(t.x), bfhi(t.x), bflo(t.y), bfhi(t.y)}; } else v[j] = nb32[pb][j]; }
#pragma unroll
            for (int j = 0; j < 4; ++j) s += (v[j].x * v[j].x + v[j].y * v[j].y) + (v[j].z * v[j].z + v[j].w * v[j].w);
            const float rinv = 1.0f / sqrtf(wave_sum(s) * (1.0f / D) + RMS_EPS);
            if (FROM_PARTIALS) { unsigned long long* x8 = (unsigned long long*)((bf16*)(ws + WS_XR) + (size_t)row * D) + lane;
#pragma unroll
                for (int j = 0; j < 4; ++j) x8[64 * j] = (unsigned long long)pk2(v[j].x, v[j].y) | ((unsigned long long)pk2(v[j].z, v[j].w) << 32); }
            unsigned long long* o8 = (unsigned long long*)(H + (size_t)row * D) + lane;
#pragma unroll
            for (int j = 0; j < 4; ++j) { const f32x4 ca = *(const LAS f32x4*)(cA + 4 * lane + 256 * j), cb = *(const LAS f32x4*)(cB + 4 * lane + 256 * j);
                v[j] = v[j] * rinv * ca + cb;
                if (OUT8) ((unsigned*)((unsigned char*)H + (size_t)row * D))[lane + 64 * j] = MOE_I8 ? pk_i8x4(v[j] * MOE_SA) : pk_fp8x4(v[j] * MOE_SA);
                else o8[64 * j] = (unsigned long long)pk2(v[j].x, v[j].y) | ((unsigned long long)pk2(v[j].z, v[j].w) << 32); }
            if (ROUTE) {
                float pe[NE];
#pragma unroll
                for (int e = 0; e < NE; ++e) pe[e] = 0.f;
#pragma unroll
                for (int j = 0; j < 4; ++j) {
#pragma unroll
                    for (int e = 0; e < NE; ++e) { const f32x4 w = *(const LAS f32x4*)(rwT + e * D + 4 * lane + 256 * j); pe[e] += (v[j].x * w.x + v[j].y * w.y) + (v[j].z * w.z + v[j].w * w.w); }
                    asm volatile("" ::: "memory"); }
                float lg[NE];
#pragma unroll
                for (int e = 0; e < NE; ++e) lg[e] = wave_sum(pe[e]);
                int i0 = 0; float v0 = lg[0];
#pragma unroll
                for (int e = 1; e < NE; ++e) if (lg[e] > v0) { v0 = lg[e]; i0 = e; }
                int i1 = -1; float v1 = -INFINITY;
#pragma unroll
                for (int e = 0; e < NE; ++e) if (e != i0 && lg[e] > v1) { v1 = lg[e]; i1 = e; }
                const float w0 = 1.0f / (1.0f + expf(v1 - v0)), w1 = 1.0f - w0;
                if (lane == i) { my_e0 = i0; my_e1 = i1; my_w0 = w0; my_w1 = w1; }
            }
          }
        }
#undef NP_LOAD
        if (ROUTE) {
            unsigned* CNT = (unsigned*)(ws + WS_CTL) + CW_CNT; int* RT2 = (int*)(ws + WS_RT2); float* RW2 = (float*)(ws + WS_RW2);
#pragma unroll
            for (int s = 0; s < 2; ++s) {
                const int me = lane < 16 ? (s ? my_e1 : my_e0) : -1; int rank = 0, mycount = 0;
#pragma unroll
                for (int e = 0; e < NE; ++e) { const unsigned long long mask = __ballot(me == e); if (lane == e) mycount = __popcll(mask); if (me == e) rank = __popcll(mask & ((1ull << lane) - 1ull)); }
                int base = 0; if (lane < NE && mycount > 0) base = (int)__hip_atomic_fetch_add(CNT + s * 8 + lane, (unsigned)mycount, __ATOMIC_RELAXED, __HIP_MEMORY_SCOPE_AGENT);
                const int bs = __shfl(base, me < 0 ? 0 : me);
                if (lane < 16) { const size_t p = (size_t)(s * 8 + me) * M + bs + rank; RT2[p] = ch * 128 + wave * 16 + lane; RW2[p] = s ? my_w1 : my_w0; }
            }
        }
    }
    if (FROM_PARTIALS) {
        float* MFw = (float*)(ws + WS_MODF);
        for (int idx = blockIdx.x * NTHR + tid; idx < 16 * 3072; idx += G * NTHR) { const int lsb = idx / 3072, n = idx % 3072; float s = a.mod_b[(lsb >> 2) * 3072 + n];
#pragma unroll
            for (int kc = 0; kc < 8; ++kc) s += P[(size_t)(kc * 16 + lsb) * 3072 + n];
            MFw[idx] = s; }
    }
}

__device__ __forceinline__ void conv_phase(const Args& a, int G, int tid) {
    unsigned char* ws = a.ws;
    const bf16* V = (const bf16*)(ws + WS_V); const bf16* Bg = (const bf16*)(ws + WS_BG); bf16* Y = (bf16*)(ws + WS_H);
    const int cg = tid & 127, rs = tid >> 7;
    float w0[8], w1[8], w2[8];
#pragma unroll
    for (int i = 0; i < 8; ++i) { w0[i] = a.conv_w[8 * cg + i]; w1[i] = a.conv_w[D + 8 * cg + i]; w2[i] = a.conv_w[2 * D + 8 * cg + i]; }
    for (int ch = blockIdx.x; ch < NCHUNK; ch += G) {
        const int r0 = ch * 128 + rs * 32, t0 = r0 & (SEQ - 1);
        v4u zz = (v4u){0u, 0u, 0u, 0u};
        v4u vm2 = t0 >= 2 ? *(const v4u*)(V + (size_t)(r0 - 2) * D + 8 * cg) : zz;
        v4u vm1 = t0 >= 1 ? *(const v4u*)(V + (size_t)(r0 - 1) * D + 8 * cg) : zz;
#pragma unroll 4
        for (int i = 0; i < 32; ++i) {
            const size_t off = (size_t)(r0 + i) * D + 8 * cg;
            const v4u v = *(const v4u*)(V + off), bg = *(const v4u*)(Bg + off);
            v4u o; float ylo8[4], yhi8[4];
#pragma unroll
            for (int q = 0; q < 4; ++q) {
                const float ylo = bflo(bg[q]) * (w0[2 * q] * bflo(vm2[q]) + w1[2 * q] * bflo(vm1[q]) + w2[2 * q] * bflo(v[q]));
                const float yhi = bfhi(bg[q]) * (w0[2 * q + 1] * bfhi(vm2[q]) + w1[2 * q + 1] * bfhi(vm1[q]) + w2[2 * q + 1] * bfhi(v[q]));
                o[q] = pk2(ylo, yhi); if (WOUT_FP8) { ylo8[q] = ylo; yhi8[q] = yhi; } }
            if (WOUT_FP8) { v2u w8; w8.x = pk_fp8x4((f32x4){ylo8[0], yhi8[0], ylo8[1], yhi8[1]} * F8_SH); w8.y = pk_fp8x4((f32x4){ylo8[2], yhi8[2], ylo8[3], yhi8[3]} * F8_SH); *(v2u*)((unsigned char*)Y + off) = w8; }
            else *(v4u*)(Y + off) = o;
            vm2 = vm1; vm1 = v;
        }
    }
}

__device__ __forceinline__ void bias_gemv(const Args& a, int gw, int NGW, int lane) {
    unsigned char* ws = a.ws; const float* MF = (const float*)(ws + WS_MODF); float* BV = (float*)(ws + WS_BIASV);
    constexpr int NROW = 2 * FF + QKVP, RPW = 5;
    for (int base = 0; base < NROW; base += RPW * NGW) {
    float res[RPW][NB];
#pragma unroll
    for (int i = 0; i < RPW; ++i) {
        const int r = base + gw + i * NGW; const bool ok = r < NROW; const int rr = ok ? r : 0;
        const int ls = rr < 2 * FF ? 1 : 2, np = ls == 1 ? rr : rr - 2 * FF;
        float wf[16];
        if ((ls == 1 && DENSE_GU_FP8) || (ls == 2 && QKV_I8)) { const v4u w8 = *(const v4u*)(ws + (ls == 1 ? WS_WFGU : WS_WQKV) + (size_t)np * D + 16 * lane);
#pragma unroll
            for (int q = 0; q < 4; ++q) {
                if (GU_I8 || ls == 2) { const int w = (int)w8[q]; wf[4 * q] = (float)((w << 24) >> 24) * (1.0f / GU_SW); wf[4 * q + 1] = (float)((w << 16) >> 24) * (1.0f / GU_SW); wf[4 * q + 2] = (float)((w << 8) >> 24) * (1.0f / GU_SW); wf[4 * q + 3] = (float)(w >> 24) * (1.0f / GU_SW); }
                else { wf[4 * q] = __builtin_amdgcn_cvt_f32_fp8((int)w8[q], 0) * (1.0f / GU_SW); wf[4 * q + 1] = __builtin_amdgcn_cvt_f32_fp8((int)w8[q], 1) * (1.0f / GU_SW);
                    wf[4 * q + 2] = __builtin_amdgcn_cvt_f32_fp8((int)w8[q], 2) * (1.0f / GU_SW); wf[4 * q + 3] = __builtin_amdgcn_cvt_f32_fp8((int)w8[q], 3) * (1.0f / GU_SW); } } }
        else { const bf16* wrow = (ls == 1 ? (const bf16*)(ws + WS_WFGU) : (const bf16*)(ws + WS_WQKV)) + (size_t)np * D + 16 * lane;
            const v4u w0 = *(const v4u*)wrow, w1 = *(const v4u*)(wrow + 8);
#pragma unroll
            for (int q = 0; q < 4; ++q) { wf[2 * q] = bflo(w0[q]); wf[2 * q + 1] = bfhi(w0[q]); wf[8 + 2 * q] = bflo(w1[q]); wf[8 + 2 * q + 1] = bfhi(w1[q]); } }
#pragma unroll
        for (int b = 0; b < NB; ++b) { const float* sh = MF + (size_t)(ls * 4 + b) * 3072 + 16 * lane; float p = 0.f;
#pragma unroll
            for (int q = 0; q < 4; ++q) { const f32x4 s4 = *(const f32x4*)(sh + 4 * q); p += (wf[4 * q] * s4.x + wf[4 * q + 1] * s4.y) + (wf[4 * q + 2] * s4.z + wf[4 * q + 3] * s4.w); }
            res[i][b] = wave_sum(p); }
    }
#pragma unroll
    for (int i = 0; i < RPW; ++i) { const int r = base + gw + i * NGW;
        if (r < NROW && lane == 0) { const int ls = r < 2 * FF ? 1 : 2, np = ls == 1 ? r : r - 2 * FF;
#pragma unroll
            for (int b = 0; b < NB; ++b) BV[(size_t)((ls - 1) * 4 + b) * (2 * FF) + np] = res[i][b]; } }
    }
}
typedef float f32x16 __attribute__((ext_vector_type(16)));
typedef short bf16x8 __attribute__((ext_vector_type(8)));
typedef short v4i16_t __attribute__((ext_vector_type(4)));
constexpr int ATT_TILES = NB * NH * 256;
constexpr int KROWB = 144;
constexpr int VROWB = 192;
template <int PASS>
__device__ __forceinline__ void attn_mfma(const Args& a, LAS unsigned char* lds, int gw, int NGW, int wave, int lane) {
    unsigned char* ws = a.ws;
    const bf16* QKV = (const bf16*)(ws + WS_QKV); bf16* AO = (bf16*)(ws + WS_H); float* LSE = (float*)(ws + WS_LSE);
    const int r32 = lane & 31, hi = lane >> 5;
    LAS unsigned char* vbuf = lds + wave * (32 * VROWB + 32 * KROWB);
    LAS unsigned char* kbuf = vbuf + 32 * VROWB;
    const int L16 = lane & 15, tq = L16 >> 2, tp = L16 & 3, gi = (lane >> 4) & 1;
    LAS unsigned char* trbase = vbuf + (4 * hi + tq) * VROWB + (16 * gi + 4 * tp) * 2;
    const bool OWNER = (NGW == 2048);
    const int ntl = OWNER ? NH * 128 : ATT_TILES, tstep = OWNER ? 256 : NGW;
    for (int lt = OWNER ? ((int)blockIdx.x >> 3) * NWAVES + wave : gw; lt < ntl; lt += tstep) {
        int tile = lt;
        if (OWNER) { const int x = (int)blockIdx.x & 7, hq_ = lt >> 7, tl = lt & 127, sh_ = 2 * (hq_ / 5), hb = 128 >> sh_;
            tile = ((tl >> (7 - sh_)) << (8 - sh_)) + (x & 1) * hb + (tl & (hb - 1)) + 256 * ((x >> 1) * NH + hq_); }
        const int ti = tile & 255, bh = tile >> 8, b = bh / NH, hq = bh - b * NH, g = hq / 5, slot = hq - g * 5;
        const int sh = 2 * g, r = 1 << sh, nblk = 256 >> sh, rho = ti >> (8 - sh), blk = ti & (nblk - 1), i0 = 32 * blk;
        const size_t tok0 = (size_t)b * SEQ + rho;
        const bf16* Qp = QKV + (tok0 + (size_t)r * (i0 + r32)) * QKVP + hq * 64 + 8 * hi;
        bf16x8 qf[4];
#pragma unroll
        for (int ds = 0; ds < 4; ++ds) qf[ds] = *(const bf16x8*)(Qp + 16 * ds);
        const int nkb = blk + 1 < 5 ? blk + 1 : 5;
        float m_run = -1e30f, l_run = 0.f, LT = 0.f;
        f32x16 o0 = {}, o1 = {};
        if (PASS == 1) { const float* lp = LSE + (tok0 + (size_t)r * (i0 + r32)) * 16 + slot; const float l0 = lp[0], l1 = lp[5], l2 = lp[10];
            const float mm = fmaxf(fmaxf(l0, l1), l2);
            LT = mm + __builtin_amdgcn_logf(__builtin_amdgcn_exp2f(l0 - mm) + __builtin_amdgcn_exp2f(l1 - mm) + __builtin_amdgcn_exp2f(l2 - mm)); }
        v4u krn[4], vrn[4];
#define ATT_LOAD(jj) do { const int p0_ = i0 + 32 * ((jj) - (nkb - 1)); \
            _Pragma("unroll") for (int c = 0; c < 4; ++c) { const int pi = lane + 64 * c, row = pi >> 3, chunk = pi & 7; const bf16* rp_ = QKV + (tok0 + (size_t)r * (p0_ + row)) * QKVP + 8 * chunk; \
                krn[c] = *(const v4u*)(rp_ + (NH + hq) * 64); if (PASS == 1) vrn[c] = *(const v4u*)(rp_ + (2 * NH + hq) * 64); } } while (0)
        ATT_LOAD(0);
        for (int j = 0; j < nkb; ++j) {
            const int kb = j - (nkb - 1);
            bf16x8 kf[4]; v4u vraw[4];
#pragma unroll
            for (int c = 0; c < 4; ++c) { const int pi = lane + 64 * c, row = pi >> 3, chunk = pi & 7; *(LAS v4u*)(kbuf + row * KROWB + chunk * 16) = krn[c]; }
            if (PASS == 1) {
#pragma unroll
                for (int c = 0; c < 4; ++c) vraw[c] = vrn[c]; }
            if (j + 1 < nkb) ATT_LOAD(j + 1);
#pragma unroll
            for (int ds = 0; ds < 4; ++ds) kf[ds] = *(const LAS bf16x8*)(kbuf + r32 * KROWB + (16 * ds + 8 * hi) * 2);
            f32x16 s = {};
#pragma unroll
            for (int ds = 0; ds < 4; ++ds) s = __builtin_amdgcn_mfma_f32_32x32x16_bf16(kf[ds], qf[ds], s, 0, 0, 0);
            if (kb == 0) {
#pragma unroll
                for (int q = 0; q < 16; ++q) { const int c = (q & 3) + 8 * (q >> 2) + 4 * hi; if (c > r32) s[q] = -1e30f; }
            } else if (kb == -4) {
#pragma unroll
                for (int q = 0; q < 16; ++q) { const int c = (q & 3) + 8 * (q >> 2) + 4 * hi; if (c < r32) s[q] = -1e30f; }
            }
            if (PASS == 0) {
                float bm = s[0];
#pragma unroll
                for (int q = 1; q < 16; ++q) bm = fmaxf(bm, s[q]);
                const float mn = fmaxf(m_run, bm); float acc = 0.f;
#pragma unroll
                for (int q = 0; q < 16; ++q) acc += __builtin_amdgcn_exp2f(s[q] - mn);
                l_run = l_run * __builtin_amdgcn_exp2f(m_run - mn) + acc; m_run = mn;
            } else {
#pragma unroll
                for (int c = 0; c < 4; ++c) { const int pi = lane + 64 * c, row = pi >> 3, chunk = pi & 7; *(LAS v4u*)(vbuf + row * VROWB + chunk * 16) = vraw[c]; }
                v4u pw0, pw1;
                { float p[16];
#pragma unroll
                  for (int q = 0; q < 16; ++q) p[q] = __builtin_amdgcn_exp2f(s[q] - LT);
                  pw0.x = pg8::cvt_pk_bf16(p[0], p[1]); pw0.y = pg8::cvt_pk_bf16(p[2], p[3]); pw0.z = pg8::cvt_pk_bf16(p[4], p[5]); pw0.w = pg8::cvt_pk_bf16(p[6], p[7]);
                  pw1.x = pg8::cvt_pk_bf16(p[8], p[9]); pw1.y = pg8::cvt_pk_bf16(p[10], p[11]); pw1.z = pg8::cvt_pk_bf16(p[12], p[13]); pw1.w = pg8::cvt_pk_bf16(p[14], p[15]); }
                const bf16x8 pa0 = __builtin_bit_cast(bf16x8, pw0), pa1 = __builtin_bit_cast(bf16x8, pw1);
#pragma unroll
                for (int db = 0; db < 2; ++db) {
                    bf16x8 vb[2];
#pragma unroll
                    for (int s2 = 0; s2 < 2; ++s2) {
                        const v4i16_t lo = __builtin_amdgcn_ds_read_tr16_b64_v4i16((LAS v4i16_t*)(trbase + (16 * s2) * VROWB + 64 * db));
                        const v4i16_t hh = __builtin_amdgcn_ds_read_tr16_b64_v4i16((LAS v4i16_t*)(trbase + (16 * s2 + 8) * VROWB + 64 * db));
                        vb[s2] = (bf16x8){lo[0], lo[1], lo[2], lo[3], hh[0], hh[1], hh[2], hh[3]};
                    }
                    if (db == 0) { o0 = __builtin_amdgcn_mfma_f32_32x32x16_bf16(pa0, vb[0], o0, 0, 0, 0); o0 = __builtin_amdgcn_mfma_f32_32x32x16_bf16(pa1, vb[1], o0, 0, 0, 0); }
                    else         { o1 = __builtin_amdgcn_mfma_f32_32x32x16_bf16(pa0, vb[0], o1, 0, 0, 0); o1 = __builtin_amdgcn_mfma_f32_32x32x16_bf16(pa1, vb[1], o1, 0, 0, 0); }
                }
            }
        }
        if (PASS == 0) {
            const float m2 = __shfl_xor(m_run, 32), l2 = __shfl_xor(l_run, 32);
            const float mt = fmaxf(m_run, m2), lt = l_run * __builtin_amdgcn_exp2f(m_run - mt) + l2 * __builtin_amdgcn_exp2f(m2 - mt);
            if (hi == 0) LSE[(tok0 + (size_t)r * (i0 + r32)) * 16 + hq] = mt + __builtin_amdgcn_logf(lt);
        } else {
#pragma unroll
            for (int q = 0; q < 16; ++q) { const int c = (q & 3) + 8 * (q >> 2) + 4 * hi;
                if (WO_FP8) { unsigned char* op8 = (unsigned char*)AO + (tok0 + (size_t)r * (i0 + c)) * D + hq * 64 + r32;
                    op8[0] = (unsigned char)(pk_fp8x4((f32x4){o0[q] * F8_SO, 0.f, 0.f, 0.f}) & 0xffu); op8[32] = (unsigned char)(pk_fp8x4((f32x4){o1[q] * F8_SO, 0.f, 0.f, 0.f}) & 0xffu); }
                else { bf16* op = AO + (tok0 + (size_t)r * (i0 + c)) * D + hq * 64 + r32; op[0] = (bf16)f2bf(o0[q]); op[32] = (bf16)f2bf(o1[q]); } }
            if (hq == 0) {
#pragma unroll
                for (int c = 0; c < 4; ++c) { const int pi = lane + 64 * c, row = pi >> 3, chunk = pi & 7;
                    if (WO_FP8) { if (chunk < 4) *(v4u*)((unsigned char*)AO + (tok0 + i0 + row) * D + 960 + 16 * chunk) = (v4u){0u, 0u, 0u, 0u}; }
                    else *(v4u*)(AO + (tok0 + i0 + row) * D + 960 + 8 * chunk) = (v4u){0u, 0u, 0u, 0u}; }
            }
        }
    }
}

__device__ __forceinline__ void final_norm_phase(const Args& a, int gw, int NGW, int lane) {
    const bf16* XR = (const bf16*)(a.ws + WS_XR); const bf16* Y1 = (const bf16*)(a.ws + WS_Y1);
    f32x4 g[4];
#pragma unroll
    for (int j = 0; j < 4; ++j) g[j] = *((const f32x4*)a.final_g + lane + 64 * j);
    for (int row0 = gw; row0 < M; row0 += 2 * NGW) {
        v2u vv[2][4], yy[2][4];
#pragma unroll
        for (int q = 0; q < 2; ++q) { const int row = row0 + q * NGW; if (row < M) { const v2u* xr = (const v2u*)(XR + (size_t)row * D) + lane; const v2u* yr = (const v2u*)(Y1 + (size_t)row * D) + lane;
#pragma unroll
            for (int j = 0; j < 4; ++j) { vv[q][j] = xr[64 * j]; yy[q][j] = yr[64 * j]; } } }
#pragma unroll
        for (int q = 0; q < 2; ++q) { const int row = row0 + q * NGW; if (row < M) { f32x4* xo = (f32x4*)(a.out + (size_t)row * D) + lane; f32x4 v[4]; float s = 0.f;
#pragma unroll
            for (int j = 0; j < 4; ++j) { v[j] = (f32x4){bflo(vv[q][j].x) + bflo(yy[q][j].x), bfhi(vv[q][j].x) + bfhi(yy[q][j].x), bflo(vv[q][j].y) + bflo(yy[q][j].y), bfhi(vv[q][j].y) + bfhi(yy[q][j].y)};
                s += (v[j].x * v[j].x + v[j].y * v[j].y) + (v[j].z * v[j].z + v[j].w * v[j].w); }
            const float rinv = 1.0f / sqrtf(wave_sum(s) * (1.0f / D) + RMS_EPS);
#pragma unroll
            for (int j = 0; j < 4; ++j) xo[64 * j] = v[j] * rinv * g[j]; } }
    }
}

constexpr int NPHASE = 15;
__global__ void __launch_bounds__(NTHR, 2) trunk_fwd(Args args) {
    extern __shared__ __attribute__((aligned(16))) unsigned char lds_raw[];
    LAS unsigned char* lds = (LAS unsigned char*)lds_raw;
    volatile LAS unsigned* MISC = (volatile LAS unsigned*)(lds + MISC_OFF);
    const int tid = threadIdx.x, lane = tid & 63, wave = __builtin_amdgcn_readfirstlane(tid >> 6);
    const int G = gridDim.x; const int bx = blockIdx.x; const int vcu = (G % 8 == 0) ? (bx % 8) * (G / 8) + bx / 8 : bx;
    const int gw = vcu * NWAVES + wave, NGW = G * NWAVES;
    unsigned char* ws = args.ws;
    unsigned* ctl = (unsigned*)(ws + WS_CTL);
    if (tid < 256) ((LAS unsigned*)(lds + LDSCTL_OFF))[tid] = 0u;
    __syncthreads();
    XcdBarrier bar; bar.bar = ctl + CW_BAR; bar.x = 0; bar.st = nullptr;
    if (!MK_PER_PHASE) bar = xcd_barrier_post(ctl + CW_BAR, MISC + 8);
    if (!MK_PER_PHASE && tid == 0) __hip_atomic_fetch_or(ctl + CW_XMAP + (bx & 7), 1u << bar.x, __ATOMIC_RELAXED, __HIP_MEMORY_SCOPE_AGENT);
    bool local_ok = false;
    const int lo = args.ph_lo, hi = args.ph_hi;
#define IN(k) (lo <= (k) && (k) < hi)
#ifndef LOCAL_SEAMS
#define LOCAL_SEAMS 0x772u
#endif
#define SEAM(k) do { if (IN(k) && IN((k) + 1)) { if (((LOCAL_SEAMS >> (k)) & 1u) && local_ok) xcd_barrier_local(bar); else xcd_barrier(bar); } } while (0)
#define Hb ((bf16*)(ws + WS_H))
#define MF ((const float*)(ws + WS_MODF))

#ifndef PROBE_DUP
#define PROBE_DUP 0u
#endif
#ifndef PROBE_REP
#define PROBE_REP 1
#endif
#ifndef NOPH_MASK
#define NOPH_MASK 0u
#endif
#define RUN(k, body) do { if (IN(k) && !((NOPH_MASK >> (k)) & 1u)) { body; if ((PROBE_DUP >> (k)) & 1u) { _Pragma("unroll") for (int rep_ = 0; rep_ < PROBE_REP; ++rep_) { xcd_barrier(bar); body; } } } SEAM(k); } while (0)
#define COMMA ,
#define PH_GEMM(EPI, ORD, Aptr, Bptr, Mv, Nv, Kv, ...) do { pg8::Gemm g{Aptr, Bptr, Mv, Nv, Kv}; pg8::StaticOrder S; S.init(Mv, Nv, G, bx); EPI E{__VA_ARGS__}; \
        pg8::gemm_phase<EPI, pg8::StaticOrder, true, true>(lds, g, S, E); } while (0)
#define MOE_GU() do { pg8::MoeOrder S; S.init(ctl + CW_CNT, 2 * FF / 256, G, bx, (const int*)(ws + WS_RT2)); \
        pg8::Gemm g{Hb, (const bf16*)(ws + WS_WMGU), 0, 0, D}; EpiSwiGLU8 E{ws + WS_MHID, 2 * FF / 256}; \
        pg8::gemm_phase<EpiSwiGLU8, pg8::MoeOrder, true, true, true, 1, (MOE_I8 != 0)>(lds, g, S, E, lds + TOKSLOT_OFF); } while (0)
#define ZGp ((const float*)(ws + WS_ZG))
#define MOE_DN() do { pg8::MoeOrderId S; S.init(ctl + CW_CNT, D / 256, G, bx, (const int*)(ws + WS_IDENT), true); \
        LAS float* gt = (LAS float*)(lds + GATE_OFF); for (int i_ = tid; i_ < NB * D; i_ += NTHR) gt[i_] = MF[(size_t)(3 * 4 + (i_ >> 10)) * 3072 + 2048 + (i_ & (D - 1))]; __syncthreads(); \
        pg8::Gemm g{(const bf16*)(ws + WS_MHID), (const bf16*)(ws + WS_WMD), 0, 0, FF}; \
        EpiMoeDown E{XRp, (bf16*)(ws + WS_Y1), (const int*)(ws + WS_RT2), (const float*)(ws + WS_RW2), gt, 1.0f / (F8_SH * F8_SW), lds + RED_OFF}; \
        pg8::gemm_phase<EpiMoeDown, pg8::MoeOrderId, true, true, true, 1>(lds, g, S, E, lds + TOKSLOT_OFF); } while (0)
#define PH_GEMM8(EPI, I8v, Aptr, Bptr, Mv, Nv, Kv, ...) do { pg8::Gemm g{Aptr, Bptr, Mv, Nv, Kv}; pg8::StaticOrder S; S.init(Mv, Nv, G, bx, (const int*)(ws + WS_IDENT)); EPI E{__VA_ARGS__}; \
        pg8::gemm_phase<EPI, pg8::StaticOrder, true, true, true, 1, I8v>(lds, g, S, E, lds + TOKSLOT_OFF); } while (0)
#define SSb ((float*)(ws + WS_SS))
#define BV ((const float*)(ws + WS_BIASV))
    RUN(0, p0_prologue(args, lds, gw, NGW, wave, lane, tid));
    if (!MK_PER_PHASE && LOCAL_SEAMS && IN(0) && IN(1) && G == 256) {
        unsigned all = 0u; bool one = true;
#pragma unroll
        for (int j = 0; j < 8; ++j) { const unsigned m = xb_ld(ctl + CW_XMAP + j); one = one && (__builtin_popcount(m) == 1); all |= m; }
        local_ok = one && (__builtin_popcount(all) == 8) && (MISC[8] == 32u);
    }
    RUN(1, (norm_phase<true, false, false, (CONVIN_I8 != 0)>(args, args.x, 0, lds, G, wave, lane, tid)));
#if CONVIN_I8
    RUN(2, PH_GEMM8(EpiConvInT<true>, true, Hb, (const bf16*)(ws + WS_WCIN), M, 3072, D, (bf16*)(ws + WS_V), (bf16*)(ws + WS_BG)));
#else
    RUN(2, PH_GEMM(EpiConvIn, 0, Hb, (const bf16*)(ws + WS_WCIN), M, 3072, D, (bf16*)(ws + WS_V), (bf16*)(ws + WS_BG)));
#endif
#ifdef PROBE_NULLGEMM_K
    if (IN(2)) { xcd_barrier(bar); PH_GEMM(EpiNull, 0, Hb, (const bf16*)(ws + WS_WCIN), M, PROBE_NULLGEMM_N, PROBE_NULLGEMM_K); xcd_barrier(bar); }
#endif
    RUN(3, { conv_phase(args, G, tid); bias_gemv(args, gw, NGW, lane); });
#define XRp ((bf16*)(ws + WS_XR))
#define XB4p ((bf16*)args.out)
#if WOUT_FP8
    RUN(4, PH_GEMM8(EpiResidB<false COMMA true COMMA (DENSE_GU_FP8 != 0)>, false, Hb, (const bf16*)(ws + WS_WCOUT), M, D, D, XRp, XRp, MF + 0 * 4 * 3072 + 2048, XB4p, SSb, MF + 1 * 4 * 3072 + 1024, args.norm_g + 1 * D, (LAS float*)(lds + RED_OFF), 1.0f / (F8_SH * F8_SW)));
#else
    RUN(4, PH_GEMM(EpiResidB<false COMMA true COMMA (DENSE_GU_FP8 != 0)>, 0, Hb, (const bf16*)(ws + WS_WCOUT), M, D, D, XRp, XRp, MF + 0 * 4 * 3072 + 2048, XB4p, SSb, MF + 1 * 4 * 3072 + 1024, args.norm_g + 1 * D, (LAS float*)(lds + RED_OFF), 1.0f));
#endif
#if DENSE_GU_FP8
    RUN(5, PH_GEMM8(EpiSwiGLU<true COMMA true COMMA (DENSE_DOWN_FP8 != 0)>, (GU_I8 != 0), XB4p, (const bf16*)(ws + WS_WFGU), M, 2 * FF, D, (bf16*)(ws + WS_HID), 2 * FF / 256, SSb, BV, lds + GATE_OFF));
#else
    RUN(5, PH_GEMM(EpiSwiGLU<true COMMA false COMMA (DENSE_DOWN_FP8 != 0)>, 0, XB4p, (const bf16*)(ws + WS_WFGU), M, 2 * FF, D, (bf16*)(ws + WS_HID), 2 * FF / 256, SSb, BV, lds + GATE_OFF));
#endif
#if DENSE_DOWN_FP8
    RUN(6, PH_GEMM8(EpiResidB<false COMMA true COMMA (QKV_I8 != 0)>, false, (const bf16*)(ws + WS_HID), (const bf16*)(ws + WS_WFD), M, D, FF, XRp, XRp, MF + 1 * 4 * 3072 + 2048, Hb, SSb, MF + 2 * 4 * 3072 + 1024, args.norm_g + 2 * D, (LAS float*)(lds + RED_OFF), 1.0f / (F8_SH * F8_SW)));
#else
    RUN(6, PH_GEMM(EpiResidB<false COMMA true>, 0, (const bf16*)(ws + WS_HID), (const bf16*)(ws + WS_WFD), M, D, FF, XRp, XRp, MF + 1 * 4 * 3072 + 2048, Hb, SSb, MF + 2 * 4 * 3072 + 1024, args.norm_g + 2 * D, (LAS float*)(lds + RED_OFF), 1.0f));
#endif
#if QKV_I8
    RUN(7, PH_GEMM8(EpiQkvRopeT<true>, true, Hb, (const bf16*)(ws + WS_WQKV), M, QKVP, D, (bf16*)(ws + WS_QKV), (const unsigned*)(ws + WS_ROPE), SSb, BV + 4 * 2 * FF, lds + GATE_OFF));
#else
    RUN(7, PH_GEMM(EpiQkvRope, 0, Hb, (const bf16*)(ws + WS_WQKV), M, QKVP, D, (bf16*)(ws + WS_QKV), (const unsigned*)(ws + WS_ROPE), SSb, BV + 4 * 2 * FF, lds + GATE_OFF));
#endif
    RUN(8, attn_mfma<0>(args, lds, gw, NGW, wave, lane));
    RUN(9, attn_mfma<1>(args, lds, gw, NGW, wave, lane));
#if WO_FP8
    RUN(10, PH_GEMM8(EpiResidB<false COMMA false>, false, Hb, (const bf16*)(ws + WS_WO), M, D, D, XRp, XRp, MF + 2 * 4 * 3072 + 2048, nullptr, nullptr, nullptr, nullptr, nullptr, 1.0f / (F8_SO * F8_SW)));
#else
    RUN(10, PH_GEMM(EpiResidB<false COMMA false>, 0, Hb, (const bf16*)(ws + WS_WO), M, D, D, XRp, XRp, MF + 2 * 4 * 3072 + 2048, nullptr, nullptr, nullptr, nullptr, nullptr, 1.0f));
#endif
    RUN(11, (norm_phase<false, true, true>(args, XRp, 3, lds, G, wave, lane, tid)));
    RUN(12, MOE_GU());
    RUN(13, MOE_DN());
    RUN(14, final_norm_phase(args, gw, NGW, lane));
#ifdef PROBE_XBAR
    for (int q = 0; q < PROBE_XBAR; ++q) xcd_barrier(bar);
#endif
#undef IN
#undef SEAM
}

extern "C" void kernel_launch(void* const* d_in, const int* in_sizes, int n_in, void* d_out, int out_size, void* d_ws, size_t ws_size, hipStream_t stream) {
    static int grid = 0;
    if (grid == 0) {
        if (n_in != 19 || out_size != M * D || ws_size < WS_END) { fprintf(stderr, "kernel_launch: unexpected shapes (n_in %d out %d ws %zu)\n", n_in, out_size, ws_size); grid = -1; return; }
        int dev = 0, cus = 0, per_cu = 0;
        if (hipGetDevice(&dev) != hipSuccess || hipDeviceGetAttribute(&cus, hipDeviceAttributeMultiprocessorCount, dev) != hipSuccess) { grid = -1; return; }
        if (hipFuncSetAttribute((const void*)trunk_fwd, hipFuncAttributeMaxDynamicSharedMemorySize, LDS_BYTES) != hipSuccess) { fprintf(stderr, "kernel_launch: hipFuncSetAttribute failed\n"); grid = -1; return; }
        if (hipOccupancyMaxActiveBlocksPerMultiprocessor(&per_cu, (const void*)trunk_fwd, NTHR, LDS_BYTES) != hipSuccess || per_cu < 1) fprintf(stderr, "kernel_launch: occupancy query reports %d\n", per_cu);
        (void)hipGetLastError();
        grid = cus;
    }
    if (grid < 0) return;
    (void)hipMemsetAsync((char*)d_ws + WS_CTL, 0, CTL_ZERO_BYTES, stream);
    Args a{};
    a.x = (const float*)d_in[0]; a.c = (const float*)d_in[1]; a.pos = (const int*)d_in[2]; a.mod_w = (const float*)d_in[3]; a.mod_b = (const float*)d_in[4]; a.norm_g = (const float*)d_in[5];
    a.conv_w_in = (const float*)d_in[6]; a.conv_w = (const float*)d_in[7]; a.conv_w_out = (const float*)d_in[8]; a.ffn_g = (const float*)d_in[9]; a.ffn_u = (const float*)d_in[10]; a.ffn_d = (const float*)d_in[11];
    a.w_qkv = (const float*)d_in[12]; a.w_o = (const float*)d_in[13]; a.router_w = (const float*)d_in[14]; a.moe_g = (const float*)d_in[15]; a.moe_u = (const float*)d_in[16]; a.moe_d = (const float*)d_in[17]; a.final_g = (const float*)d_in[18];
    a.out = (float*)d_out; a.ws = (unsigned char*)d_ws;
#if MK_PER_PHASE
    for (int p = 0; p < NPHASE; ++p) { a.ph_lo = p; a.ph_hi = p + 1; hipLaunchKernelGGL(trunk_fwd, dim3(grid), dim3(NTHR), LDS_BYTES, stream, a); }
#else
    a.ph_lo = 0; a.ph_hi = NPHASE; hipLaunchKernelGGL(trunk_fwd, dim3(grid), dim3(NTHR), LDS_BYTES, stream, a);
#endif
}
```

```cpp
#include <hip/hip_runtime.h>
#include <cstdio>
#include <cstdint>

#ifndef DENSE_GU_FP8
#define DENSE_GU_FP8 1
#endif
#ifndef ATTN_ONE_PASS
#define ATTN_ONE_PASS 1
#endif
#ifndef MOE_I8
#define MOE_I8 0
#endif
#ifndef GU_I8
#define GU_I8 1
#endif
#ifndef CONVIN_I8
#define CONVIN_I8 0
#endif
#ifndef QKV_I8
#define QKV_I8 1
#endif
#ifndef WO_FP8
#define WO_FP8 1
#endif
#ifndef WOUT_FP8
#define WOUT_FP8 0
#endif
#ifndef DENSE_DOWN_FP8
#define DENSE_DOWN_FP8 1
#endif
#ifndef MK_PER_PHASE
#define MK_PER_PHASE 0
#endif

namespace pg8 {
#define PG8_LAS __attribute__((address_space(3)))
typedef unsigned short bf16_t;
typedef short bf16x8 __attribute__((ext_vector_type(8)));
typedef float f32x4 __attribute__((ext_vector_type(4)));
typedef unsigned u32x4 __attribute__((ext_vector_type(4)));
constexpr int BM = 256, BK = 64, HALF = 128, HTB = HALF * BK * 2, STAGE_BYTES = 8 * HTB, NXCD = 8, WGM = 8;

__host__ __device__ __forceinline__ int lds_byte(int r, int c) { const int st = (r >> 4) * 2 + (c >> 5), rr = r & 15, cc = c & 31, ob = rr * 64 + cc * 2; return st * 1024 + (ob ^ (((ob >> 9) & 1) << 5)); }
__host__ __device__ __forceinline__ void stage_rc(int b, int& R, int& C) { const int st = b / 1024, sb = b % 1024, swz = sb ^ (((sb >> 9) & 1) << 5); R = (st >> 1) * 16 + swz / 64; C = (st & 1) * 32 + (swz % 64) / 2; }
__host__ __device__ __forceinline__ int perm32(int rho) { const int n = rho >> 4, i = rho & 15; return 8 * (i >> 2) + 4 * n + (i & 3); }

struct Unit { int pm, pn, k, nv, g, sp; };
struct Gemm { const bf16_t* A; const bf16_t* Bt; int M, N, K; };

struct StaticOrder {
    static constexpr bool IDROWS = true;
    int nM, nN, nwg, G, c; const int* ident;
    __host__ __device__ void init(int M, int N, int G_, int c_, const int* id = nullptr) { nM = M / BM; nN = N / BM; nwg = nM * nN; G = G_; c = c_; ident = id; }
    __host__ __device__ bool next(int i, Unit& u) const {
        const long L = (long)i * G + c; if (L >= nwg) return false;
        int wgid = (int)L; { const int q = nwg / NXCD, r = nwg % NXCD, xcd = wgid % NXCD, off = wgid / NXCD; wgid = (xcd < r ? xcd * (q + 1) : r * (q + 1) + (xcd - r) * q) + off; }
        const int nig = WGM * nN, gid = wgid / nig, fm = gid * WGM, gsz = (nM - fm) < WGM ? (nM - fm) : WGM;
        u.pm = fm + ((wgid % nig) % gsz); u.pn = (wgid % nig) / gsz; u.nv = 256; return true;
    }
    __device__ __forceinline__ const int* tokens(const Unit& u) const { return ident + 256 * u.pm; }
    __device__ __forceinline__ void a_ready(const Unit&) const {}
    __device__ __forceinline__ void done(const Unit&) const {}
};
struct RepeatOrder : StaticOrder { int nrep;
    __host__ __device__ bool next(int i, Unit& u) const { if (i >= nrep) return false; return StaticOrder::next(0, u); } };
template <bool IDENT> struct MoeOrderT {
    static constexpr bool IDROWS = IDENT;
    int nM, nN, nwg, G, c; int nt[16]; const int* rowtok; bool ident;
    static constexpr int MTOK = 32768;
    __device__ __forceinline__ void init(unsigned* cnt, int nN_, int G_, int c_, const int* rt, bool ident_ = false) {
        ident = ident_;
        int b = 0;
#pragma unroll
        for (int q = 0; q < 16; ++q) { const int ne = __builtin_amdgcn_readfirstlane((int)__hip_atomic_load(cnt + q, __ATOMIC_RELAXED, __HIP_MEMORY_SCOPE_AGENT)); nt[q] = ne | (b << 16); b += (ne + 255) >> 8; }
        nM = b; nN = nN_; nwg = nM * nN; G = G_; c = c_; rowtok = rt;
    }
    __device__ __forceinline__ bool next(int i, Unit& u) const {
        const long L = (long)i * G + c; if (L >= nwg) return false;
        int wgid = (int)L; { const int q = nwg / NXCD, r = nwg % NXCD, xcd = wgid % NXCD, off = wgid / NXCD; wgid = (xcd < r ? xcd * (q + 1) : r * (q + 1) + (xcd - r) * q) + off; }
        const int nig = WGM * nN, gid = wgid / nig, fm = gid * WGM, gsz = (nM - fm) < WGM ? (nM - fm) : WGM;
        const int pm = fm + ((wgid % nig) % gsz), pn = (wgid % nig) / gsz;
        int q0 = 0, sel = nt[0];
#pragma unroll
        for (int q = 1; q < 16; ++q) if (pm >= (nt[q] >> 16)) { q0 = q; sel = nt[q]; }
        u.pm = pm; u.pn = (q0 & 7) * nN + pn; u.g = q0; u.k = pm - (sel >> 16); const int rem = (sel & 0xffff) - 256 * u.k; u.nv = rem < 256 ? rem : 256; return true;
    }
    __device__ __forceinline__ const int* tokens(const Unit& u) const { return ident ? rowtok + 256 * u.pm : rowtok + (size_t)u.g * MTOK + 256 * u.k; }
    __device__ __forceinline__ void a_ready(const Unit&) const {}
    __device__ __forceinline__ void done(const Unit&) const {}
};
typedef MoeOrderT<false> MoeOrder; typedef MoeOrderT<true> MoeOrderId;

typedef int v8i_t __attribute__((ext_vector_type(8)));
typedef int v4i_t __attribute__((ext_vector_type(4)));
__device__ __forceinline__ v8i_t cat8(bf16x8 a, bf16x8 b) { const v4i_t x = __builtin_bit_cast(v4i_t, a), y = __builtin_bit_cast(v4i_t, b); return __builtin_shufflevector(x, y, 0, 1, 2, 3, 4, 5, 6, 7); }
__device__ __forceinline__ unsigned cvt_pk_bf16(float lo, float hi) { unsigned r; asm volatile("v_cvt_pk_bf16_f32 %0, %1, %2" : "=v"(r) : "v"(lo), "v"(hi)); return r; }

template <class Epi, class Sched, bool ALIGN_EPI = false, bool SP2 = false, bool GATHER = false, int ES = 2, bool I8 = false>
__device__ __forceinline__ void gemm_phase(PG8_LAS unsigned char* lds, const Gemm g, const Sched& S, const Epi& E, PG8_LAS unsigned char* tokslots = nullptr) {
    const int tid = threadIdx.x, wid = __builtin_amdgcn_readfirstlane(tid >> 6), lane = tid & 63, wr = wid >> 2, wc = wid & 3, fr = lane & 15, fq = lane >> 4;
    const int K = g.K, KB = K * ES  , nt = KB / (BK * 2);
    static_assert(!GATHER || SP2, "the gathering A path is written for the SP2 loop only");
    unsigned voffA[2], voffB[2];
#pragma unroll
    for (int i = 0; i < 2; ++i) { int R, C; stage_rc(tid * 16 + i * 8192, R, C); const int Rb = Epi::PERM ? ((R & ~31) + perm32(R & 31)) : R;
        voffA[i] = (unsigned)(R * KB + C * 2); voffB[i] = (unsigned)(Rb * KB + C * 2); }
    unsigned gcur[2][2] = {{0u, 0u}, {0u, 0u}};
    const size_t kstep = (size_t)(BK * 2);
    const size_t hstep = (size_t)HALF * KB;
    const size_t tstep = 2 * hstep;
    const unsigned ldsw = (unsigned)wid * 1024u;
    const int aoff = lds_byte(wr * 64 + fr, fq * 8), boff = lds_byte(wc * 32 + fr, fq * 8);
#define PG8_SA(b, h) (((b) * 2 + (h)) * HTB)
#define PG8_SB(b, h) ((4 + (b) * 2 + (h)) * HTB)
#define PG8_STAGE(bufoff, gbase, voff) do { _Pragma("unroll") for (int _i = 0; _i < 2; ++_i) \
        __builtin_amdgcn_global_load_lds((const unsigned*)((const char*)(gbase) + (voff)[_i]), (PG8_LAS unsigned*)(lds + (bufoff) + ldsw + _i * 8192), 16, 0, 0); } while (0)
#define PG8_STAGE_A(bufoff, kptr, half, ofs) do { if constexpr (GATHER) { _Pragma("unroll") for (int _i = 0; _i < 2; ++_i) \
        __builtin_amdgcn_global_load_lds((const unsigned*)((const char*)(kptr) + (ofs)[half][_i]), (PG8_LAS unsigned*)(lds + (bufoff) + ldsw + _i * 8192), 16, 0, 0); } \
        else { PG8_STAGE(bufoff, (const char*)(kptr) + (half) * hstep, voffA); } } while (0)
#define PG8_LDA(dst, b, h) do { _Pragma("unroll") for (int m = 0; m < 4; ++m) _Pragma("unroll") for (int k = 0; k < 2; ++k) dst[m][k] = *(const PG8_LAS bf16x8*)(lds + PG8_SA(b, h) + aoff + m * 2048 + k * 1024); } while (0)
#define PG8_LDB(dst, b, h) do { _Pragma("unroll") for (int n = 0; n < 2; ++n) _Pragma("unroll") for (int k = 0; k < 2; ++k) dst[n][k] = *(const PG8_LAS bf16x8*)(lds + PG8_SB(b, h) + boff + n * 2048 + k * 1024); } while (0)
#define PG8_MMA(ai, bj, At, Bt) do { __builtin_amdgcn_s_setprio(1); _Pragma("unroll") for (int m = 0; m < 4; ++m) _Pragma("unroll") for (int n = 0; n < 2; ++n) { \
        if constexpr (ES == 2) { _Pragma("unroll") for (int k = 0; k < 2; ++k) acc[ai][bj][m][n] = __builtin_amdgcn_mfma_f32_16x16x32_bf16(Bt[n][k], At[m][k], acc[ai][bj][m][n], 0, 0, 0); } \
        else if constexpr (I8) { _Pragma("unroll") for (int k = 0; k < 2; ++k) acc[ai][bj][m][n] = __builtin_bit_cast(f32x4, __builtin_amdgcn_mfma_i32_16x16x64_i8(__builtin_bit_cast(v4i_t, Bt[n][k]), __builtin_bit_cast(v4i_t, At[m][k]), __builtin_bit_cast(v4i_t, acc[ai][bj][m][n]), 0, 0, 0)); } \
        else { acc[ai][bj][m][n] = __builtin_amdgcn_mfma_scale_f32_16x16x128_f8f6f4(cat8(Bt[n][0], Bt[n][1]), cat8(At[m][0], At[m][1]), acc[ai][bj][m][n], 0, 0, 0, 0x7f7f7f7f, 0, 0x7f7f7f7f); } } \
        __builtin_amdgcn_s_setprio(0); } while (0)
#define PG8_WAIT_V(n) asm volatile("s_waitcnt vmcnt(" #n ")" ::: "memory")
#define PG8_WAIT_L(n) asm volatile("s_waitcnt lgkmcnt(" #n ")" ::: "memory")
#define PG8_BAR __builtin_amdgcn_s_barrier()
#define PG8_SCHED __builtin_amdgcn_sched_barrier(0)
    Unit cur, nxt; int ui = 0;
    if (!S.next(0, cur)) return;
    f32x4 acc[2][2][4][2];
#pragma unroll
    for (int a = 0; a < 2; ++a)
#pragma unroll
        for (int b = 0; b < 2; ++b)
#pragma unroll
            for (int m = 0; m < 4; ++m)
#pragma unroll
                for (int n = 0; n < 2; ++n) acc[a][b][m][n] = (f32x4){0.f, 0.f, 0.f, 0.f};
    bf16x8 At[4][2], B0[2][2], B1[2][2];
    const char* cA = GATHER ? (const char*)g.A : (const char*)g.A + (size_t)cur.pm * tstep; const char* cB = (const char*)g.Bt + (size_t)cur.pn * tstep;
    if constexpr (GATHER) { const int* tk = S.tokens(cur);
#pragma unroll
        for (int h = 0; h < 2; ++h)
#pragma unroll
            for (int i = 0; i < 2; ++i) { int R, C; stage_rc(tid * 16 + i * 8192, R, C); const int rl = h * HALF + R; int tok;
                if constexpr (Sched::IDROWS) tok = rl < cur.nv ? 256 * cur.pm + rl : 0; else tok = rl < cur.nv ? tk[rl] : 0;
                gcur[h][i] = (unsigned)tok * (unsigned)KB + (unsigned)C * 2u; } }
    S.a_ready(cur);
    if constexpr (SP2) {
        PG8_STAGE(PG8_SB(0, 0), cB, voffB); PG8_STAGE(PG8_SB(0, 1), cB + hstep, voffB); PG8_STAGE_A(PG8_SA(0, 0), cA, 0, gcur); PG8_STAGE_A(PG8_SA(0, 1), cA, 1, gcur);
        PG8_STAGE(PG8_SB(1, 0), cB + kstep, voffB); PG8_STAGE_A(PG8_SA(1, 0), cA + kstep, 0, gcur); PG8_STAGE(PG8_SB(1, 1), cB + hstep + kstep, voffB);
        if (wr == 1) PG8_BAR;
        PG8_WAIT_V(8); PG8_BAR;
        PG8_WAIT_V(6); PG8_BAR;
    } else {
        PG8_STAGE(PG8_SB(0, 0), cB, voffB); PG8_STAGE_A(PG8_SA(0, 0), cA, 0, gcur); PG8_STAGE(PG8_SB(0, 1), cB + hstep, voffB); PG8_STAGE_A(PG8_SA(0, 1), cA, 1, gcur);
        if (wr == 1) PG8_BAR;
        PG8_WAIT_V(4); PG8_BAR;
        PG8_STAGE(PG8_SB(1, 0), cB + kstep, voffB); PG8_STAGE_A(PG8_SA(1, 0), cA + kstep, 0, gcur); PG8_STAGE(PG8_SB(1, 1), cB + hstep + kstep, voffB);
        PG8_WAIT_V(6); PG8_BAR;
    }
    for (;;) {
        cur.sp = ui & 1;
        if constexpr (Epi::SIDE) E.side_issue(cur, wid, lane);
        const bool has_next = S.next(ui + 1, nxt);
        const char* nA = GATHER ? cA : (has_next ? (const char*)g.A + (size_t)nxt.pm * tstep : cA); const char* nB = has_next ? (const char*)g.Bt + (size_t)nxt.pn * tstep : cB;
        if constexpr (GATHER && !Sched::IDROWS) { if (has_next && wid < 4)
            __builtin_amdgcn_global_load_lds((const unsigned*)(S.tokens(nxt) + wid * 64 + lane), (PG8_LAS unsigned*)(tokslots + ((ui + 1) & 1) * 1024 + wid * 256), 4, 0, 0); }
#pragma unroll 1
        for (int t = 0; t < nt; t += 2) {
            const bool last = (t == nt - 2);
            const char* a1 = cA + (size_t)(t + 1) * kstep;
            const char* a2 = last ? nA : cA + (size_t)(t + 2) * kstep; const char* b2 = last ? nB : cB + (size_t)(t + 2) * kstep;
            const char* a3 = a2 + kstep; const char* b3 = b2 + kstep;
            if (last && has_next) S.a_ready(nxt);
            if constexpr (SP2) {
            PG8_LDB(B0, 0, 0); PG8_LDB(B1, 0, 1); PG8_SCHED; PG8_LDA(At, 0, 0); PG8_STAGE_A(PG8_SA(1, 1), a1, 1, gcur);
            if constexpr (GATHER) { if (last && has_next) {
#pragma unroll
                for (int h = 0; h < 2; ++h)
#pragma unroll
                    for (int i = 0; i < 2; ++i) { int R, C; stage_rc(tid * 16 + i * 8192, R, C); const int rl = h * HALF + R; int tok; if constexpr (Sched::IDROWS) tok = 256 * nxt.pm + rl; else tok = *(const PG8_LAS int*)(tokslots + ((ui + 1) & 1) * 1024 + rl * 4);
                        gcur[h][i] = (unsigned)(rl < nxt.nv ? tok : 0) * (unsigned)KB + (unsigned)C * 2u; } } }
            PG8_WAIT_V(8); PG8_WAIT_L(0); PG8_BAR; PG8_MMA(0, 0, At, B0); PG8_MMA(0, 1, At, B1); PG8_BAR; PG8_SCHED;
            PG8_LDA(At, 0, 1); PG8_STAGE(PG8_SB(0, 0), b2, voffB); PG8_STAGE(PG8_SB(0, 1), b2 + hstep, voffB); PG8_STAGE_A(PG8_SA(0, 0), a2, 0, gcur);
            PG8_WAIT_V(8); PG8_WAIT_L(0); PG8_BAR; PG8_MMA(1, 0, At, B0); PG8_MMA(1, 1, At, B1); PG8_BAR; PG8_SCHED;
            PG8_LDB(B0, 1, 0); PG8_LDB(B1, 1, 1); PG8_SCHED; PG8_LDA(At, 1, 0); PG8_STAGE_A(PG8_SA(0, 1), a2, 1, gcur);
            PG8_WAIT_V(8); PG8_WAIT_L(0); PG8_BAR; PG8_MMA(0, 0, At, B0); PG8_MMA(0, 1, At, B1); PG8_BAR; PG8_SCHED;
            PG8_LDA(At, 1, 1); PG8_STAGE(PG8_SB(1, 0), b3, voffB); PG8_STAGE(PG8_SB(1, 1), b3 + hstep, voffB); PG8_STAGE_A(PG8_SA(1, 0), a3, 0, gcur);
            PG8_WAIT_V(8); PG8_WAIT_L(0); PG8_BAR; PG8_MMA(1, 0, At, B0); PG8_MMA(1, 1, At, B1); PG8_BAR; PG8_SCHED;
            } else {
            PG8_LDB(B0, 0, 0); PG8_SCHED; PG8_LDA(At, 0, 0); PG8_STAGE_A(PG8_SA(1, 1), a1, 1, gcur);
            PG8_WAIT_L(8); PG8_BAR; PG8_WAIT_L(0); PG8_MMA(0, 0, At, B0); PG8_BAR; PG8_SCHED;
            PG8_LDB(B1, 0, 1); PG8_STAGE(PG8_SB(0, 0), b2, voffB);
            PG8_BAR; PG8_WAIT_L(0); PG8_MMA(0, 1, At, B1); PG8_BAR;
            PG8_LDA(At, 0, 1); PG8_STAGE_A(PG8_SA(0, 0), a2, 0, gcur);
            PG8_BAR; PG8_WAIT_L(0); PG8_MMA(1, 0, At, B0); PG8_BAR; PG8_SCHED;
            PG8_STAGE(PG8_SB(0, 1), b2 + hstep, voffB);
            PG8_WAIT_V(6); PG8_BAR; PG8_MMA(1, 1, At, B1); PG8_BAR;
            PG8_LDB(B0, 1, 0); PG8_SCHED; PG8_LDA(At, 1, 0); PG8_STAGE_A(PG8_SA(0, 1), a2, 1, gcur);
            PG8_WAIT_L(8); PG8_BAR; PG8_WAIT_L(0); PG8_MMA(0, 0, At, B0); PG8_BAR; PG8_SCHED;
            PG8_LDB(B1, 1, 1); PG8_STAGE(PG8_SB(1, 0), b3, voffB);
            PG8_BAR; PG8_WAIT_L(0); PG8_MMA(0, 1, At, B1); PG8_BAR;
            PG8_LDA(At, 1, 1); PG8_STAGE_A(PG8_SA(1, 0), a3, 0, gcur);
            PG8_BAR; PG8_WAIT_L(0); PG8_MMA(1, 0, At, B0); PG8_BAR; PG8_SCHED;
            PG8_STAGE(PG8_SB(1, 1), b3 + hstep, voffB);
            PG8_WAIT_V(6); PG8_BAR; PG8_MMA(1, 1, At, B1); PG8_BAR;
            }
        }
        if constexpr (ALIGN_EPI) { if (wr == 0) PG8_BAR; }
        E(acc, cur, wr, wc, fr, fq); S.done(cur);
        if (!has_next) break;
#pragma unroll
        for (int a = 0; a < 2; ++a)
#pragma unroll
            for (int b = 0; b < 2; ++b)
#pragma unroll
                for (int m = 0; m < 4; ++m)
#pragma unroll
                    for (int n = 0; n < 2; ++n) acc[a][b][m][n] = (f32x4){0.f, 0.f, 0.f, 0.f};
        cur = nxt; cA = nA; cB = nB; ++ui;

        if constexpr (ALIGN_EPI) { if (wr == 1) PG8_BAR; }
    }
    PG8_WAIT_V(0);
    if constexpr (!ALIGN_EPI) { if (wr == 0) PG8_BAR; }
    PG8_BAR;
#undef PG8_SA
#undef PG8_SB
#undef PG8_STAGE
#undef PG8_STAGE_A
#undef PG8_LDA
#undef PG8_LDB
#undef PG8_MMA
#undef PG8_WAIT_V
#undef PG8_WAIT_L
#undef PG8_BAR
#undef PG8_SCHED
}
}

constexpr int NWAVES = 8, NTHR = NWAVES * 64;
constexpr int NB = 4, SEQ = 8192, D = 1024, M = NB * SEQ;
constexpr int FF = 2816, NE = 8;
constexpr int NH = 15, NHQKV = 45, QKVP = 3072;
constexpr int RPAD = M + NE * 256;
constexpr int NCHUNK = M / 128;
constexpr float RMS_EPS = 1e-6f;
constexpr float I8_SA = 127.f / 8.f, I8_SW = 127.f * 32.f / 5.f;
constexpr float GU_SA = GU_I8 ? I8_SA : 16.f, GU_SW = GU_I8 ? I8_SW : 128.f;
constexpr float MOE_SA = MOE_I8 ? I8_SA : 16.f, MOE_SW = MOE_I8 ? I8_SW : 128.f;
constexpr float F8_SO = 32.f;
constexpr float F8_SA = 16.f, F8_SW = 128.f, F8_SH = 8.f;
constexpr float C2 = 0.125f * 1.4426950408889634f;

constexpr size_t MiB = 1u << 20;
constexpr size_t WS_CTL = 0, CTL_ZERO_BYTES = 64 * 1024;
constexpr size_t WS_MODP = 1 * MiB;
constexpr size_t WS_MODF = 3 * MiB;
constexpr size_t WS_IDENT = 4 * MiB + 512 * 1024;
constexpr size_t WS_ZG = WS_MODF + 256 * 1024;
constexpr size_t WS_SS = 4 * MiB;
constexpr size_t WS_BIASV = 5 * MiB;
constexpr size_t WS_XR = 448 * MiB;
constexpr size_t WS_ROPE = 6 * MiB;
constexpr size_t WS_LSE = 14 * MiB;
constexpr size_t WS_WCIN = 16 * MiB, WS_WCOUT = 22 * MiB, WS_WFGU = 24 * MiB, WS_WFD = 35 * MiB, WS_WQKV = 41 * MiB, WS_WO = 47 * MiB, WS_WMGU = 49 * MiB, WS_WMD = 137 * MiB;
constexpr size_t WS_H = 181 * MiB;
constexpr size_t WS_BIG = 245 * MiB;
constexpr size_t WS_BG = WS_BIG, WS_V = WS_BIG + 64 * MiB;
constexpr size_t WS_HID = WS_BIG;
constexpr size_t WS_QKV = WS_BIG;
constexpr size_t WS_RT2 = 10 * MiB, WS_RW2 = 12 * MiB;
constexpr size_t WS_MHID = WS_BIG;
constexpr size_t WS_Y1 = WS_H;
constexpr size_t WS_END = 512 * MiB;
static_assert(WS_MHID + (size_t)2 * RPAD * FF <= WS_XR && WS_QKV + (size_t)M * QKVP * 2 <= WS_XR && WS_HID + (size_t)M * FF * 2 <= WS_XR && WS_XR + (size_t)M * D * 2 <= WS_END, "d_ws map");
static_assert(WS_WMD + (size_t)NE * D * FF * 2 <= WS_H && WS_H + (size_t)M * D * 2 <= WS_BIG, "d_ws map 2");
constexpr int CW_XMAP = 8320;
constexpr int CW_CNT = 8192;
constexpr int CW_BAR = 4096;

constexpr int RING_BYTES = 131072;
constexpr int LDSCTL_OFF = RING_BYTES, MISC_OFF = LDSCTL_OFF + 320;
constexpr int RED_OFF = LDSCTL_OFF + 4096;
constexpr int TOKSLOT_OFF = LDSCTL_OFF + 1024;
constexpr int GATE_OFF = LDSCTL_OFF + 8192;
constexpr int LDS_BYTES = 155648;

#define GAS __attribute__((address_space(1)))
#define LAS __attribute__((address_space(3)))
typedef unsigned short bf16;
typedef unsigned v4u __attribute__((ext_vector_type(4)));
typedef unsigned v2u __attribute__((ext_vector_type(2)));
typedef float f32x4 __attribute__((ext_vector_type(4)));
#define LDS_WAIT() asm volatile("s_waitcnt lgkmcnt(0)" ::: "memory")
__device__ __forceinline__ unsigned f2bf(float f) { unsigned u = __builtin_bit_cast(unsigned, f); return (u + 0x7fffu + ((u >> 16) & 1u)) >> 16; }
__device__ __forceinline__ unsigned pk2(float lo, float hi) { return f2bf(lo) | (f2bf(hi) << 16); }
__device__ __forceinline__ float bflo(unsigned u) { return __builtin_bit_cast(float, u << 16); }
__device__ __forceinline__ float bfhi(unsigned u) { return __builtin_bit_cast(float, u & 0xffff0000u); }

__device__ __forceinline__ unsigned pk_fp8x4(f32x4 v) {
    const float a = __builtin_amdgcn_fmed3f(v.x, -448.f, 448.f), b = __builtin_amdgcn_fmed3f(v.y, -448.f, 448.f), c = __builtin_amdgcn_fmed3f(v.z, -448.f, 448.f), d = __builtin_amdgcn_fmed3f(v.w, -448.f, 448.f);
    int p = __builtin_amdgcn_cvt_pk_fp8_f32(a, b, 0, false); p = __builtin_amdgcn_cvt_pk_fp8_f32(c, d, p, true); return (unsigned)p; }
__device__ __forceinline__ unsigned pk_i8x4(f32x4 v) {
    const float mg = 12582912.0f;
    const unsigned a = __builtin_bit_cast(unsigned, __builtin_amdgcn_fmed3f(v.x, -127.f, 127.f) + mg), b = __builtin_bit_cast(unsigned, __builtin_amdgcn_fmed3f(v.y, -127.f, 127.f) + mg);
    const unsigned c = __builtin_bit_cast(unsigned, __builtin_amdgcn_fmed3f(v.z, -127.f, 127.f) + mg), d = __builtin_bit_cast(unsigned, __builtin_amdgcn_fmed3f(v.w, -127.f, 127.f) + mg);
    return __builtin_amdgcn_perm(__builtin_amdgcn_perm(d, c, 0x0c0c0400u), __builtin_amdgcn_perm(b, a, 0x0c0c0400u), 0x05040100u); }
__device__ __forceinline__ unsigned pk_q8x4(f32x4 v) { return GU_I8 ? pk_i8x4(v) : pk_fp8x4(v); }
#define XB_TMO      128
#define XB_XCNT(j)  (256  + 64 * (j))
#define XB_XSUB(j)  (1280 + 64 * (j))
#define XB_XGEN(j)  (2304 + 64 * (j))
#define XB_TOP      3328
#define XB_TOPGEN   3392
#define XCD_BAR_WORDS 3456
#define XB_SPIN_CAP (1u << 18)
__device__ __forceinline__ unsigned xb_ld(unsigned* p)              { return __hip_atomic_load(p, __ATOMIC_RELAXED, __HIP_MEMORY_SCOPE_AGENT); }
__device__ __forceinline__ unsigned xb_add(unsigned* p, unsigned v) { return __hip_atomic_fetch_add(p, v, __ATOMIC_RELAXED, __HIP_MEMORY_SCOPE_AGENT); }
__device__ __forceinline__ unsigned xb_xcc_id() { return (unsigned)__builtin_amdgcn_s_getreg((3 << 11) | 20) & 0xFu; }
#define XB_SPIN(cond, bar) do { unsigned _sp = 0; while (cond) { __builtin_amdgcn_s_sleep(1); \
    if ((++_sp & 255u) == 0u) { if (xb_ld(&(bar)[XB_TMO])) break; if (_sp > XB_SPIN_CAP) { atomicAdd(&(bar)[XB_TMO], 1u); break; } } } } while (0)
struct XcdBarrier { unsigned* bar; unsigned x; volatile LAS unsigned* st; };
__device__ __forceinline__ XcdBarrier xcd_barrier_post(unsigned* bar, volatile LAS unsigned* st) {
    XcdBarrier b; b.bar = bar; b.x = xb_xcc_id(); b.st = st;
    if (threadIdx.x == 0) (void)xb_add(&bar[XB_XCNT(b.x)], 1u);
    return b;
}
__device__ __forceinline__ void xcd_barrier_complete(unsigned* bar, unsigned x, unsigned& nloc, unsigned& nx) {
    const unsigned G = gridDim.x * gridDim.y * gridDim.z;
    unsigned sum, cnt, mine, sp = 0u;
    for (;;) {
        sum = 0u; cnt = 0u; mine = 0u;
#pragma unroll
        for (unsigned j = 0; j < 16; ++j) { const unsigned c = xb_ld(&bar[XB_XCNT(j)]); sum += c; cnt += (c > 0u) ? 1u : 0u; mine = (j == x) ? c : mine; }
        if (sum == G) break;
        __builtin_amdgcn_s_sleep(1);
        if ((++sp & 255u) == 0u) { if (xb_ld(&bar[XB_TMO])) break; if (sp > XB_SPIN_CAP) { atomicAdd(&bar[XB_TMO], 1u); break; } }
    }
    nloc = mine > 0u ? mine : 1u; nx = cnt > 0u ? cnt : 1u;
}
__device__ __forceinline__ void xcd_barrier(const XcdBarrier& b) {
    asm volatile("s_waitcnt vmcnt(0)" ::: "memory");
    __syncthreads();
    if (threadIdx.x == 0) {
        unsigned* bar = b.bar;
        __builtin_amdgcn_s_waitcnt(0);
        unsigned nloc = b.st[0], nx = b.st[1];
        if (nloc == 0u) { xcd_barrier_complete(bar, b.x, nloc, nx); b.st[0] = nloc; b.st[1] = nx; }
        const unsigned old = xb_add(&bar[XB_XSUB(b.x)], 1u);
        const unsigned gen = old / nloc;
        if (old + 1u == (gen + 1u) * nloc) {
            __builtin_amdgcn_fence(__ATOMIC_RELEASE, "agent");
            asm volatile("s_waitcnt vmcnt(0)" ::: "memory");
            const unsigned og = xb_add(&bar[XB_TOP], 1u);
            const unsigned tg = og / nx;
            if (og + 1u == (tg + 1u) * nx) xb_add(&bar[XB_TOPGEN], 1u);
            else XB_SPIN(xb_ld(&bar[XB_TOPGEN]) == tg, bar);
            __builtin_amdgcn_fence(__ATOMIC_ACQUIRE, "agent");
            xb_add(&bar[XB_XGEN(b.x)], 1u);
            asm volatile("s_waitcnt vmcnt(0)" ::: "memory");
        } else {
            XB_SPIN(xb_ld(&bar[XB_XGEN(b.x)]) == gen, bar);
            __builtin_amdgcn_fence(__ATOMIC_ACQUIRE, "agent");
            asm volatile("s_waitcnt vmcnt(0)" ::: "memory");
        }
    }
    __syncthreads();
}

#define XB_LSUB(j)  (3456 + 16 * (j))
#define XB_LGEN(j)  (3712 + 16 * (j))
__device__ __forceinline__ void xcd_barrier_local(const XcdBarrier& b) {
    asm volatile("s_waitcnt vmcnt(0)" ::: "memory");
    __syncthreads();
    if (threadIdx.x == 0) {
        unsigned* bar = b.bar;
        __builtin_amdgcn_s_waitcnt(0);
        const unsigned nloc = b.st[0];
        const unsigned old = xb_add(&bar[XB_LSUB(b.x)], 1u);
        const unsigned gen = old / nloc;
        if (old + 1u == (gen + 1u) * nloc) xb_add(&bar[XB_LGEN(b.x)], 1u);
        else XB_SPIN(xb_ld(&bar[XB_LGEN(b.x)]) == gen, bar);
        __builtin_amdgcn_fence(__ATOMIC_ACQUIRE, "agent");
        asm volatile("s_waitcnt vmcnt(0)" ::: "memory");
    }
    __syncthreads();
}

__device__ __forceinline__ float wave_sum(float v) {
#pragma unroll
    for (int o = 1; o < 64; o <<= 1) v += __shfl_xor(v, o);
    return v;
}
__device__ __forceinline__ float wave_max(float v) {
#pragma unroll
    for (int o = 1; o < 64; o <<= 1) v = fmaxf(v, __shfl_xor(v, o));
    return v;
}
__device__ __forceinline__ float silu_f(float v) { return v * __builtin_amdgcn_rcpf(1.0f + __builtin_amdgcn_exp2f(-1.4426950408889634f * v)); }

struct Args {
    const float* x; const float* c; const int* pos; const float* mod_w; const float* mod_b; const float* norm_g;
    const float* conv_w_in; const float* conv_w; const float* conv_w_out; const float* ffn_g; const float* ffn_u; const float* ffn_d;
    const float* w_qkv; const float* w_o; const float* router_w; const float* moe_g; const float* moe_u; const float* moe_d; const float* final_g;
    float* out; unsigned char* ws; int ph_lo, ph_hi;
};

using pg8::Unit; using pg8::HALF; using pg8::BM;
#define PINV(x) asm volatile("" : "+v"(x))
#define ROWSTEP(k) (((k) == 3) ? 80u : 16u)
#ifndef STORE_AUX
#define STORE_AUX 0
#endif
__device__ __forceinline__ __amdgpu_buffer_rsrc_t mk_rsrc(const void* base) { return __builtin_amdgcn_make_buffer_rsrc(const_cast<void*>(base), 0, 0x7fffffff, 0x00020000); }
__device__ __forceinline__ void st16(__amdgpu_buffer_rsrc_t r, unsigned off, v4u v) { __builtin_amdgcn_raw_buffer_store_b128(v, r, (int)off, 0, STORE_AUX); }
__device__ __forceinline__ void st8(__amdgpu_buffer_rsrc_t r, unsigned off, v2u v) { __builtin_amdgcn_raw_buffer_store_b64(v, r, (int)off, 0, STORE_AUX); }
__device__ __forceinline__ void st16f(__amdgpu_buffer_rsrc_t r, unsigned off, f32x4 v) { __builtin_amdgcn_raw_buffer_store_b128(__builtin_bit_cast(v4u, v), r, (int)off, 0, STORE_AUX); }
template <class T> __device__ __forceinline__ T* at_off(T* base, unsigned byteoff) { return (T*)((char*)base + byteoff); }
template <class T> __device__ __forceinline__ const T* at_off(const T* base, unsigned byteoff) { return (const T*)((const char*)base + byteoff); }
__device__ __forceinline__ v4u pack8(const f32x4 a, const f32x4 b) { v4u w; w.x = pg8::cvt_pk_bf16(a[0], a[1]); w.y = pg8::cvt_pk_bf16(a[2], a[3]); w.z = pg8::cvt_pk_bf16(b[0], b[1]); w.w = pg8::cvt_pk_bf16(b[2], b[3]); return w; }
typedef int i32x4 __attribute__((ext_vector_type(4)));
__device__ __forceinline__ f32x4 acc_f32(const f32x4 a, bool i8) { return i8 ? __builtin_convertvector(__builtin_bit_cast(i32x4, a), f32x4) : a; }
template <bool I8> struct EpiConvInT {
    static constexpr bool PERM = true, SIDE = false;
    bf16* V; bf16* Bg;
    __device__ __forceinline__ void operator()(const f32x4 (&acc)[2][2][4][2], const Unit& u, int wr, int wc, int fr, int fq) const {
        PINV(fr); PINV(fq);
        const int row0 = u.pm * BM + wr * 64 + fr; const __amdgpu_buffer_rsrc_t rV = mk_rsrc(V), rB = mk_rsrc(Bg);
        constexpr float ci = I8 ? 1.0f / (GU_SA * GU_SW) : 1.0f;
        if (u.pn < 8) {
            unsigned ro = (unsigned)(row0 * D + u.pn * 128 + wc * 32 + 8 * fq) * 2u;
#pragma unroll
            for (int k = 0; k < 8; ++k) { const int ai = k >> 2, m = k & 3;
                st16(rV, ro, pack8(acc_f32(acc[ai][0][m][0], I8) * acc_f32(acc[ai][1][m][0], I8) * (ci * ci), acc_f32(acc[ai][0][m][1], I8) * acc_f32(acc[ai][1][m][1], I8) * (ci * ci)));
                ro += ROWSTEP(k) * (unsigned)(D * 2); PINV(ro); }
        } else {
            unsigned ro = (unsigned)(row0 * D + (u.pn - 8) * 256 + wc * 32 + 8 * fq) * 2u;
#pragma unroll
            for (int k = 0; k < 8; ++k) { const int ai = k >> 2, m = k & 3;
                st16(rB, ro, pack8(acc_f32(acc[ai][0][m][0], I8) * ci, acc_f32(acc[ai][0][m][1], I8) * ci));
                st16(rB, ro + HALF * 2, pack8(acc_f32(acc[ai][1][m][0], I8) * ci, acc_f32(acc[ai][1][m][1], I8) * ci));
                ro += ROWSTEP(k) * (unsigned)(D * 2); PINV(ro); }
        }
    }
};
typedef EpiConvInT<false> EpiConvIn;
typedef float f32x2 __attribute__((ext_vector_type(2)));
__device__ __forceinline__ f32x2 swiglu2(f32x2 g, f32x2 u, float cg, float cgu) {
    const f32x2 t = g * (-1.4426950408889634f * cg);
    f32x2 e; e.x = __builtin_amdgcn_exp2f(t.x); e.y = __builtin_amdgcn_exp2f(t.y);
    const float k = 1.0f / cgu;
    const f32x2 d = e * k + k;
    f32x2 r; r.x = __builtin_amdgcn_rcpf(d.x); r.y = __builtin_amdgcn_rcpf(d.y);
    return (g * u) * r;
}
__device__ __forceinline__ f32x4 swiglu4(f32x4 g, f32x4 u, float cg, float cgu) {
    const f32x2 a = swiglu2((f32x2){g.x, g.y}, (f32x2){u.x, u.y}, cg, cgu), b = swiglu2((f32x2){g.z, g.w}, (f32x2){u.z, u.w}, cg, cgu); return (f32x4){a.x, a.y, b.x, b.y}; }
__device__ __forceinline__ float rinv_of(const f32x4 s) { return __builtin_amdgcn_rsqf(((s.x + s.y) + (s.z + s.w)) * (1.0f / D) + RMS_EPS); }
constexpr int SIDE_BYTES = 5120;
template <bool NORM, bool F8 = false, bool F8O = F8> struct EpiSwiGLU {
    static constexpr bool PERM = true, SIDE = NORM;
    bf16* Hd; int nN; const float* SS; const float* bias; LAS unsigned char* side;
    __device__ __forceinline__ void side_issue(const Unit& u, int wid, int lane) const {
        LAS unsigned char* sl = side + u.sp * SIDE_BYTES;
        if (wid < 4) __builtin_amdgcn_global_load_lds((const unsigned*)(SS + ((size_t)(u.pm * BM + wid * 64 + lane)) * 4), (LAS unsigned*)(sl + wid * 1024), 16, 0, 0);
        else if (wid == 4) __builtin_amdgcn_global_load_lds((const unsigned*)(bias + (size_t)((u.pm * BM) / SEQ) * (2 * FF) + u.pn * BM + lane * 4), (LAS unsigned*)(sl + 4096), 16, 0, 0);
    }
    __device__ __forceinline__ void operator()(const f32x4 (&acc)[2][2][4][2], const Unit& u, int wr, int wc, int fr, int fq) const {
        PINV(fr); PINV(fq);
        const int row0 = u.pm * BM + wr * 64 + fr, pnl = u.pn % nN;
        f32x4 (&a)[2][2][4][2] = const_cast<f32x4 (&)[2][2][4][2]>(acc);
        if (NORM) {
            const LAS unsigned char* sl = side + u.sp * SIDE_BYTES;
            f32x4 bv[2][2];
#pragma unroll
            for (int bj = 0; bj < 2; ++bj)
#pragma unroll
                for (int n = 0; n < 2; ++n) bv[bj][n] = *(const LAS f32x4*)(sl + 4096 + (bj * HALF + wc * 32 + 8 * fq + 4 * n) * 4);
#pragma unroll
            for (int k = 0; k < 8; ++k) { const float r = rinv_of(*(const LAS f32x4*)(sl + ((k >> 2) * HALF + wr * 64 + (k & 3) * 16 + fr) * 16)) * (F8 ? 1.0f / (GU_SA * GU_SW) : 1.0f);
#pragma unroll
                for (int bj = 0; bj < 2; ++bj)
#pragma unroll
                    for (int n = 0; n < 2; ++n) a[k >> 2][bj][k & 3][n] = acc_f32(a[k >> 2][bj][k & 3][n], F8 && GU_I8) * r + bv[bj][n]; }
        }
        unsigned ro = (unsigned)(row0 * FF + pnl * 128 + wc * 32 + 8 * fq) * (F8O ? 1u : 2u); const __amdgpu_buffer_rsrc_t rH = mk_rsrc(Hd);
#pragma unroll
        for (int k = 0; k < 8; ++k) { const int ai = k >> 2, m = k & 3;
            const f32x4 g0 = a[ai][0][m][0], g1 = a[ai][0][m][1], u0 = a[ai][1][m][0], u1 = a[ai][1][m][1];
            const f32x4 v0 = swiglu4(g0, u0, 1.0f, F8O ? F8_SH : 1.0f), v1 = swiglu4(g1, u1, 1.0f, F8O ? F8_SH : 1.0f);
            if (F8O) { v2u w8; w8.x = pk_fp8x4(v0); w8.y = pk_fp8x4(v1); st8(rH, ro, w8); } else st16(rH, ro, pack8(v0, v1));
            ro += ROWSTEP(k) * (unsigned)(FF * (F8O ? 1 : 2)); PINV(ro); }
    }
};
struct EpiSwiGLU8 {
    static constexpr bool PERM = true, SIDE = false;
    unsigned char* Hd; int nN;
    __device__ __forceinline__ void operator()(const f32x4 (&acc)[2][2][4][2], const Unit& u, int wr, int wc, int fr, int fq) const {
        PINV(fr); PINV(fq);
        const int row0 = u.pm * BM + wr * 64 + fr, pnl = u.pn % nN;
        unsigned ro = (unsigned)(row0 * FF + pnl * 128 + wc * 32 + 8 * fq); const __amdgpu_buffer_rsrc_t rH = mk_rsrc(Hd);
        constexpr float ci = 1.0f / (MOE_SA * MOE_SW);
#pragma unroll
        for (int k = 0; k < 8; ++k) { const int ai = k >> 2, m = k & 3;
            const f32x4 v0 = swiglu4(acc_f32(acc[ai][0][m][0], MOE_I8), acc_f32(acc[ai][1][m][0], MOE_I8), ci, ci * ci * F8_SH), v1 = swiglu4(acc_f32(acc[ai][0][m][1], MOE_I8), acc_f32(acc[ai][1][m][1], MOE_I8), ci, ci * ci * F8_SH);
            v2u w; w.x = pk_fp8x4(v0); w.y = pk_fp8x4(v1); st8(rH, ro, w);
            ro += ROWSTEP(k) * (unsigned)FF; PINV(ro); }
    }
};
template <bool I8> struct EpiQkvRopeT {
    static constexpr bool PERM = true, SIDE = true;
    bf16* QKV; const unsigned* rope; const float* SS; const float* bias; LAS unsigned char* side;
    __device__ __forceinline__ void side_issue(const Unit& u, int wid, int lane) const {
        LAS unsigned char* sl = side + u.sp * SIDE_BYTES;
        if (wid < 4) __builtin_amdgcn_global_load_lds((const unsigned*)(SS + ((size_t)(u.pm * BM + wid * 64 + lane)) * 4), (LAS unsigned*)(sl + wid * 1024), 16, 0, 0);
        else if (wid == 4) __builtin_amdgcn_global_load_lds((const unsigned*)(bias + (size_t)((u.pm * BM) / SEQ) * (2 * FF) + u.pn * BM + lane * 4), (LAS unsigned*)(sl + 4096), 16, 0, 0);
    }
    __device__ __forceinline__ void operator()(const f32x4 (&acc)[2][2][4][2], const Unit& u, int wr, int wc, int fr, int fq) const {
        PINV(fr); PINV(fq);
        const int hd = 4 * u.pn + wc; if (hd >= NHQKV) return;
        const int row0 = u.pm * BM + wr * 64 + fr;
        const float sc = hd < NH ? C2 : 1.0f;
        f32x4 (&a)[2][2][4][2] = const_cast<f32x4 (&)[2][2][4][2]>(acc);
        { const LAS unsigned char* sl = side + u.sp * SIDE_BYTES;
            f32x4 bv[2][2];
#pragma unroll
            for (int bj = 0; bj < 2; ++bj)
#pragma unroll
                for (int n = 0; n < 2; ++n) bv[bj][n] = *(const LAS f32x4*)(sl + 4096 + (bj * HALF + wc * 32 + 8 * fq + 4 * n) * 4);
#pragma unroll
            for (int k = 0; k < 8; ++k) { const float r = rinv_of(*(const LAS f32x4*)(sl + ((k >> 2) * HALF + wr * 64 + (k & 3) * 16 + fr) * 16)) * (I8 ? 1.0f / (GU_SA * GU_SW) : 1.0f);
#pragma unroll
                for (int bj = 0; bj < 2; ++bj)
#pragma unroll
                    for (int n = 0; n < 2; ++n) a[k >> 2][bj][k & 3][n] = acc_f32(a[k >> 2][bj][k & 3][n], I8) * r + bv[bj][n]; } }
        const bool rot = hd < 2 * NH; const __amdgpu_buffer_rsrc_t rQ = mk_rsrc(QKV);
        v4u cs[2][2];
        unsigned co = (unsigned)(row0 * 32 + 8 * fq) * 4u, ro = (unsigned)(row0 * QKVP + hd * 64 + 8 * fq) * 2u;
#define RP_H2F(u, hi) ((float)__builtin_bit_cast(_Float16, (unsigned short)((hi) ? ((u) >> 16) : ((u) & 0xffffu))))
        cs[0][0] = *at_off((const v4u*)rope, co); cs[0][1] = *at_off((const v4u*)rope, co + 16);
#pragma unroll
        for (int k = 0; k < 8; ++k) { const int ai = k >> 2, m = k & 3, cb_ = k & 1;
            co += ROWSTEP(k) * 128u; PINV(co);
            if (k < 7) { cs[cb_ ^ 1][0] = *at_off((const v4u*)rope, co); cs[cb_ ^ 1][1] = *at_off((const v4u*)rope, co + 16); }
#pragma unroll
            for (int n = 0; n < 2; ++n) {
                const f32x4 x1 = a[ai][0][m][n], x2 = a[ai][1][m][n]; f32x4 c, s;
#pragma unroll
                for (int i = 0; i < 4; ++i) { const float cf = RP_H2F(cs[cb_][n][i], 0), sf = RP_H2F(cs[cb_][n][i], 1); c[i] = rot ? cf : 1.0f; s[i] = rot ? sf : 0.0f; }
                const f32x4 o1 = (x1 * c - x2 * s) * sc, o2 = (x2 * c + x1 * s) * sc;
                v2u w; w.x = pg8::cvt_pk_bf16(o1[0], o1[1]); w.y = pg8::cvt_pk_bf16(o1[2], o1[3]); st8(rQ, ro + 8 * n, w);
                w.x = pg8::cvt_pk_bf16(o2[0], o2[1]); w.y = pg8::cvt_pk_bf16(o2[2], o2[3]); st8(rQ, ro + 64 + 8 * n, w); }
            ro += ROWSTEP(k) * (unsigned)(QKVP * 2); PINV(ro); }
#undef RP_H2F
    }
};
typedef EpiQkvRopeT<false> EpiQkvRope;
__device__ __forceinline__ void unpack8(const v4u u, f32x4& a, f32x4& b) { a = (f32x4){bflo(u.x), bfhi(u.x), bflo(u.y), bfhi(u.y)}; b = (f32x4){bflo(u.z), bfhi(u.z), bflo(u.w), bfhi(u.w)}; }
template <bool BASE_F32, bool NEXT, bool XB8 = false> struct EpiResidB {
    static constexpr bool PERM = true, SIDE = false;
    const void* base; bf16* XR; const float* gate; bf16* XB; float* SS; const float* scl; const float* ng; LAS float* red; float ascale;
    __device__ __forceinline__ void operator()(const f32x4 (&acc)[2][2][4][2], const Unit& u, int wr, int wc, int fr, int fq) const {
        PINV(fr); PINV(fq);
        const int row0 = u.pm * BM + wr * 64 + fr, col0 = u.pn * BM + wc * 32 + 8 * fq, b = (u.pm * BM) / SEQ;
        f32x4 gv[2][2], can[2][2];
#pragma unroll
        for (int bj = 0; bj < 2; ++bj)
#pragma unroll
            for (int n = 0; n < 2; ++n) { gv[bj][n] = *(const f32x4*)(gate + (size_t)b * 3072 + col0 + bj * HALF + 4 * n) * ascale;
                if (NEXT) can[bj][n] = *(const f32x4*)(ng + col0 + bj * HALF + 4 * n) * (*(const f32x4*)(scl + (size_t)b * 3072 + col0 + bj * HALF + 4 * n) + 1.0f); }
        const __amdgpu_buffer_rsrc_t rR = mk_rsrc(XR), rX = mk_rsrc(XB);
        f32x4 bf[2][2][2]; v4u bh[2][2];
        unsigned lo = (unsigned)(row0 * D + col0) * (BASE_F32 ? 4u : 2u), so = (unsigned)(row0 * D + col0) * 2u; int rl = wr * 64 + fr;
#define ER_LOAD(buf) do { if (BASE_F32) { _Pragma("unroll") for (int bj = 0; bj < 2; ++bj) _Pragma("unroll") for (int n = 0; n < 2; ++n) bf[buf][bj][n] = *at_off((const f32x4*)base, lo + (bj * HALF + 4 * n) * 4); } \
        else { _Pragma("unroll") for (int bj = 0; bj < 2; ++bj) bh[buf][bj] = *at_off((const v4u*)base, lo + bj * HALF * 2); } } while (0)
        ER_LOAD(0);
#pragma unroll
        for (int k = 0; k < 8; ++k) { const int ai = k >> 2, m = k & 3, cb_ = k & 1;
            lo += ROWSTEP(k) * (unsigned)(D * (BASE_F32 ? 4 : 2)); PINV(lo);
            if (k < 7) { if (cb_) ER_LOAD(0); else ER_LOAD(1); }
            float s = 0.f;
#pragma unroll
            for (int bj = 0; bj < 2; ++bj) { f32x4 x0, x1;
                if (BASE_F32) { x0 = bf[cb_][bj][0]; x1 = bf[cb_][bj][1]; } else unpack8(bh[cb_][bj], x0, x1);
                x0 = x0 + gv[bj][0] * acc[ai][bj][m][0]; x1 = x1 + gv[bj][1] * acc[ai][bj][m][1];
                st16(rR, so + bj * HALF * 2, pack8(x0, x1));
                if (NEXT) { s += ((x0.x * x0.x + x0.y * x0.y) + (x0.z * x0.z + x0.w * x0.w)) + ((x1.x * x1.x + x1.y * x1.y) + (x1.z * x1.z + x1.w * x1.w));
                    if (XB8) { v2u w8; w8.x = pk_q8x4(x0 * can[bj][0] * GU_SA); w8.y = pk_q8x4(x1 * can[bj][1] * GU_SA); st8(rX, (so >> 1) + bj * HALF, w8); }
                    else st16(rX, so + bj * HALF * 2, pack8(x0 * can[bj][0], x1 * can[bj][1])); } }
            if (NEXT) { s += __shfl_xor(s, 16); s += __shfl_xor(s, 32); if (fq == 0) red[rl * 4 + wc] = s; }
            so += ROWSTEP(k) * (unsigned)(D * 2); PINV(so); rl += (int)ROWSTEP(k); }
#undef ER_LOAD
        if (NEXT) {
            asm volatile("s_waitcnt lgkmcnt(0)" ::: "memory"); __builtin_amdgcn_s_barrier(); asm volatile("" ::: "memory");
            if (threadIdx.x < 256) { const f32x4 t = *(const LAS f32x4*)(red + threadIdx.x * 4); SS[(size_t)(u.pm * BM + threadIdx.x) * 4 + u.pn] = (t.x + t.y) + (t.z + t.w); }
        }
    }
};
struct EpiMoeDown {
    static constexpr bool PERM = true, SIDE = true;
    bf16* XR; bf16* Y1; const int* rowtok; const float* roww; const LAS float* gate; float oscale; LAS unsigned char* side;
    __device__ __forceinline__ void side_issue(const Unit& u, int wid, int lane) const {
        LAS unsigned char* sl = side + u.sp * 2048; const size_t lb = (size_t)u.g * M + 256 * u.k;
        if (wid < 4) __builtin_amdgcn_global_load_lds((const unsigned*)(rowtok + lb + wid * 64 + lane), (LAS unsigned*)(sl + wid * 256), 4, 0, 0);
        else __builtin_amdgcn_global_load_lds((const unsigned*)(roww + lb + (wid - 4) * 64 + lane), (LAS unsigned*)(sl + 1024 + (wid - 4) * 256), 4, 0, 0);
    }
    __device__ __forceinline__ void operator()(const f32x4 (&acc)[2][2][4][2], const Unit& u, int wr, int wc, int fr, int fq) const {
        PINV(fr); PINV(fq);
        const int col0 = (u.pn & 3) * BM + wc * 32 + 8 * fq; const LAS unsigned char* sl = side + u.sp * 2048;
        int tok[8]; float w[8];
#pragma unroll
        for (int k = 0; k < 8; ++k) { const int rl = (k >> 2) * HALF + wr * 64 + (k & 3) * 16 + fr; const bool ok = rl < u.nv; const int t_ = *(const LAS int*)(sl + rl * 4); const float w_ = *(const LAS float*)(sl + 1024 + rl * 4);
            tok[k] = ok ? t_ : -1; w[k] = ok ? w_ * oscale : 0.f; }
        if (u.g < 8) {
            const __amdgpu_buffer_rsrc_t rR = mk_rsrc(XR);
            v4u bh[2][2];
#define ER_LOAD(buf, kk) do { const unsigned o_ = (unsigned)((tok[kk] < 0 ? 0 : tok[kk]) * D + col0) * 2u; \
            _Pragma("unroll") for (int bj = 0; bj < 2; ++bj) bh[buf][bj] = *at_off((const v4u*)XR, o_ + bj * HALF * 2); } while (0)
            ER_LOAD(0, 0);
#pragma unroll
            for (int k = 0; k < 8; ++k) { const int ai = k >> 2, m = k & 3, cb_ = k & 1;
                if (k < 7) { if (cb_) ER_LOAD(0, (k + 1) & 7); else ER_LOAD(1, (k + 1) & 7); }
#pragma unroll
                for (int bj = 0; bj < 2; ++bj) PINV(bh[cb_][bj]);
                if (tok[k] >= 0) { const unsigned o_ = (unsigned)(tok[k] * D + col0) * 2u; const LAS float* g_ = gate + (tok[k] >> 13) * D + col0; const float w_ = w[k];
#pragma unroll
                    for (int bj = 0; bj < 2; ++bj) { f32x4 x0, x1; unpack8(bh[cb_][bj], x0, x1);
                        x0 = x0 + *(const LAS f32x4*)(g_ + bj * HALF) * w_ * acc[ai][bj][m][0]; x1 = x1 + *(const LAS f32x4*)(g_ + bj * HALF + 4) * w_ * acc[ai][bj][m][1];
                        st16(rR, o_ + bj * HALF * 2, pack8(x0, x1)); } } }
#undef ER_LOAD
        } else {
            const __amdgpu_buffer_rsrc_t rY = mk_rsrc(Y1);
#pragma unroll
            for (int k = 0; k < 8; ++k) { const int ai = k >> 2, m = k & 3;
                if (tok[k] >= 0) { const unsigned o_ = (unsigned)(tok[k] * D + col0) * 2u; const LAS float* g_ = gate + (tok[k] >> 13) * D + col0; const float w_ = w[k];
#pragma unroll
                    for (int bj = 0; bj < 2; ++bj) st16(rY, o_ + bj * HALF * 2, pack8(*(const LAS f32x4*)(g_ + bj * HALF) * w_ * acc[ai][bj][m][0], *(const LAS f32x4*)(g_ + bj * HALF + 4) * w_ * acc[ai][bj][m][1])); } }
        }
    }
};
struct EpiNull { static constexpr bool PERM = true, SIDE = false;
    __device__ __forceinline__ void operator()(const f32x4 (&acc)[2][2][4][2], const Unit& u, int wr, int wc, int fr, int fq) const {
        PINV(fr); PINV(fq);
#pragma unroll
        for (int ai = 0; ai < 2; ++ai)
#pragma unroll
            for (int bj = 0; bj < 2; ++bj)
                asm volatile("" :: "v"(acc[ai][bj][0][0]), "v"(acc[ai][bj][0][1]), "v"(acc[ai][bj][1][0]), "v"(acc[ai][bj][1][1]), "v"(acc[ai][bj][2][0]), "v"(acc[ai][bj][2][1]), "v"(acc[ai][bj][3][0]), "v"(acc[ai][bj][3][1])); } };
__constant__ float INVF[32] = {
    1.0f, 0.7498942093324559f, 0.5623413251903491f, 0.4216965034285822f, 0.31622776601683794f, 0.23713737056616552f, 0.1778279410038923f, 0.1333521432163324f,
    0.1f, 0.07498942093324558f, 0.05623413251903491f, 0.04216965034285822f, 0.03162277660168379f, 0.023713737056616554f, 0.01778279410038923f, 0.01333521432163324f,
    0.01f, 0.007498942093324558f, 0.005623413251903491f, 0.004216965034285823f, 0.0031622776601683794f, 0.0023713737056616554f, 0.0017782794100389228f, 0.001333521432163324f,
    0.001f, 0.0007498942093324559f, 0.0005623413251903491f, 0.0004216965034285823f, 0.00031622776601683794f, 0.00023713737056616554f, 0.00017782794100389227f, 0.0001333521432163324f };

template <int MAP, int FMT  >
__device__ __forceinline__ void conv_block(const float* W, int ld, int ncol, int kvalid, int k0, int c0, unsigned char* dst, int Kp  , int rowoff, float sc, int wave, int lane) {
    const int col = c0 + 4 * lane, kb = k0 + 16 * wave; const bool act = col < ncol;
    f32x4 v[16];
#pragma unroll
    for (int i = 0; i < 16; ++i) v[i] = (act && kb + i < kvalid) ? *(const f32x4*)(W + (size_t)(kb + i) * ld + col) : (f32x4){0.f, 0.f, 0.f, 0.f};
    if (!act) return;
    int nrow;
    if (MAP == 0) nrow = col;
    else if (MAP == 1) { if (col < 1024) nrow = 2048 + col; else { const int cc = (col - 1024) & 1023, up = col >= 2048; nrow = 256 * (cc >> 7) + (cc & 127) + (up ? 128 : 0); } }
    else if (MAP == 2) nrow = 256 * (col >> 7) + (col & 127);
    else { const int head = col >> 6, bj = (col >> 5) & 1, dd = col & 31; nrow = 256 * (head >> 2) + 128 * bj + 32 * (head & 3) + dd; }
    nrow += rowoff;
#pragma unroll
    for (int j = 0; j < 4; ++j) {
        if (FMT != 0) { v4u o;
#pragma unroll
            for (int q = 0; q < 4; ++q) { const f32x4 t = (f32x4){v[4 * q][j], v[4 * q + 1][j], v[4 * q + 2][j], v[4 * q + 3][j]} * sc; o[q] = FMT == 2 ? pk_i8x4(t) : pk_fp8x4(t); }
            *(v4u*)(dst + (size_t)(nrow + j) * Kp + kb) = o; }
        else { v4u o0, o1;
#pragma unroll
            for (int q = 0; q < 4; ++q) { o0[q] = pk2(v[2 * q][j], v[2 * q + 1][j]); o1[q] = pk2(v[8 + 2 * q][j], v[8 + 2 * q + 1][j]); }
            bf16* p = (bf16*)dst + (size_t)(nrow + j) * Kp + kb; *(v4u*)p = o0; *(v4u*)(p + 8) = o1; }
    }
}
__device__ __forceinline__ void p0_prologue(const Args& a, LAS unsigned char* lds, int gw, int NGW, int wave, int lane, int tid) {
    unsigned char* ws = a.ws;
    LAS float* sc = (LAS float*)(lds + 69632);
    for (int i = tid; i < NB * D; i += NTHR) sc[i] = silu_f(a.c[i]);
    if (blockIdx.x == 0) for (int i = tid; i < 16 * 3072; i += NTHR) ((float*)(ws + WS_ZG))[i] = 0.f;
    if (blockIdx.x == 1) for (int i = tid; i < 2 * RPAD; i += NTHR) ((int*)(ws + WS_IDENT))[i] = i;
    if (blockIdx.x == 2) {
        for (int i = tid; i < 192 * (D / 8); i += NTHR) { const int rr = i / (D / 8), c8 = i % (D / 8), bj = rr / 96, q = rr % 96;
            if (QKV_I8) { if (c8 < D / 16) *(v4u*)(ws + WS_WQKV + (size_t)(2816 + 128 * bj + 32 + q) * D + 16 * c8) = (v4u){0u, 0u, 0u, 0u}; }
            else *(v4u*)((bf16*)(ws + WS_WQKV) + (size_t)(2816 + 128 * bj + 32 + q) * D + 8 * c8) = (v4u){0u, 0u, 0u, 0u}; } }
    __syncthreads();
    constexpr int B_CIN = 8 * 12, B_COUT = 8 * 4, B_FG = 8 * 11, B_FD = 22 * 4, B_QKV = 8 * 12, B_WO = 8 * 4, B_MG = NE * B_FG, B_MD = NE * B_FD;
    constexpr int NBLK = B_CIN + B_COUT + 2 * B_FG + B_FD + B_QKV + B_WO + 2 * B_MG + B_MD;
    for (int it = blockIdx.x; it < NBLK; it += gridDim.x) {
        int r = it;
        if (r < B_CIN) { conv_block<1, CONVIN_I8 ? 2 : 0>(a.conv_w_in, 3072, 3072, D, 128 * (r / 12), 256 * (r % 12), ws + WS_WCIN, D, 0, GU_SW, wave, lane); continue; } r -= B_CIN;
        if (r < B_COUT) { conv_block<0, WOUT_FP8 ? 1 : 0>(a.conv_w_out, D, D, D, 128 * (r / 4), 256 * (r % 4), ws + WS_WCOUT, D, 0, F8_SW, wave, lane); continue; } r -= B_COUT;
        if (r < 2 * B_FG) { const int up = r >= B_FG, q = up ? r - B_FG : r;
            conv_block<2, DENSE_GU_FP8 ? (GU_I8 ? 2 : 1) : 0>(up ? a.ffn_u : a.ffn_g, FF, FF, D, 128 * (q / 11), 256 * (q % 11), ws + WS_WFGU, D, up ? 128 : 0, GU_SW, wave, lane); continue; } r -= 2 * B_FG;
        if (r < B_FD) { conv_block<0, DENSE_DOWN_FP8 ? 1 : 0>(a.ffn_d, D, D, FF, 128 * (r / 4), 256 * (r % 4), ws + WS_WFD, FF, 0, F8_SW, wave, lane); continue; } r -= B_FD;
        if (r < B_QKV) { conv_block<3, QKV_I8 ? 2 : 0>(a.w_qkv, 2880, 2880, D, 128 * (r / 12), 256 * (r % 12), ws + WS_WQKV, D, 0, GU_SW, wave, lane); continue; } r -= B_QKV;
        if (r < B_WO) { conv_block<0, WO_FP8 ? 1 : 0>(a.w_o, D, D, 960, 128 * (r / 4), 256 * (r % 4), ws + WS_WO, D, 0, F8_SW, wave, lane); continue; } r -= B_WO;
        if (r < 2 * B_MG) { const int up = r >= B_MG, q = up ? r - B_MG : r, e = q / B_FG, qq = q % B_FG;
            conv_block<2, MOE_I8 ? 2 : 1>((up ? a.moe_u : a.moe_g) + (size_t)e * D * FF, FF, FF, D, 128 * (qq / 11), 256 * (qq % 11), ws + WS_WMGU, D, e * 2 * FF + (up ? 128 : 0), MOE_SW, wave, lane); continue; } r -= 2 * B_MG;
        { const int e = r / B_FD, qq = r % B_FD;
            conv_block<0, 1>(a.moe_d + (size_t)e * FF * D, D, D, FF, 128 * (qq / 4), 256 * (qq % 4), ws + WS_WMD, FF, e * D, F8_SW, wave, lane); }
    }
    constexpr int I_ADA = 4 * 12 * 8, I_ROPE = M / 2;
    for (int it = gw; it < I_ADA + I_ROPE; it += NGW) {
        int r = it;
        if (r < I_ADA) {
            const int ls = r / 96, q = r % 96, cg = q / 8, kc = q % 8;
            const float* W = a.mod_w + (size_t)ls * D * 3072 + (size_t)(kc * 128) * 3072 + cg * 256 + 4 * lane;
            f32x4 acc[NB];
#pragma unroll
            for (int b = 0; b < NB; ++b) acc[b] = (f32x4){0.f, 0.f, 0.f, 0.f};
#pragma unroll 8
            for (int k = 0; k < 128; ++k) { const f32x4 w = *(const f32x4*)(W + (size_t)k * 3072);
#pragma unroll
                for (int b = 0; b < NB; ++b) acc[b] += w * sc[b * D + kc * 128 + k]; }
            float* P = (float*)(ws + WS_MODP);
#pragma unroll
            for (int b = 0; b < NB; ++b) *(f32x4*)(P + (size_t)(kc * 16 + ls * 4 + b) * 3072 + cg * 256 + 4 * lane) = acc[b];
            continue;
        }
        r -= I_ADA;
        {
            const int tok = 2 * r + (lane >> 5), i = lane & 31;
            const float ang = (float)a.pos[tok] * INVF[i];
            double rev = (double)ang * 0.15915494309189535; rev -= __builtin_rint(rev);
            const float fr = (float)rev;
            unsigned* R = (unsigned*)(ws + WS_ROPE) + (size_t)tok * 32;
            const _Float16 hc = (_Float16)__builtin_amdgcn_cosf(fr), hs = (_Float16)__builtin_amdgcn_sinf(fr);
            R[i] = (unsigned)__builtin_bit_cast(unsigned short, hc) | ((unsigned)__builtin_bit_cast(unsigned short, hs) << 16);
        }
    }
}

template <bool FROM_PARTIALS, bool ROUTE, bool SRC16 = false, bool OUT8 = ROUTE>
__device__ __forceinline__ void norm_phase(const Args& a, const void* xsrc, int ls, LAS unsigned char* lds, int G, int wave, int lane, int tid) {
    unsigned char* ws = a.ws;
    LAS float* cA = (LAS float*)lds;
    LAS float* cB = (LAS float*)(lds + 4096);
    LAS float* rwT = (LAS float*)(lds + 8192);
    bf16* H = (bf16*)(ws + WS_H);
    const float* P = (const float*)(ws + WS_MODP); const float* MF = (const float*)(ws + WS_MODF);
    if (ROUTE) { for (int i = tid; i < D * NE; i += NTHR) { const int k = i >> 3, e = i & 7; rwT[e * D + k] = a.router_w[i]; } }
    for (int ch = (G % 8 == 0) ? (blockIdx.x % 8) * (G / 8) + blockIdx.x / 8 : blockIdx.x; ch < NCHUNK; ch += G) {
        const int b = ch / (SEQ / 128);
        __syncthreads();
        for (int k = tid; k < D; k += NTHR) {
            float sh, scl;
            if (FROM_PARTIALS) { sh = a.mod_b[ls * 3072 + k]; scl = a.mod_b[ls * 3072 + D + k];
#pragma unroll
                for (int kc = 0; kc < 8; ++kc) { sh += P[(size_t)(kc * 16 + ls * 4 + b) * 3072 + k]; scl += P[(size_t)(kc * 16 + ls * 4 + b) * 3072 + D + k]; } }
            else { sh = MF[(size_t)(ls * 4 + b) * 3072 + k]; scl = MF[(size_t)(ls * 4 + b) * 3072 + D + k]; }
            cA[k] = a.norm_g[ls * D + k] * (1.0f + scl); cB[k] = sh;
        }
        int my_e0 = -1, my_e1 = -1; float my_w0 = 0.f, my_w1 = 0.f;
        __syncthreads();
        v2u nb16[2][4]; f32x4 nb32[2][4];
#define NP_LOAD(buf, ii) do { const int row_ = ch * 128 + wave * 16 + (ii); \
            if (SRC16) { const v2u* xr = (const v2u*)((const bf16*)xsrc + (size_t)row_ * D) + lane; _Pragma("unroll") for (int j = 0; j < 4; ++j) nb16[buf][j] = xr[64 * j]; } \
            else { const f32x4* xr = (const f32x4*)((const float*)xsrc + (size_t)row_ * D) + lane; _Pragma("unroll") for (int j = 0; j < 4; ++j) nb32[buf][j] = xr[64 * j]; } } while (0)
        NP_LOAD(0, 0);
        for (int i2 = 0; i2 < 16; i2 += 2) {
#pragma unroll
          for (int pb = 0; pb < 2; ++pb) {
            const int i = i2 + pb;
            if (pb == 0) NP_LOAD(1, i + 1); else if (i + 1 < 16) NP_LOAD(0, i + 1);
            const int row = ch * 128 + wave * 16 + i;
            f32x4 v[4]; float s = 0.f;
#pragma unroll
            for (int j = 0; j < 4; ++j) { if (SRC16) { const v2u t = nb16[pb][j]; v[j] = (f32x4){bflo(t.x), bfhi(t.x), bflo(t.y), bfhi(t.y)}; } else v[j] = nb32[pb][j]; }
#pragma unroll
            for (int j = 0; j < 4; ++j) s += (v[j].x * v[j].x + v[j].y * v[j].y) + (v[j].z * v[j].z + v[j].w * v[j].w);
            const float rinv = 1.0f / sqrtf(wave_sum(s) * (1.0f / D) + RMS_EPS);
            if (FROM_PARTIALS) { unsigned long long* x8 = (unsigned long long*)((bf16*)(ws + WS_XR) + (size_t)row * D) + lane;
#pragma unroll
                for (int j = 0; j < 4; ++j) x8[64 * j] = (unsigned long long)pk2(v[j].x, v[j].y) | ((unsigned long long)pk2(v[j].z, v[j].w) << 32); }
            unsigned long long* o8 = (unsigned long long*)(H + (size_t)row * D) + lane;
#pragma unroll
            for (int j = 0; j < 4; ++j) { const f32x4 ca = *(const LAS f32x4*)(cA + 4 * lane + 256 * j), cb = *(const LAS f32x4*)(cB + 4 * lane + 256 * j);
                v[j] = v[j] * rinv * ca + cb;
                if (OUT8) ((unsigned*)((unsigned char*)H + (size_t)row * D))[lane + 64 * j] = MOE_I8 ? pk_i8x4(v[j] * MOE_SA) : pk_fp8x4(v[j] * MOE_SA);
                else o8[64 * j] = (unsigned long long)pk2(v[j].x, v[j].y) | ((unsigned long long)pk2(v[j].z, v[j].w) << 32); }
            if (ROUTE) {
                float pe[NE];
#pragma unroll
                for (int e = 0; e < NE; ++e) pe[e] = 0.f;
#pragma unroll
                for (int j = 0; j < 4; ++j) {
#pragma unroll
                    for (int e = 0; e < NE; ++e) { const f32x4 w = *(const LAS f32x4*)(rwT + e * D + 4 * lane + 256 * j); pe[e] += (v[j].x * w.x + v[j].y * w.y) + (v[j].z * w.z + v[j].w * w.w); }
                    asm volatile("" ::: "memory"); }
                float lg[NE];
#pragma unroll
                for (int e = 0; e < NE; ++e) lg[e] = wave_sum(pe[e]);
                int i0 = 0; float v0 = lg[0];
#pragma unroll
                for (int e = 1; e < NE; ++e) if (lg[e] > v0) { v0 = lg[e]; i0 = e; }
                int i1 = -1; float v1 = -INFINITY;
#pragma unroll
                for (int e = 0; e < NE; ++e) if (e != i0 && lg[e] > v1) { v1 = lg[e]; i1 = e; }
                const float w0 = 1.0f / (1.0f + expf(v1 - v0)), w1 = 1.0f - w0;
                if (lane == i) { my_e0 = i0; my_e1 = i1; my_w0 = w0; my_w1 = w1; }
            }
          }
        }
#undef NP_LOAD
        if (ROUTE) {
            unsigned* CNT = (unsigned*)(ws + WS_CTL) + CW_CNT; int* RT2 = (int*)(ws + WS_RT2); float* RW2 = (float*)(ws + WS_RW2);
#pragma unroll
            for (int s = 0; s < 2; ++s) {
                const int me = lane < 16 ? (s ? my_e1 : my_e0) : -1; int rank = 0, mycount = 0;
#pragma unroll
                for (int e = 0; e < NE; ++e) { const unsigned long long mask = __ballot(me == e); if (lane == e) mycount = __popcll(mask); if (me == e) rank = __popcll(mask & ((1ull << lane) - 1ull)); }
                int base = 0; if (lane < NE && mycount > 0) base = (int)__hip_atomic_fetch_add(CNT + s * 8 + lane, (unsigned)mycount, __ATOMIC_RELAXED, __HIP_MEMORY_SCOPE_AGENT);
                const int bs = __shfl(base, me < 0 ? 0 : me);
                if (lane < 16) { const size_t p = (size_t)(s * 8 + me) * M + bs + rank; RT2[p] = ch * 128 + wave * 16 + lane; RW2[p] = s ? my_w1 : my_w0; }
            }
        }
    }
    if (FROM_PARTIALS) {
        float* MFw = (float*)(ws + WS_MODF);
        for (int idx = blockIdx.x * NTHR + tid; idx < 16 * 3072; idx += G * NTHR) { const int lsb = idx / 3072, n = idx % 3072; float s = a.mod_b[(lsb >> 2) * 3072 + n];
#pragma unroll
            for (int kc = 0; kc < 8; ++kc) s += P[(size_t)(kc * 16 + lsb) * 3072 + n];
            MFw[idx] = s; }
    }
}

__device__ __forceinline__ void conv_phase(const Args& a, int G, int tid) {
    unsigned char* ws = a.ws;
    const bf16* V = (const bf16*)(ws + WS_V); const bf16* Bg = (const bf16*)(ws + WS_BG); bf16* Y = (bf16*)(ws + WS_H);
    const int cg = tid & 127, rs = tid >> 7;
    float w0[8], w1[8], w2[8];
#pragma unroll
    for (int i = 0; i < 8; ++i) { w0[i] = a.conv_w[8 * cg + i]; w1[i] = a.conv_w[D + 8 * cg + i]; w2[i] = a.conv_w[2 * D + 8 * cg + i]; }
    for (int ch = blockIdx.x; ch < NCHUNK; ch += G) {
        const int r0 = ch * 128 + rs * 32, t0 = r0 & (SEQ - 1);
        v4u zz = (v4u){0u, 0u, 0u, 0u};
        v4u vm2 = t0 >= 2 ? *(const v4u*)(V + (size_t)(r0 - 2) * D + 8 * cg) : zz;
        v4u vm1 = t0 >= 1 ? *(const v4u*)(V + (size_t)(r0 - 1) * D + 8 * cg) : zz;
#pragma unroll 4
        for (int i = 0; i < 32; ++i) {
            const size_t off = (size_t)(r0 + i) * D + 8 * cg;
            const v4u v = *(const v4u*)(V + off), bg = *(const v4u*)(Bg + off);
            v4u o; float ylo8[4], yhi8[4];
#pragma unroll
            for (int q = 0; q < 4; ++q) {
                const float ylo = bflo(bg[q]) * (w0[2 * q] * bflo(vm2[q]) + w1[2 * q] * bflo(vm1[q]) + w2[2 * q] * bflo(v[q]));
                const float yhi = bfhi(bg[q]) * (w0[2 * q + 1] * bfhi(vm2[q]) + w1[2 * q + 1] * bfhi(vm1[q]) + w2[2 * q + 1] * bfhi(v[q]));
                o[q] = pk2(ylo, yhi); if (WOUT_FP8) { ylo8[q] = ylo; yhi8[q] = yhi; } }
            if (WOUT_FP8) { v2u w8; w8.x = pk_fp8x4((f32x4){ylo8[0], yhi8[0], ylo8[1], yhi8[1]} * F8_SH); w8.y = pk_fp8x4((f32x4){ylo8[2], yhi8[2], ylo8[3], yhi8[3]} * F8_SH); *(v2u*)((unsigned char*)Y + off) = w8; }
            else *(v4u*)(Y + off) = o;
            vm2 = vm1; vm1 = v;
        }
    }
}

__device__ __forceinline__ void bias_gemv(const Args& a, int gw, int NGW, int lane) {
    unsigned char* ws = a.ws; const float* MF = (const float*)(ws + WS_MODF); float* BV = (float*)(ws + WS_BIASV);
    constexpr int NROW = 2 * FF + QKVP, RPW = 5;
    for (int base = 0; base < NROW; base += RPW * NGW) {
    float res[RPW][NB];
#pragma unroll
    for (int i = 0; i < RPW; ++i) {
        const int r = base + gw + i * NGW; const bool ok = r < NROW; const int rr = ok ? r : 0;
        const int ls = rr < 2 * FF ? 1 : 2, np = ls == 1 ? rr : rr - 2 * FF;
        float wf[16];
        if ((ls == 1 && DENSE_GU_FP8) || (ls == 2 && QKV_I8)) { const v4u w8 = *(const v4u*)(ws + (ls == 1 ? WS_WFGU : WS_WQKV) + (size_t)np * D + 16 * lane);
#pragma unroll
            for (int q = 0; q < 4; ++q) {
                if (GU_I8 || ls == 2) { const int w = (int)w8[q]; wf[4 * q] = (float)((w << 24) >> 24) * (1.0f / GU_SW); wf[4 * q + 1] = (float)((w << 16) >> 24) * (1.0f / GU_SW); wf[4 * q + 2] = (float)((w << 8) >> 24) * (1.0f / GU_SW); wf[4 * q + 3] = (float)(w >> 24) * (1.0f / GU_SW); }
                else { wf[4 * q] = __builtin_amdgcn_cvt_f32_fp8((int)w8[q], 0) * (1.0f / GU_SW); wf[4 * q + 1] = __builtin_amdgcn_cvt_f32_fp8((int)w8[q], 1) * (1.0f / GU_SW);
                    wf[4 * q + 2] = __builtin_amdgcn_cvt_f32_fp8((int)w8[q], 2) * (1.0f / GU_SW); wf[4 * q + 3] = __builtin_amdgcn_cvt_f32_fp8((int)w8[q], 3) * (1.0f / GU_SW); } } }
        else { const bf16* wrow = (ls == 1 ? (const bf16*)(ws + WS_WFGU) : (const bf16*)(ws + WS_WQKV)) + (size_t)np * D + 16 * lane;
            const v4u w0 = *(const v4u*)wrow, w1 = *(const v4u*)(wrow + 8);
#pragma unroll
            for (int q = 0; q < 4; ++q) { wf[2 * q] = bflo(w0[q]); wf[2 * q + 1] = bfhi(w0[q]); wf[8 + 2 * q] = bflo(w1[q]); wf[8 + 2 * q + 1] = bfhi(w1[q]); } }
#pragma unroll
        for (int b = 0; b < NB; ++b) { const float* sh = MF + (size_t)(ls * 4 + b) * 3072 + 16 * lane; float p = 0.f;
#pragma unroll
            for (int q = 0; q < 4; ++q) { const f32x4 s4 = *(const f32x4*)(sh + 4 * q); p += (wf[4 * q] * s4.x + wf[4 * q + 1] * s4.y) + (wf[4 * q + 2] * s4.z + wf[4 * q + 3] * s4.w); }
            res[i][b] = wave_sum(p); }
    }
#pragma unroll
    for (int i = 0; i < RPW; ++i) { const int r = base + gw + i * NGW;
        if (r < NROW && lane == 0) { const int ls = r < 2 * FF ? 1 : 2, np = ls == 1 ? r : r - 2 * FF;
#pragma unroll
            for (int b = 0; b < NB; ++b) BV[(size_t)((ls - 1) * 4 + b) * (2 * FF) + np] = res[i][b]; } }
    }
}
typedef float f32x16 __attribute__((ext_vector_type(16)));
typedef short bf16x8 __attribute__((ext_vector_type(8)));
typedef short v4i16_t __attribute__((ext_vector_type(4)));
constexpr int ATT_TILES = NB * NH * 256;
constexpr int KROWB = 144;
constexpr int VROWB = 192;
template <int PASS>
__device__ __forceinline__ void attn_mfma(const Args& a, LAS unsigned char* lds, int gw, int NGW, int wave, int lane) {
    unsigned char* ws = a.ws;
    const bf16* QKV = (const bf16*)(ws + WS_QKV); bf16* AO = (bf16*)(ws + WS_H); float* LSE = (float*)(ws + WS_LSE);
    const int r32 = lane & 31, hi = lane >> 5;
    LAS unsigned char* vbuf = lds + wave * (32 * VROWB + 32 * KROWB);
    LAS unsigned char* kbuf = vbuf + 32 * VROWB;
    const int L16 = lane & 15, tq = L16 >> 2, tp = L16 & 3, gi = (lane >> 4) & 1;
    LAS unsigned char* trbase = vbuf + (4 * hi + tq) * VROWB + (16 * gi + 4 * tp) * 2;
    const bool OWNER = (NGW == 2048);
    const int ntl = OWNER ? NH * 128 : ATT_TILES, tstep = OWNER ? 256 : NGW;
    for (int lt = OWNER ? ((int)blockIdx.x >> 3) * NWAVES + wave : gw; lt < ntl; lt += tstep) {
        int tile = lt;
        if (OWNER) { const int x = (int)blockIdx.x & 7, hq_ = lt >> 7, tl = lt & 127, sh_ = 2 * (hq_ / 5), hb = 128 >> sh_;
            tile = ((tl >> (7 - sh_)) << (8 - sh_)) + (x & 1) * hb + (tl & (hb - 1)) + 256 * ((x >> 1) * NH + hq_); }
        const int ti = tile & 255, bh = tile >> 8, b = bh / NH, hq = bh - b * NH, g = hq / 5, slot = hq - g * 5;
        const int sh = 2 * g, r = 1 << sh, nblk = 256 >> sh, rho = ti >> (8 - sh), blk = ti & (nblk - 1), i0 = 32 * blk;
        const size_t tok0 = (size_t)b * SEQ + rho;
        const bf16* Qp = QKV + (tok0 + (size_t)r * (i0 + r32)) * QKVP + hq * 64 + 8 * hi;
        bf16x8 qf[4];
#pragma unroll
        for (int ds = 0; ds < 4; ++ds) qf[ds] = *(const bf16x8*)(Qp + 16 * ds);
        const int nkb = blk + 1 < 5 ? blk + 1 : 5;
        float m_run = -1e30f, l_run = 0.f, LT = 0.f;
        f32x16 o0 = {}, o1 = {};
        if (PASS == 1) { const float* lp = LSE + (tok0 + (size_t)r * (i0 + r32)) * 16 + slot; const float l0 = lp[0], l1 = lp[5], l2 = lp[10];
            const float mm = fmaxf(fmaxf(l0, l1), l2);
            LT = mm + __builtin_amdgcn_logf(__builtin_amdgcn_exp2f(l0 - mm) + __builtin_amdgcn_exp2f(l1 - mm) + __builtin_amdgcn_exp2f(l2 - mm)); }
        v4u krn[4], vrn[4];
#define ATT_LOAD(jj) do { const int p0_ = i0 + 32 * ((jj) - (nkb - 1)); \
            _Pragma("unroll") for (int c = 0; c < 4; ++c) { const int pi = lane + 64 * c, row = pi >> 3, chunk = pi & 7; const bf16* rp_ = QKV + (tok0 + (size_t)r * (p0_ + row)) * QKVP + 8 * chunk; \
                krn[c] = *(const v4u*)(rp_ + (NH + hq) * 64); if (PASS == 1) vrn[c] = *(const v4u*)(rp_ + (2 * NH + hq) * 64); } } while (0)
        ATT_LOAD(0);
        for (int j = 0; j < nkb; ++j) {
            const int kb = j - (nkb - 1);
            bf16x8 kf[4]; v4u vraw[4];
#pragma unroll
            for (int c = 0; c < 4; ++c) { const int pi = lane + 64 * c, row = pi >> 3, chunk = pi & 7; *(LAS v4u*)(kbuf + row * KROWB + chunk * 16) = krn[c]; }
            if (PASS == 1) {
#pragma unroll
                for (int c = 0; c < 4; ++c) vraw[c] = vrn[c]; }
            if (j + 1 < nkb) ATT_LOAD(j + 1);
#pragma unroll
            for (int ds = 0; ds < 4; ++ds) kf[ds] = *(const LAS bf16x8*)(kbuf + r32 * KROWB + (16 * ds + 8 * hi) * 2);
            f32x16 s = {};
#pragma unroll
            for (int ds = 0; ds < 4; ++ds) s = __builtin_amdgcn_mfma_f32_32x32x16_bf16(kf[ds], qf[ds], s, 0, 0, 0);
            if (kb == 0) {
#pragma unroll
                for (int q = 0; q < 16; ++q) { const int c = (q & 3) + 8 * (q >> 2) + 4 * hi; if (c > r32) s[q] = -1e30f; }
            } else if (kb == -4) {
#pragma unroll
                for (int q = 0; q < 16; ++q) { const int c = (q & 3) + 8 * (q >> 2) + 4 * hi; if (c < r32) s[q] = -1e30f; }
            }
            if (PASS == 0) {
                float bm = s[0];
#pragma unroll
                for (int q = 1; q < 16; ++q) bm = fmaxf(bm, s[q]);
                const float mn = fmaxf(m_run, bm); float acc = 0.f;
#pragma unroll
                for (int q = 0; q < 16; ++q) acc += __builtin_amdgcn_exp2f(s[q] - mn);
                l_run = l_run * __builtin_amdgcn_exp2f(m_run - mn) + acc; m_run = mn;
            } else {
#pragma unroll
                for (int c = 0; c < 4; ++c) { const int pi = lane + 64 * c, row = pi >> 3, chunk = pi & 7; *(LAS v4u*)(vbuf + row * VROWB + chunk * 16) = vraw[c]; }
                v4u pw0, pw1;
                { float p[16];
#pragma unroll
                  for (int q = 0; q < 16; ++q) p[q] = __builtin_amdgcn_exp2f(s[q] - LT);
                  pw0.x = pg8::cvt_pk_bf16(p[0], p[1]); pw0.y = pg8::cvt_pk_bf16(p[2], p[3]); pw0.z = pg8::cvt_pk_bf16(p[4], p[5]); pw0.w = pg8::cvt_pk_bf16(p[6], p[7]);
                  pw1.x = pg8::cvt_pk_bf16(p[8], p[9]); pw1.y = pg8::cvt_pk_bf16(p[10], p[11]); pw1.z = pg8::cvt_pk_bf16(p[12], p[13]); pw1.w = pg8::cvt_pk_bf16(p[14], p[15]); }
                const bf16x8 pa0 = __builtin_bit_cast(bf16x8, pw0), pa1 = __builtin_bit_cast(bf16x8, pw1);
#pragma unroll
                for (int db = 0; db < 2; ++db) {
                    bf16x8 vb[2];
#pragma unroll
                    for (int s2 = 0; s2 < 2; ++s2) {
                        const v4i16_t lo = __builtin_amdgcn_ds_read_tr16_b64_v4i16((LAS v4i16_t*)(trbase + (16 * s2) * VROWB + 64 * db));
                        const v4i16_t hh = __builtin_amdgcn_ds_read_tr16_b64_v4i16((LAS v4i16_t*)(trbase + (16 * s2 + 8) * VROWB + 64 * db));
                        vb[s2] = (bf16x8){lo[0], lo[1], lo[2], lo[3], hh[0], hh[1], hh[2], hh[3]};
                    }
                    if (db == 0) { o0 = __builtin_amdgcn_mfma_f32_32x32x16_bf16(pa0, vb[0], o0, 0, 0, 0); o0 = __builtin_amdgcn_mfma_f32_32x32x16_bf16(pa1, vb[1], o0, 0, 0, 0); }
                    else         { o1 = __builtin_amdgcn_mfma_f32_32x32x16_bf16(pa0, vb[0], o1, 0, 0, 0); o1 = __builtin_amdgcn_mfma_f32_32x32x16_bf16(pa1, vb[1], o1, 0, 0, 0); }
                }
            }
        }
        if (PASS == 0) {
            const float m2 = __shfl_xor(m_run, 32), l2 = __shfl_xor(l_run, 32);
            const float mt = fmaxf(m_run, m2), lt = l_run * __builtin_amdgcn_exp2f(m_run - mt) + l2 * __builtin_amdgcn_exp2f(m2 - mt);
            if (hi == 0) LSE[(tok0 + (size_t)r * (i0 + r32)) * 16 + hq] = mt + __builtin_amdgcn_logf(lt);
        } else {
#pragma unroll
            for (int q = 0; q < 16; ++q) { const int c = (q & 3) + 8 * (q >> 2) + 4 * hi;
                if (WO_FP8) { unsigned char* op8 = (unsigned char*)AO + (tok0 + (size_t)r * (i0 + c)) * D + hq * 64 + r32;
                    op8[0] = (unsigned char)(pk_fp8x4((f32x4){o0[q] * F8_SO, 0.f, 0.f, 0.f}) & 0xffu); op8[32] = (unsigned char)(pk_fp8x4((f32x4){o1[q] * F8_SO, 0.f, 0.f, 0.f}) & 0xffu); }
                else { bf16* op = AO + (tok0 + (size_t)r * (i0 + c)) * D + hq * 64 + r32; op[0] = (bf16)f2bf(o0[q]); op[32] = (bf16)f2bf(o1[q]); } }
            if (hq == 0) {
#pragma unroll
                for (int c = 0; c < 4; ++c) { const int pi = lane + 64 * c, row = pi >> 3, chunk = pi & 7;
                    if (WO_FP8) { if (chunk < 4) *(v4u*)((unsigned char*)AO + (tok0 + i0 + row) * D + 960 + 16 * chunk) = (v4u){0u, 0u, 0u, 0u}; }
                    else *(v4u*)(AO + (tok0 + i0 + row) * D + 960 + 8 * chunk) = (v4u){0u, 0u, 0u, 0u}; }
            }
        }
    }
}

__device__ __forceinline__ void attn_one(const Args& a, LAS unsigned char* lds, int gw, int NGW, int wave, int lane) {
    unsigned char* ws = a.ws;
    const bf16* QKV = (const bf16*)(ws + WS_QKV); unsigned char* AO = ws + WS_H; float* LSE = (float*)(ws + WS_LSE);
    const int r32 = lane & 31, hi = lane >> 5;
    LAS unsigned char* vbuf = lds + wave * (32 * VROWB + 32 * KROWB);
    LAS unsigned char* kbuf = vbuf + 32 * VROWB;
    const int L16 = lane & 15, tq = L16 >> 2, tp = L16 & 3, gi = (lane >> 4) & 1;
    LAS unsigned char* trbase = vbuf + (4 * hi + tq) * VROWB + (16 * gi + 4 * tp) * 2;
    const bool OWNER = (NGW == 2048);
    const int ntl = OWNER ? NH * 128 : ATT_TILES, tstep = OWNER ? 256 : NGW;
    for (int lt = OWNER ? ((int)blockIdx.x >> 3) * NWAVES + wave : gw; lt < ntl; lt += tstep) {
        int tile = lt;
        if (OWNER) { const int x = (int)blockIdx.x & 7, hq_ = lt >> 7, tl = lt & 127, sh_ = 2 * (hq_ / 5), hb = 128 >> sh_;
            tile = ((tl >> (7 - sh_)) << (8 - sh_)) + (x & 1) * hb + (tl & (hb - 1)) + 256 * ((x >> 1) * NH + hq_); }
        const int ti = tile & 255, bh = tile >> 8, b = bh / NH, hq = bh - b * NH, g = hq / 5;
        const int sh = 2 * g, r = 1 << sh, nblk = 256 >> sh, rho = ti >> (8 - sh), blk = ti & (nblk - 1), i0 = 32 * blk;
        const size_t tok0 = (size_t)b * SEQ + rho;
        const bf16* Qp = QKV + (tok0 + (size_t)r * (i0 + r32)) * QKVP + hq * 64 + 8 * hi;
        bf16x8 qf[4];
#pragma unroll
        for (int ds = 0; ds < 4; ++ds) qf[ds] = *(const bf16x8*)(Qp + 16 * ds);
        const int kb0 = blk >= 4 ? 0 : 4 - blk;
        v4u krn[4], vrn[4];
#define A1_LOAD(dst, kbi, hoff) do { const int p0_ = i0 + 32 * ((kbi) - 4); \
            _Pragma("unroll") for (int c = 0; c < 4; ++c) { const int pi = lane + 64 * c, row = pi >> 3, chunk = pi & 7; \
                dst[c] = *(const v4u*)(QKV + (tok0 + (size_t)r * (p0_ + row)) * QKVP + 8 * chunk + (hoff) * 64); } } while (0)
        A1_LOAD(krn, kb0, NH + hq);
        f32x16 S[5];
        float m_run = -1e30f, l_run = 0.f;
#pragma unroll
        for (int kbi = 0; kbi < 5; ++kbi) {
            if (kbi >= kb0) {
#pragma unroll
                for (int c = 0; c < 4; ++c) { const int pi = lane + 64 * c, row = pi >> 3, chunk = pi & 7; *(LAS v4u*)(kbuf + row * KROWB + chunk * 16) = krn[c]; }
                if (kbi < 4) A1_LOAD(krn, kbi + 1, NH + hq); else A1_LOAD(vrn, kb0, 2 * NH + hq);
                bf16x8 kf[4];
#pragma unroll
                for (int ds = 0; ds < 4; ++ds) kf[ds] = *(const LAS bf16x8*)(kbuf + r32 * KROWB + (16 * ds + 8 * hi) * 2);
                f32x16 s = {};
#pragma unroll
                for (int ds = 0; ds < 4; ++ds) s = __builtin_amdgcn_mfma_f32_32x32x16_bf16(kf[ds], qf[ds], s, 0, 0, 0);
                if (kbi == 4) {
#pragma unroll
                    for (int q = 0; q < 16; ++q) { const int c = (q & 3) + 8 * (q >> 2) + 4 * hi; if (c > r32) s[q] = -1e30f; }
                } else if (kbi == 0) {
#pragma unroll
                    for (int q = 0; q < 16; ++q) { const int c = (q & 3) + 8 * (q >> 2) + 4 * hi; if (c < r32) s[q] = -1e30f; }
                }
                float bm = s[0];
#pragma unroll
                for (int q = 1; q < 16; ++q) bm = fmaxf(bm, s[q]);
                const float mn = fmaxf(m_run, bm); float acc = 0.f;
#pragma unroll
                for (int q = 0; q < 16; ++q) acc += __builtin_amdgcn_exp2f(s[q] - mn);
                l_run = l_run * __builtin_amdgcn_exp2f(m_run - mn) + acc; m_run = mn;
                S[kbi] = s;
            }
        }
        float lse;
        { const float m2 = __shfl_xor(m_run, 32), l2 = __shfl_xor(l_run, 32);
          const float mt = fmaxf(m_run, m2), ltot = l_run * __builtin_amdgcn_exp2f(m_run - mt) + l2 * __builtin_amdgcn_exp2f(m2 - mt);
          lse = mt + __builtin_amdgcn_logf(ltot); }
        if (hi == 0) LSE[(tok0 + (size_t)r * (i0 + r32)) * 16 + hq] = lse;
        f32x16 o0 = {}, o1 = {};
#pragma unroll
        for (int kbi = 0; kbi < 5; ++kbi) {
            if (kbi >= kb0) {
#pragma unroll
                for (int c = 0; c < 4; ++c) { const int pi = lane + 64 * c, row = pi >> 3, chunk = pi & 7; *(LAS v4u*)(vbuf + row * VROWB + chunk * 16) = vrn[c]; }
                if (kbi < 4) A1_LOAD(vrn, kbi + 1, 2 * NH + hq);
                v4u pw0, pw1;
                { float p[16];
#pragma unroll
                  for (int q = 0; q < 16; ++q) p[q] = __builtin_amdgcn_exp2f(S[kbi][q] - lse);
                  pw0.x = pg8::cvt_pk_bf16(p[0], p[1]); pw0.y = pg8::cvt_pk_bf16(p[2], p[3]); pw0.z = pg8::cvt_pk_bf16(p[4], p[5]); pw0.w = pg8::cvt_pk_bf16(p[6], p[7]);
                  pw1.x = pg8::cvt_pk_bf16(p[8], p[9]); pw1.y = pg8::cvt_pk_bf16(p[10], p[11]); pw1.z = pg8::cvt_pk_bf16(p[12], p[13]); pw1.w = pg8::cvt_pk_bf16(p[14], p[15]); }
                const bf16x8 pa0 = __builtin_bit_cast(bf16x8, pw0), pa1 = __builtin_bit_cast(bf16x8, pw1);
#pragma unroll
                for (int db = 0; db < 2; ++db) {
                    bf16x8 vb[2];
#pragma unroll
                    for (int s2 = 0; s2 < 2; ++s2) {
                        const v4i16_t lo = __builtin_amdgcn_ds_read_tr16_b64_v4i16((LAS v4i16_t*)(trbase + (16 * s2) * VROWB + 64 * db));
                        const v4i16_t hh = __builtin_amdgcn_ds_read_tr16_b64_v4i16((LAS v4i16_t*)(trbase + (16 * s2 + 8) * VROWB + 64 * db));
                        vb[s2] = (bf16x8){lo[0], lo[1], lo[2], lo[3], hh[0], hh[1], hh[2], hh[3]};
                    }
                    if (db == 0) { o0 = __builtin_amdgcn_mfma_f32_32x32x16_bf16(pa0, vb[0], o0, 0, 0, 0); o0 = __builtin_amdgcn_mfma_f32_32x32x16_bf16(pa1, vb[1], o0, 0, 0, 0); }
                    else         { o1 = __builtin_amdgcn_mfma_f32_32x32x16_bf16(pa0, vb[0], o1, 0, 0, 0); o1 = __builtin_amdgcn_mfma_f32_32x32x16_bf16(pa1, vb[1], o1, 0, 0, 0); }
                }
            }
        }
#undef A1_LOAD
#pragma unroll
        for (int q = 0; q < 16; ++q) { const int c = (q & 3) + 8 * (q >> 2) + 4 * hi;
            unsigned char* op8 = AO + (tok0 + (size_t)r * (i0 + c)) * D + hq * 64 + r32;
            op8[0] = (unsigned char)(pk_fp8x4((f32x4){o0[q] * F8_SO, 0.f, 0.f, 0.f}) & 0xffu); op8[32] = (unsigned char)(pk_fp8x4((f32x4){o1[q] * F8_SO, 0.f, 0.f, 0.f}) & 0xffu); }
        if (hq == 0) {
#pragma unroll
            for (int c = 0; c < 4; ++c) { const int pi = lane + 64 * c, row = pi >> 3, chunk = pi & 7;
                if (chunk < 4) *(v4u*)(AO + (tok0 + i0 + row) * D + 960 + 16 * chunk) = (v4u){0u, 0u, 0u, 0u}; }
        }
    }
}
__device__ __forceinline__ void attn_fix(const Args& a, int G, int wave, int lane) {
    unsigned char* AO = a.ws + WS_H; const float* LSE = (const float*)(a.ws + WS_LSE);
    const int head = lane >> 2, slot = head % 5; const bool act = lane < 60;
    for (int ch = (G % 8 == 0) ? (blockIdx.x % 8) * (G / 8) + blockIdx.x / 8 : blockIdx.x; ch < NCHUNK; ch += G) {
        const int t0 = ch * 128 + wave * 16;
#pragma unroll 1
        for (int tb = 0; tb < 16; tb += 4) {
            v4u raw[4]; float l0[4], l1[4], l2[4];
#pragma unroll
            for (int j = 0; j < 4; ++j) { const size_t tok = (size_t)(t0 + tb + j);
                raw[j] = act ? *(const v4u*)(AO + tok * D + 16 * lane) : (v4u){0u, 0u, 0u, 0u};
                l0[j] = act ? LSE[tok * 16 + slot] : 0.f; l1[j] = act ? LSE[tok * 16 + slot + 5] : 0.f; l2[j] = act ? LSE[tok * 16 + slot + 10] : 0.f; }
#pragma unroll
            for (int j = 0; j < 4; ++j) { const size_t tok = (size_t)(t0 + tb + j);
                const float mm = fmaxf(fmaxf(l0[j], l1[j]), l2[j]);
                const float LT = mm + __builtin_amdgcn_logf(__builtin_amdgcn_exp2f(l0[j] - mm) + __builtin_amdgcn_exp2f(l1[j] - mm) + __builtin_amdgcn_exp2f(l2[j] - mm));
                const float mine = head < 5 ? l0[j] : (head < 10 ? l1[j] : l2[j]);
                const float f = __builtin_amdgcn_exp2f(mine - LT);
                v4u o;
#pragma unroll
                for (int q = 0; q < 4; ++q) { const int w = (int)raw[j][q];
                    o[q] = pk_fp8x4((f32x4){__builtin_amdgcn_cvt_f32_fp8(w, 0) * f, __builtin_amdgcn_cvt_f32_fp8(w, 1) * f, __builtin_amdgcn_cvt_f32_fp8(w, 2) * f, __builtin_amdgcn_cvt_f32_fp8(w, 3) * f}); }
                if (act) *(v4u*)(AO + tok * D + 16 * lane) = o; }
        }
    }
}

__device__ __forceinline__ void final_norm_phase(const Args& a, int gw, int NGW, int lane) {
    const bf16* XR = (const bf16*)(a.ws + WS_XR); const bf16* Y1 = (const bf16*)(a.ws + WS_Y1);
    f32x4 g[4];
#pragma unroll
    for (int j = 0; j < 4; ++j) g[j] = *((const f32x4*)a.final_g + lane + 64 * j);
    for (int row0 = gw; row0 < M; row0 += 2 * NGW) {
        v2u vv[2][4], yy[2][4];
#pragma unroll
        for (int q = 0; q < 2; ++q) { const int row = row0 + q * NGW; if (row < M) { const v2u* xr = (const v2u*)(XR + (size_t)row * D) + lane; const v2u* yr = (const v2u*)(Y1 + (size_t)row * D) + lane;
#pragma unroll
            for (int j = 0; j < 4; ++j) { vv[q][j] = xr[64 * j]; yy[q][j] = yr[64 * j]; } } }
#pragma unroll
        for (int q = 0; q < 2; ++q) { const int row = row0 + q * NGW; if (row < M) { f32x4* xo = (f32x4*)(a.out + (size_t)row * D) + lane; f32x4 v[4]; float s = 0.f;
#pragma unroll
            for (int j = 0; j < 4; ++j) { v[j] = (f32x4){bflo(vv[q][j].x) + bflo(yy[q][j].x), bfhi(vv[q][j].x) + bfhi(yy[q][j].x), bflo(vv[q][j].y) + bflo(yy[q][j].y), bfhi(vv[q][j].y) + bfhi(yy[q][j].y)};
                s += (v[j].x * v[j].x + v[j].y * v[j].y) + (v[j].z * v[j].z + v[j].w * v[j].w); }
            const float rinv = 1.0f / sqrtf(wave_sum(s) * (1.0f / D) + RMS_EPS);
#pragma unroll
            for (int j = 0; j < 4; ++j) xo[64 * j] = v[j] * rinv * g[j]; } }
    }
}

constexpr int NPHASE = 15;
__global__ void __launch_bounds__(NTHR, 2) trunk_fwd(Args args) {
    extern __shared__ __attribute__((aligned(16))) unsigned char lds_raw[];
    LAS unsigned char* lds = (LAS unsigned char*)lds_raw;
    volatile LAS unsigned* MISC = (volatile LAS unsigned*)(lds + MISC_OFF);
    const int tid = threadIdx.x, lane = tid & 63, wave = __builtin_amdgcn_readfirstlane(tid >> 6);
    const int G = gridDim.x; const int bx = blockIdx.x; const int vcu = (G % 8 == 0) ? (bx % 8) * (G / 8) + bx / 8 : bx;
    const int gw = vcu * NWAVES + wave, NGW = G * NWAVES;
    unsigned char* ws = args.ws;
    unsigned* ctl = (unsigned*)(ws + WS_CTL);
    if (tid < 256) ((LAS unsigned*)(lds + LDSCTL_OFF))[tid] = 0u;
    __syncthreads();
    XcdBarrier bar; bar.bar = ctl + CW_BAR; bar.x = 0; bar.st = nullptr;
    if (!MK_PER_PHASE) bar = xcd_barrier_post(ctl + CW_BAR, MISC + 8);
    if (!MK_PER_PHASE && tid == 0) __hip_atomic_fetch_or(ctl + CW_XMAP + (bx & 7), 1u << bar.x, __ATOMIC_RELAXED, __HIP_MEMORY_SCOPE_AGENT);
    bool local_ok = false;
    const int lo = args.ph_lo, hi = args.ph_hi;
#define IN(k) (lo <= (k) && (k) < hi)
#ifndef LOCAL_SEAMS
#define LOCAL_SEAMS 0x772u
#endif
#define SEAM(k) do { if (IN(k) && IN((k) + 1)) { if (((LOCAL_SEAMS >> (k)) & 1u) && local_ok) xcd_barrier_local(bar); else xcd_barrier(bar); } } while (0)
#define Hb ((bf16*)(ws + WS_H))
#define MF ((const float*)(ws + WS_MODF))

#ifndef PROBE_DUP
#define PROBE_DUP 0u
#endif
#ifndef PROBE_REP
#define PROBE_REP 1
#endif
#ifndef NOPH_MASK
#define NOPH_MASK 0u
#endif
#define RUN(k, body) do { if (IN(k) && !((NOPH_MASK >> (k)) & 1u)) { body; if ((PROBE_DUP >> (k)) & 1u) { _Pragma("unroll") for (int rep_ = 0; rep_ < PROBE_REP; ++rep_) { xcd_barrier(bar); body; } } } SEAM(k); } while (0)
#define COMMA ,
#define PH_GEMM(EPI, ORD, Aptr, Bptr, Mv, Nv, Kv, ...) do { pg8::Gemm g{Aptr, Bptr, Mv, Nv, Kv}; pg8::StaticOrder S; S.init(Mv, Nv, G, bx); EPI E{__VA_ARGS__}; \
        pg8::gemm_phase<EPI, pg8::StaticOrder, true, true>(lds, g, S, E); } while (0)
#define MOE_GU() do { pg8::MoeOrder S; S.init(ctl + CW_CNT, 2 * FF / 256, G, bx, (const int*)(ws + WS_RT2)); \
        pg8::Gemm g{Hb, (const bf16*)(ws + WS_WMGU), 0, 0, D}; EpiSwiGLU8 E{ws + WS_MHID, 2 * FF / 256}; \
        pg8::gemm_phase<EpiSwiGLU8, pg8::MoeOrder, true, true, true, 1, (MOE_I8 != 0)>(lds, g, S, E, lds + TOKSLOT_OFF); } while (0)
#define ZGp ((const float*)(ws + WS_ZG))
#define MOE_DN() do { pg8::MoeOrderId S; S.init(ctl + CW_CNT, D / 256, G, bx, (const int*)(ws + WS_IDENT), true); \
        LAS float* gt = (LAS float*)(lds + GATE_OFF); for (int i_ = tid; i_ < NB * D; i_ += NTHR) gt[i_] = MF[(size_t)(3 * 4 + (i_ >> 10)) * 3072 + 2048 + (i_ & (D - 1))]; __syncthreads(); \
        pg8::Gemm g{(const bf16*)(ws + WS_MHID), (const bf16*)(ws + WS_WMD), 0, 0, FF}; \
        EpiMoeDown E{XRp, (bf16*)(ws + WS_Y1), (const int*)(ws + WS_RT2), (const float*)(ws + WS_RW2), gt, 1.0f / (F8_SH * F8_SW), lds + RED_OFF}; \
        pg8::gemm_phase<EpiMoeDown, pg8::MoeOrderId, true, true, true, 1>(lds, g, S, E, lds + TOKSLOT_OFF); } while (0)
#define PH_GEMM8(EPI, I8v, Aptr, Bptr, Mv, Nv, Kv, ...) do { pg8::Gemm g{Aptr, Bptr, Mv, Nv, Kv}; pg8::StaticOrder S; S.init(Mv, Nv, G, bx, (const int*)(ws + WS_IDENT)); EPI E{__VA_ARGS__}; \
        pg8::gemm_phase<EPI, pg8::StaticOrder, true, true, true, 1, I8v>(lds, g, S, E, lds + TOKSLOT_OFF); } while (0)
#define SSb ((float*)(ws + WS_SS))
#define BV ((const float*)(ws + WS_BIASV))
    RUN(0, p0_prologue(args, lds, gw, NGW, wave, lane, tid));
    if (!MK_PER_PHASE && LOCAL_SEAMS && IN(0) && IN(1) && G == 256) {
        unsigned all = 0u; bool one = true;
#pragma unroll
        for (int j = 0; j < 8; ++j) { const unsigned m = xb_ld(ctl + CW_XMAP + j); one = one && (__builtin_popcount(m) == 1); all |= m; }
        local_ok = one && (__builtin_popcount(all) == 8) && (MISC[8] == 32u);
    }
    RUN(1, (norm_phase<true, false, false, (CONVIN_I8 != 0)>(args, args.x, 0, lds, G, wave, lane, tid)));
#if CONVIN_I8
    RUN(2, PH_GEMM8(EpiConvInT<true>, true, Hb, (const bf16*)(ws + WS_WCIN), M, 3072, D, (bf16*)(ws + WS_V), (bf16*)(ws + WS_BG)));
#else
    RUN(2, PH_GEMM(EpiConvIn, 0, Hb, (const bf16*)(ws + WS_WCIN), M, 3072, D, (bf16*)(ws + WS_V), (bf16*)(ws + WS_BG)));
#endif
#ifdef PROBE_NULLGEMM_K
    if (IN(2)) { xcd_barrier(bar); PH_GEMM(EpiNull, 0, Hb, (const bf16*)(ws + WS_WCIN), M, PROBE_NULLGEMM_N, PROBE_NULLGEMM_K); xcd_barrier(bar); }
#endif
    RUN(3, { conv_phase(args, G, tid); bias_gemv(args, gw, NGW, lane); });
#define XRp ((bf16*)(ws + WS_XR))
#define XB4p ((bf16*)args.out)
#if WOUT_FP8
    RUN(4, PH_GEMM8(EpiResidB<false COMMA true COMMA (DENSE_GU_FP8 != 0)>, false, Hb, (const bf16*)(ws + WS_WCOUT), M, D, D, XRp, XRp, MF + 0 * 4 * 3072 + 2048, XB4p, SSb, MF + 1 * 4 * 3072 + 1024, args.norm_g + 1 * D, (LAS float*)(lds + RED_OFF), 1.0f / (F8_SH * F8_SW)));
#else
    RUN(4, PH_GEMM(EpiResidB<false COMMA true COMMA (DENSE_GU_FP8 != 0)>, 0, Hb, (const bf16*)(ws + WS_WCOUT), M, D, D, XRp, XRp, MF + 0 * 4 * 3072 + 2048, XB4p, SSb, MF + 1 * 4 * 3072 + 1024, args.norm_g + 1 * D, (LAS float*)(lds + RED_OFF), 1.0f));
#endif
#if DENSE_GU_FP8
    RUN(5, PH_GEMM8(EpiSwiGLU<true COMMA true COMMA (DENSE_DOWN_FP8 != 0)>, (GU_I8 != 0), XB4p, (const bf16*)(ws + WS_WFGU), M, 2 * FF, D, (bf16*)(ws + WS_HID), 2 * FF / 256, SSb, BV, lds + GATE_OFF));
#else
    RUN(5, PH_GEMM(EpiSwiGLU<true COMMA false COMMA (DENSE_DOWN_FP8 != 0)>, 0, XB4p, (const bf16*)(ws + WS_WFGU), M, 2 * FF, D, (bf16*)(ws + WS_HID), 2 * FF / 256, SSb, BV, lds + GATE_OFF));
#endif
#if DENSE_DOWN_FP8
    RUN(6, PH_GEMM8(EpiResidB<false COMMA true COMMA (QKV_I8 != 0)>, false, (const bf16*)(ws + WS_HID), (const bf16*)(ws + WS_WFD), M, D, FF, XRp, XRp, MF + 1 * 4 * 3072 + 2048, Hb, SSb, MF + 2 * 4 * 3072 + 1024, args.norm_g + 2 * D, (LAS float*)(lds + RED_OFF), 1.0f / (F8_SH * F8_SW)));
#else
    RUN(6, PH_GEMM(EpiResidB<false COMMA true>, 0, (const bf16*)(ws + WS_HID), (const bf16*)(ws + WS_WFD), M, D, FF, XRp, XRp, MF + 1 * 4 * 3072 + 2048, Hb, SSb, MF + 2 * 4 * 3072 + 1024, args.norm_g + 2 * D, (LAS float*)(lds + RED_OFF), 1.0f));
#endif
#if QKV_I8
    RUN(7, PH_GEMM8(EpiQkvRopeT<true>, true, Hb, (const bf16*)(ws + WS_WQKV), M, QKVP, D, (bf16*)(ws + WS_QKV), (const unsigned*)(ws + WS_ROPE), SSb, BV + 4 * 2 * FF, lds + GATE_OFF));
#else
    RUN(7, PH_GEMM(EpiQkvRope, 0, Hb, (const bf16*)(ws + WS_WQKV), M, QKVP, D, (bf16*)(ws + WS_QKV), (const unsigned*)(ws + WS_ROPE), SSb, BV + 4 * 2 * FF, lds + GATE_OFF));
#endif
#if ATTN_ONE_PASS
    RUN(8, attn_one(args, lds, gw, NGW, wave, lane));
    RUN(9, attn_fix(args, G, wave, lane));
#else
    RUN(8, attn_mfma<0>(args, lds, gw, NGW, wave, lane));
    RUN(9, attn_mfma<1>(args, lds, gw, NGW, wave, lane));
#endif
#if WO_FP8
    RUN(10, PH_GEMM8(EpiResidB<false COMMA false>, false, Hb, (const bf16*)(ws + WS_WO), M, D, D, XRp, XRp, MF + 2 * 4 * 3072 + 2048, nullptr, nullptr, nullptr, nullptr, nullptr, 1.0f / (F8_SO * F8_SW)));
#else
    RUN(10, PH_GEMM(EpiResidB<false COMMA false>, 0, Hb, (const bf16*)(ws + WS_WO), M, D, D, XRp, XRp, MF + 2 * 4 * 3072 + 2048, nullptr, nullptr, nullptr, nullptr, nullptr, 1.0f));
#endif
    RUN(11, (norm_phase<false, true, true>(args, XRp, 3, lds, G, wave, lane, tid)));
    RUN(12, MOE_GU());
    RUN(13, MOE_DN());
    RUN(14, final_norm_phase(args, gw, NGW, lane));
#ifdef PROBE_XBAR
    for (int q = 0; q < PROBE_XBAR; ++q) xcd_barrier(bar);
#endif
#undef IN
#undef SEAM
}

extern "C" void kernel_launch(void* const* d_in, const int* in_sizes, int n_in, void* d_out, int out_size, void* d_ws, size_t ws_size, hipStream_t stream) {
    static int grid = 0;
    if (grid == 0) {
        if (n_in != 19 || out_size != M * D || ws_size < WS_END) { fprintf(stderr, "kernel_launch: unexpected shapes (n_in %d out %d ws %zu)\n", n_in, out_size, ws_size); grid = -1; return; }
        int dev = 0, cus = 0, per_cu = 0;
        if (hipGetDevice(&dev) != hipSuccess || hipDeviceGetAttribute(&cus, hipDeviceAttributeMultiprocessorCount, dev) != hipSuccess) { grid = -1; return; }
        if (hipFuncSetAttribute((const void*)trunk_fwd, hipFuncAttributeMaxDynamicSharedMemorySize, LDS_BYTES) != hipSuccess) { fprintf(stderr, "kernel_launch: hipFuncSetAttribute failed\n"); grid = -1; return; }
        if (hipOccupancyMaxActiveBlocksPerMultiprocessor(&per_cu, (const void*)trunk_fwd, NTHR, LDS_BYTES) != hipSuccess || per_cu < 1) fprintf(stderr, "kernel_launch: occupancy query reports %d\n", per_cu);
        (void)hipGetLastError();
        grid = cus;
    }
    if (grid < 0) return;
    (void)hipMemsetAsync((char*)d_ws + WS_CTL, 0, CTL_ZERO_BYTES, stream);
    Args a{};
    a.x = (const float*)d_in[0]; a.c = (const float*)d_in[1]; a.pos = (const int*)d_in[2]; a.mod_w = (const float*)d_in[3]; a.mod_b = (const float*)d_in[4]; a.norm_g = (const float*)d_in[5];
    a.conv_w_in = (const float*)d_in[6]; a.conv_w = (const float*)d_in[7]; a.conv_w_out = (const float*)d_in[8]; a.ffn_g = (const float*)d_in[9]; a.ffn_u = (const float*)d_in[10]; a.ffn_d = (const float*)d_in[11];
    a.w_qkv = (const float*)d_in[12]; a.w_o = (const float*)d_in[13]; a.router_w = (const float*)d_in[14]; a.moe_g = (const float*)d_in[15]; a.moe_u = (const float*)d_in[16]; a.moe_d = (const float*)d_in[17]; a.final_g = (const float*)d_in[18];
    a.out = (float*)d_out; a.ws = (unsigned char*)d_ws;
#if MK_PER_PHASE
    for (int p = 0; p < NPHASE; ++p) { a.ph_lo = p; a.ph_hi = p + 1; hipLaunchKernelGGL(trunk_fwd, dim3(grid), dim3(NTHR), LDS_BYTES, stream, a); }
#else
    a.ph_lo = 0; a.ph_hi = NPHASE; hipLaunchKernelGGL(trunk_fwd, dim3(grid), dim3(NTHR), LDS_BYTES, stream, a);
#endif
}
```

```cpp
#include <hip/hip_runtime.h>
#include <cstdio>
#include <cstdint>

#ifndef DENSE_GU_FP8
#define DENSE_GU_FP8 1
#endif
#ifndef ATTN_ONE_PASS
#define ATTN_ONE_PASS 1
#endif
#ifndef MOE_I8
#define MOE_I8 0
#endif
#ifndef GU_I8
#define GU_I8 1
#endif
#ifndef CONVIN_I8
#define CONVIN_I8 0
#endif
#ifndef QKV_I8
#define QKV_I8 1
#endif
#ifndef WO_FP8
#define WO_FP8 1
#endif
#ifndef WOUT_FP8
#define WOUT_FP8 0
#endif
#ifndef DENSE_DOWN_FP8
#define DENSE_DOWN_FP8 1
#endif
#ifndef MK_PER_PHASE
#define MK_PER_PHASE 0
#endif

namespace pg8 {
#define PG8_LAS __attribute__((address_space(3)))
typedef unsigned short bf16_t;
typedef short bf16x8 __attribute__((ext_vector_type(8)));
typedef float f32x4 __attribute__((ext_vector_type(4)));
typedef unsigned u32x4 __attribute__((ext_vector_type(4)));
constexpr int BM = 256, BK = 64, HALF = 128, HTB = HALF * BK * 2, STAGE_BYTES = 8 * HTB, NXCD = 8, WGM = 8;

__host__ __device__ __forceinline__ int lds_byte(int r, int c) { const int st = (r >> 4) * 2 + (c >> 5), rr = r & 15, cc = c & 31, ob = rr * 64 + cc * 2; return st * 1024 + (ob ^ (((ob >> 9) & 1) << 5)); }
__host__ __device__ __forceinline__ void stage_rc(int b, int& R, int& C) { const int st = b / 1024, sb = b % 1024, swz = sb ^ (((sb >> 9) & 1) << 5); R = (st >> 1) * 16 + swz / 64; C = (st & 1) * 32 + (swz % 64) / 2; }
__host__ __device__ __forceinline__ int perm32(int rho) { const int n = rho >> 4, i = rho & 15; return 8 * (i >> 2) + 4 * n + (i & 3); }

struct Unit { int pm, pn, k, nv, g, sp; };
struct Gemm { const bf16_t* A; const bf16_t* Bt; int M, N, K; };

struct StaticOrder {
    static constexpr bool IDROWS = true;
    int nM, nN, nwg, G, c; const int* ident;
    __host__ __device__ void init(int M, int N, int G_, int c_, const int* id = nullptr) { nM = M / BM; nN = N / BM; nwg = nM * nN; G = G_; c = c_; ident = id; }
    __host__ __device__ bool next(int i, Unit& u) const {
        const long L = (long)i * G + c; if (L >= nwg) return false;
        int wgid = (int)L; { const int q = nwg / NXCD, r = nwg % NXCD, xcd = wgid % NXCD, off = wgid / NXCD; wgid = (xcd < r ? xcd * (q + 1) : r * (q + 1) + (xcd - r) * q) + off; }
        const int nig = WGM * nN, gid = wgid / nig, fm = gid * WGM, gsz = (nM - fm) < WGM ? (nM - fm) : WGM;
        u.pm = fm + ((wgid % nig) % gsz); u.pn = (wgid % nig) / gsz; u.nv = 256; return true;
    }
    __device__ __forceinline__ const int* tokens(const Unit& u) const { return ident + 256 * u.pm; }
    __device__ __forceinline__ void a_ready(const Unit&) const {}
    __device__ __forceinline__ void done(const Unit&) const {}
};
struct RepeatOrder : StaticOrder { int nrep;
    __host__ __device__ bool next(int i, Unit& u) const { if (i >= nrep) return false; return StaticOrder::next(0, u); } };
template <bool IDENT> struct MoeOrderT {
    static constexpr bool IDROWS = IDENT;
    int nM, nN, nwg, G, c; int nt[16]; const int* rowtok; bool ident;
    static constexpr int MTOK = 32768;
    __device__ __forceinline__ void init(unsigned* cnt, int nN_, int G_, int c_, const int* rt, bool ident_ = false) {
        ident = ident_;
        int b = 0;
#pragma unroll
        for (int q = 0; q < 16; ++q) { const int ne = __builtin_amdgcn_readfirstlane((int)__hip_atomic_load(cnt + q, __ATOMIC_RELAXED, __HIP_MEMORY_SCOPE_AGENT)); nt[q] = ne | (b << 16); b += (ne + 255) >> 8; }
        nM = b; nN = nN_; nwg = nM * nN; G = G_; c = c_; rowtok = rt;
    }
    __device__ __forceinline__ bool next(int i, Unit& u) const {
        const long L = (long)i * G + c; if (L >= nwg) return false;
        int wgid = (int)L; { const int q = nwg / NXCD, r = nwg % NXCD, xcd = wgid % NXCD, off = wgid / NXCD; wgid = (xcd < r ? xcd * (q + 1) : r * (q + 1) + (xcd - r) * q) + off; }
        const int nig = WGM * nN, gid = wgid / nig, fm = gid * WGM, gsz = (nM - fm) < WGM ? (nM - fm) : WGM;
        const int pm = fm + ((wgid % nig) % gsz), pn = (wgid % nig) / gsz;
        int q0 = 0, sel = nt[0];
#pragma unroll
        for (int q = 1; q < 16; ++q) if (pm >= (nt[q] >> 16)) { q0 = q; sel = nt[q]; }
        u.pm = pm; u.pn = (q0 & 7) * nN + pn; u.g = q0; u.k = pm - (sel >> 16); const int rem = (sel & 0xffff) - 256 * u.k; u.nv = rem < 256 ? rem : 256; return true;
    }
    __device__ __forceinline__ const int* tokens(const Unit& u) const { return ident ? rowtok + 256 * u.pm : rowtok + (size_t)u.g * MTOK + 256 * u.k; }
    __device__ __forceinline__ void a_ready(const Unit&) const {}
    __device__ __forceinline__ void done(const Unit&) const {}
};
typedef MoeOrderT<false> MoeOrder; typedef MoeOrderT<true> MoeOrderId;

typedef int v8i_t __attribute__((ext_vector_type(8)));
typedef int v4i_t __attribute__((ext_vector_type(4)));
__device__ __forceinline__ v8i_t cat8(bf16x8 a, bf16x8 b) { const v4i_t x = __builtin_bit_cast(v4i_t, a), y = __builtin_bit_cast(v4i_t, b); return __builtin_shufflevector(x, y, 0, 1, 2, 3, 4, 5, 6, 7); }
__device__ __forceinline__ unsigned cvt_pk_bf16(float lo, float hi) { unsigned r; asm volatile("v_cvt_pk_bf16_f32 %0, %1, %2" : "=v"(r) : "v"(lo), "v"(hi)); return r; }

template <class Epi, class Sched, bool ALIGN_EPI = false, bool SP2 = false, bool GATHER = false, int ES = 2, bool I8 = false>
__device__ __forceinline__ void gemm_phase(PG8_LAS unsigned char* lds, const Gemm g, const Sched& S, const Epi& E, PG8_LAS unsigned char* tokslots = nullptr) {
    const int tid = threadIdx.x, wid = __builtin_amdgcn_readfirstlane(tid >> 6), lane = tid & 63, wr = wid >> 2, wc = wid & 3, fr = lane & 15, fq = lane >> 4;
    const int K = g.K, KB = K * ES  , nt = KB / (BK * 2);
    static_assert(!GATHER || SP2, "the gathering A path is written for the SP2 loop only");
    unsigned voffA[2], voffB[2];
#pragma unroll
    for (int i = 0; i < 2; ++i) { int R, C; stage_rc(tid * 16 + i * 8192, R, C); const int Rb = Epi::PERM ? ((R & ~31) + perm32(R & 31)) : R;
        voffA[i] = (unsigned)(R * KB + C * 2); voffB[i] = (unsigned)(Rb * KB + C * 2); }
    unsigned gcur[2][2] = {{0u, 0u}, {0u, 0u}};
    const size_t kstep = (size_t)(BK * 2);
    const size_t hstep = (size_t)HALF * KB;
    const size_t tstep = 2 * hstep;
    const unsigned ldsw = (unsigned)wid * 1024u;
    const int aoff = lds_byte(wr * 64 + fr, fq * 8), boff = lds_byte(wc * 32 + fr, fq * 8);
#define PG8_SA(b, h) (((b) * 2 + (h)) * HTB)
#define PG8_SB(b, h) ((4 + (b) * 2 + (h)) * HTB)
#define PG8_STAGE(bufoff, gbase, voff) do { _Pragma("unroll") for (int _i = 0; _i < 2; ++_i) \
        __builtin_amdgcn_global_load_lds((const unsigned*)((const char*)(gbase) + (voff)[_i]), (PG8_LAS unsigned*)(lds + (bufoff) + ldsw + _i * 8192), 16, 0, 0); } while (0)
#define PG8_STAGE_A(bufoff, kptr, half, ofs) do { if constexpr (GATHER) { _Pragma("unroll") for (int _i = 0; _i < 2; ++_i) \
        __builtin_amdgcn_global_load_lds((const unsigned*)((const char*)(kptr) + (ofs)[half][_i]), (PG8_LAS unsigned*)(lds + (bufoff) + ldsw + _i * 8192), 16, 0, 0); } \
        else { PG8_STAGE(bufoff, (const char*)(kptr) + (half) * hstep, voffA); } } while (0)
#define PG8_LDA(dst, b, h) do { _Pragma("unroll") for (int m = 0; m < 4; ++m) _Pragma("unroll") for (int k = 0; k < 2; ++k) dst[m][k] = *(const PG8_LAS bf16x8*)(lds + PG8_SA(b, h) + aoff + m * 2048 + k * 1024); } while (0)
#define PG8_LDB(dst, b, h) do { _Pragma("unroll") for (int n = 0; n < 2; ++n) _Pragma("unroll") for (int k = 0; k < 2; ++k) dst[n][k] = *(const PG8_LAS bf16x8*)(lds + PG8_SB(b, h) + boff + n * 2048 + k * 1024); } while (0)
#define PG8_MMA(ai, bj, At, Bt) do { __builtin_amdgcn_s_setprio(1); _Pragma("unroll") for (int m = 0; m < 4; ++m) _Pragma("unroll") for (int n = 0; n < 2; ++n) { \
        if constexpr (ES == 2) { _Pragma("unroll") for (int k = 0; k < 2; ++k) acc[ai][bj][m][n] = __builtin_amdgcn_mfma_f32_16x16x32_bf16(Bt[n][k], At[m][k], acc[ai][bj][m][n], 0, 0, 0); } \
        else if constexpr (I8) { _Pragma("unroll") for (int k = 0; k < 2; ++k) acc[ai][bj][m][n] = __builtin_bit_cast(f32x4, __builtin_amdgcn_mfma_i32_16x16x64_i8(__builtin_bit_cast(v4i_t, Bt[n][k]), __builtin_bit_cast(v4i_t, At[m][k]), __builtin_bit_cast(v4i_t, acc[ai][bj][m][n]), 0, 0, 0)); } \
        else { acc[ai][bj][m][n] = __builtin_amdgcn_mfma_scale_f32_16x16x128_f8f6f4(cat8(Bt[n][0], Bt[n][1]), cat8(At[m][0], At[m][1]), acc[ai][bj][m][n], 0, 0, 0, 0x7f7f7f7f, 0, 0x7f7f7f7f); } } \
        __builtin_amdgcn_s_setprio(0); } while (0)
#define PG8_WAIT_V(n) asm volatile("s_waitcnt vmcnt(" #n ")" ::: "memory")
#define PG8_WAIT_L(n) asm volatile("s_waitcnt lgkmcnt(" #n ")" ::: "memory")
#define PG8_BAR __builtin_amdgcn_s_barrier()
#define PG8_SCHED __builtin_amdgcn_sched_barrier(0)
    Unit cur, nxt; int ui = 0;
    if (!S.next(0, cur)) return;
    f32x4 acc[2][2][4][2];
#pragma unroll
    for (int a = 0; a < 2; ++a)
#pragma unroll
        for (int b = 0; b < 2; ++b)
#pragma unroll
            for (int m = 0; m < 4; ++m)
#pragma unroll
                for (int n = 0; n < 2; ++n) acc[a][b][m][n] = (f32x4){0.f, 0.f, 0.f, 0.f};
    bf16x8 At[4][2], B0[2][2], B1[2][2];
    const char* cA = GATHER ? (const char*)g.A : (const char*)g.A + (size_t)cur.pm * tstep; const char* cB = (const char*)g.Bt + (size_t)cur.pn * tstep;
    if constexpr (GATHER) { const int* tk = S.tokens(cur);
#pragma unroll
        for (int h = 0; h < 2; ++h)
#pragma unroll
            for (int i = 0; i < 2; ++i) { int R, C; stage_rc(tid * 16 + i * 8192, R, C); const int rl = h * HALF + R; int tok;
                if constexpr (Sched::IDROWS) tok = rl < cur.nv ? 256 * cur.pm + rl : 0; else tok = rl < cur.nv ? tk[rl] : 0;
                gcur[h][i] = (unsigned)tok * (unsigned)KB + (unsigned)C * 2u; } }
    S.a_ready(cur);
    if constexpr (SP2) {
        PG8_STAGE(PG8_SB(0, 0), cB, voffB); PG8_STAGE(PG8_SB(0, 1), cB + hstep, voffB); PG8_STAGE_A(PG8_SA(0, 0), cA, 0, gcur); PG8_STAGE_A(PG8_SA(0, 1), cA, 1, gcur);
        PG8_STAGE(PG8_SB(1, 0), cB + kstep, voffB); PG8_STAGE_A(PG8_SA(1, 0), cA + kstep, 0, gcur); PG8_STAGE(PG8_SB(1, 1), cB + hstep + kstep, voffB);
        if (wr == 1) PG8_BAR;
        PG8_WAIT_V(8); PG8_BAR;
        PG8_WAIT_V(6); PG8_BAR;
    } else {
        PG8_STAGE(PG8_SB(0, 0), cB, voffB); PG8_STAGE_A(PG8_SA(0, 0), cA, 0, gcur); PG8_STAGE(PG8_SB(0, 1), cB + hstep, voffB); PG8_STAGE_A(PG8_SA(0, 1), cA, 1, gcur);
        if (wr == 1) PG8_BAR;
        PG8_WAIT_V(4); PG8_BAR;
        PG8_STAGE(PG8_SB(1, 0), cB + kstep, voffB); PG8_STAGE_A(PG8_SA(1, 0), cA + kstep, 0, gcur); PG8_STAGE(PG8_SB(1, 1), cB + hstep + kstep, voffB);
        PG8_WAIT_V(6); PG8_BAR;
    }
    for (;;) {
        cur.sp = ui & 1;
        if constexpr (Epi::SIDE) E.side_issue(cur, wid, lane);
        const bool has_next = S.next(ui + 1, nxt);
        const char* nA = GATHER ? cA : (has_next ? (const char*)g.A + (size_t)nxt.pm * tstep : cA); const char* nB = has_next ? (const char*)g.Bt + (size_t)nxt.pn * tstep : cB;
        if constexpr (GATHER && !Sched::IDROWS) { if (has_next && wid < 4)
            __builtin_amdgcn_global_load_lds((const unsigned*)(S.tokens(nxt) + wid * 64 + lane), (PG8_LAS unsigned*)(tokslots + ((ui + 1) & 1) * 1024 + wid * 256), 4, 0, 0); }
#pragma unroll 1
        for (int t = 0; t < nt; t += 2) {
            const bool last = (t == nt - 2);
            const char* a1 = cA + (size_t)(t + 1) * kstep;
            const char* a2 = last ? nA : cA + (size_t)(t + 2) * kstep; const char* b2 = last ? nB : cB + (size_t)(t + 2) * kstep;
            const char* a3 = a2 + kstep; const char* b3 = b2 + kstep;
            if (last && has_next) S.a_ready(nxt);
            if constexpr (SP2) {
            PG8_LDB(B0, 0, 0); PG8_LDB(B1, 0, 1); PG8_SCHED; PG8_LDA(At, 0, 0); PG8_STAGE_A(PG8_SA(1, 1), a1, 1, gcur);
            if constexpr (GATHER) { if (last && has_next) {
#pragma unroll
                for (int h = 0; h < 2; ++h)
#pragma unroll
                    for (int i = 0; i < 2; ++i) { int R, C; stage_rc(tid * 16 + i * 8192, R, C); const int rl = h * HALF + R; int tok; if constexpr (Sched::IDROWS) tok = 256 * nxt.pm + rl; else tok = *(const PG8_LAS int*)(tokslots + ((ui + 1) & 1) * 1024 + rl * 4);
                        gcur[h][i] = (unsigned)(rl < nxt.nv ? tok : 0) * (unsigned)KB + (unsigned)C * 2u; } } }
            PG8_WAIT_V(8); PG8_WAIT_L(0); PG8_BAR; PG8_MMA(0, 0, At, B0); PG8_MMA(0, 1, At, B1); PG8_BAR; PG8_SCHED;
            PG8_LDA(At, 0, 1); PG8_STAGE(PG8_SB(0, 0), b2, voffB); PG8_STAGE(PG8_SB(0, 1), b2 + hstep, voffB); PG8_STAGE_A(PG8_SA(0, 0), a2, 0, gcur);
            PG8_WAIT_V(8); PG8_WAIT_L(0); PG8_BAR; PG8_MMA(1, 0, At, B0); PG8_MMA(1, 1, At, B1); PG8_BAR; PG8_SCHED;
            PG8_LDB(B0, 1, 0); PG8_LDB(B1, 1, 1); PG8_SCHED; PG8_LDA(At, 1, 0); PG8_STAGE_A(PG8_SA(0, 1), a2, 1, gcur);
            PG8_WAIT_V(8); PG8_WAIT_L(0); PG8_BAR; PG8_MMA(0, 0, At, B0); PG8_MMA(0, 1, At, B1); PG8_BAR; PG8_SCHED;
            PG8_LDA(At, 1, 1); PG8_STAGE(PG8_SB(1, 0), b3, voffB); PG8_STAGE(PG8_SB(1, 1), b3 + hstep, voffB); PG8_STAGE_A(PG8_SA(1, 0), a3, 0, gcur);
            PG8_WAIT_V(8); PG8_WAIT_L(0); PG8_BAR; PG8_MMA(1, 0, At, B0); PG8_MMA(1, 1, At, B1); PG8_BAR; PG8_SCHED;
            } else {
            PG8_LDB(B0, 0, 0); PG8_SCHED; PG8_LDA(At, 0, 0); PG8_STAGE_A(PG8_SA(1, 1), a1, 1, gcur);
            PG8_WAIT_L(8); PG8_BAR; PG8_WAIT_L(0); PG8_MMA(0, 0, At, B0); PG8_BAR; PG8_SCHED;
            PG8_LDB(B1, 0, 1); PG8_STAGE(PG8_SB(0, 0), b2, voffB);
            PG8_BAR; PG8_WAIT_L(0); PG8_MMA(0, 1, At, B1); PG8_BAR;
            PG8_LDA(At, 0, 1); PG8_STAGE_A(PG8_SA(0, 0), a2, 0, gcur);
            PG8_BAR; PG8_WAIT_L(0); PG8_MMA(1, 0, At, B0); PG8_BAR; PG8_SCHED;
            PG8_STAGE(PG8_SB(0, 1), b2 + hstep, voffB);
            PG8_WAIT_V(6); PG8_BAR; PG8_MMA(1, 1, At, B1); PG8_BAR;
            PG8_LDB(B0, 1, 0); PG8_SCHED; PG8_LDA(At, 1, 0); PG8_STAGE_A(PG8_SA(0, 1), a2, 1, gcur);
            PG8_WAIT_L(8); PG8_BAR; PG8_WAIT_L(0); PG8_MMA(0, 0, At, B0); PG8_BAR; PG8_SCHED;
            PG8_LDB(B1, 1, 1); PG8_STAGE(PG8_SB(1, 0), b3, voffB);
            PG8_BAR; PG8_WAIT_L(0); PG8_MMA(0, 1, At, B1); PG8_BAR;
            PG8_LDA(At, 1, 1); PG8_STAGE_A(PG8_SA(1, 0), a3, 0, gcur);
            PG8_BAR; PG8_WAIT_L(0); PG8_MMA(1, 0, At, B0); PG8_BAR; PG8_SCHED;
            PG8_STAGE(PG8_SB(1, 1), b3 + hstep, voffB);
            PG8_WAIT_V(6); PG8_BAR; PG8_MMA(1, 1, At, B1); PG8_BAR;
            }
        }
        if constexpr (ALIGN_EPI) { if (wr == 0) PG8_BAR; }
        E(acc, cur, wr, wc, fr, fq); S.done(cur);
        if (!has_next) break;
#pragma unroll
        for (int a = 0; a < 2; ++a)
#pragma unroll
            for (int b = 0; b < 2; ++b)
#pragma unroll
                for (int m = 0; m < 4; ++m)
#pragma unroll
                    for (int n = 0; n < 2; ++n) acc[a][b][m][n] = (f32x4){0.f, 0.f, 0.f, 0.f};
        cur = nxt; cA = nA; cB = nB; ++ui;

        if constexpr (ALIGN_EPI) { if (wr == 1) PG8_BAR; }
    }
    PG8_WAIT_V(0);
    if constexpr (!ALIGN_EPI) { if (wr == 0) PG8_BAR; }
    PG8_BAR;
#undef PG8_SA
#undef PG8_SB
#undef PG8_STAGE
#undef PG8_STAGE_A
#undef PG8_LDA
#undef PG8_LDB
#undef PG8_MMA
#undef PG8_WAIT_V
#undef PG8_WAIT_L
#undef PG8_BAR
#undef PG8_SCHED
}
}

constexpr int NWAVES = 8, NTHR = NWAVES * 64;
constexpr int NB = 4, SEQ = 8192, D = 1024, M = NB * SEQ;
constexpr int FF = 2816, NE = 8;
constexpr int NH = 15, NHQKV = 45, QKVP = 3072;
constexpr int RPAD = M + NE * 256;
constexpr int NCHUNK = M / 128;
constexpr float RMS_EPS = 1e-6f;
constexpr float I8_SA = 127.f / 8.f, I8_SW = 127.f * 32.f / 5.f;
constexpr float GU_SA = GU_I8 ? I8_SA : 16.f, GU_SW = GU_I8 ? I8_SW : 128.f;
constexpr float MOE_SA = MOE_I8 ? I8_SA : 16.f, MOE_SW = MOE_I8 ? I8_SW : 128.f;
constexpr float F8_SO = 32.f;
constexpr float F8_SA = 16.f, F8_SW = 128.f, F8_SH = 8.f;
constexpr float C2 = 0.125f * 1.4426950408889634f;

constexpr size_t MiB = 1u << 20;
constexpr size_t WS_CTL = 0, CTL_ZERO_BYTES = 64 * 1024;
constexpr size_t WS_MODP = 1 * MiB;
constexpr size_t WS_MODF = 3 * MiB;
constexpr size_t WS_IDENT = 4 * MiB + 512 * 1024;
constexpr size_t WS_ZG = WS_MODF + 256 * 1024;
constexpr size_t WS_SS = 4 * MiB;
constexpr size_t WS_BIASV = 5 * MiB;
constexpr size_t WS_XR = 448 * MiB;
constexpr size_t WS_ROPE = 6 * MiB;
constexpr size_t WS_LSE = 14 * MiB;
constexpr size_t WS_WCIN = 16 * MiB, WS_WCOUT = 22 * MiB, WS_WFGU = 24 * MiB, WS_WFD = 35 * MiB, WS_WQKV = 41 * MiB, WS_WO = 47 * MiB, WS_WMGU = 49 * MiB, WS_WMD = 137 * MiB;
constexpr size_t WS_H = 181 * MiB;
constexpr size_t WS_BIG = 245 * MiB;
constexpr size_t WS_BG = WS_BIG, WS_V = WS_BIG + 64 * MiB;
constexpr size_t WS_HID = WS_BIG;
constexpr size_t WS_QKV = WS_BIG;
constexpr size_t WS_RT2 = 10 * MiB, WS_RW2 = 12 * MiB;
constexpr size_t WS_MHID = WS_BIG;
constexpr size_t WS_Y1 = WS_H;
constexpr size_t WS_END = 512 * MiB;
static_assert(WS_MHID + (size_t)2 * RPAD * FF <= WS_XR && WS_QKV + (size_t)M * QKVP * 2 <= WS_XR && WS_HID + (size_t)M * FF * 2 <= WS_XR && WS_XR + (size_t)M * D * 2 <= WS_END, "d_ws map");
static_assert(WS_WMD + (size_t)NE * D * FF * 2 <= WS_H && WS_H + (size_t)M * D * 2 <= WS_BIG, "d_ws map 2");
constexpr int CW_XMAP = 8320;
constexpr int CW_CNT = 8192;
constexpr int CW_BAR = 4096;

constexpr int RING_BYTES = 131072;
constexpr int LDSCTL_OFF = RING_BYTES, MISC_OFF = LDSCTL_OFF + 320;
constexpr int RED_OFF = LDSCTL_OFF + 4096;
constexpr int TOKSLOT_OFF = LDSCTL_OFF + 1024;
constexpr int GATE_OFF = LDSCTL_OFF + 8192;
constexpr int LDS_BYTES = 155648;

#define GAS __attribute__((address_space(1)))
#define LAS __attribute__((address_space(3)))
typedef unsigned short bf16;
typedef unsigned v4u __attribute__((ext_vector_type(4)));
typedef unsigned v2u __attribute__((ext_vector_type(2)));
typedef float f32x4 __attribute__((ext_vector_type(4)));
#define LDS_WAIT() asm volatile("s_waitcnt lgkmcnt(0)" ::: "memory")
__device__ __forceinline__ unsigned f2bf(float f) { unsigned u = __builtin_bit_cast(unsigned, f); return (u + 0x7fffu + ((u >> 16) & 1u)) >> 16; }
__device__ __forceinline__ unsigned pk2(float lo, float hi) { return f2bf(lo) | (f2bf(hi) << 16); }
__device__ __forceinline__ float bflo(unsigned u) { return __builtin_bit_cast(float, u << 16); }
__device__ __forceinline__ float bfhi(unsigned u) { return __builtin_bit_cast(float, u & 0xffff0000u); }

__device__ __forceinline__ unsigned pk_fp8x4(f32x4 v) {
    const float a = __builtin_amdgcn_fmed3f(v.x, -448.f, 448.f), b = __builtin_amdgcn_fmed3f(v.y, -448.f, 448.f), c = __builtin_amdgcn_fmed3f(v.z, -448.f, 448.f), d = __builtin_amdgcn_fmed3f(v.w, -448.f, 448.f);
    int p = __builtin_amdgcn_cvt_pk_fp8_f32(a, b, 0, false); p = __builtin_amdgcn_cvt_pk_fp8_f32(c, d, p, true); return (unsigned)p; }
__device__ __forceinline__ unsigned pk_i8x4(f32x4 v) {
    const float mg = 12582912.0f;
    const unsigned a = __builtin_bit_cast(unsigned, __builtin_amdgcn_fmed3f(v.x, -127.f, 127.f) + mg), b = __builtin_bit_cast(unsigned, __builtin_amdgcn_fmed3f(v.y, -127.f, 127.f) + mg);
    const unsigned c = __builtin_bit_cast(unsigned, __builtin_amdgcn_fmed3f(v.z, -127.f, 127.f) + mg), d = __builtin_bit_cast(unsigned, __builtin_amdgcn_fmed3f(v.w, -127.f, 127.f) + mg);
    return __builtin_amdgcn_perm(__builtin_amdgcn_perm(d, c, 0x0c0c0400u), __builtin_amdgcn_perm(b, a, 0x0c0c0400u), 0x05040100u); }
__device__ __forceinline__ unsigned pk_q8x4(f32x4 v) { return GU_I8 ? pk_i8x4(v) : pk_fp8x4(v); }
#define XB_TMO      128
#define XB_XCNT(j)  (256  + 64 * (j))
#define XB_XSUB(j)  (1280 + 64 * (j))
#define XB_XGEN(j)  (2304 + 64 * (j))
#define XB_TOP      3328
#define XB_TOPGEN   3392
#define XCD_BAR_WORDS 3456
#define XB_SPIN_CAP (1u << 18)
__device__ __forceinline__ unsigned xb_ld(unsigned* p)              { return __hip_atomic_load(p, __ATOMIC_RELAXED, __HIP_MEMORY_SCOPE_AGENT); }
__device__ __forceinline__ unsigned xb_add(unsigned* p, unsigned v) { return __hip_atomic_fetch_add(p, v, __ATOMIC_RELAXED, __HIP_MEMORY_SCOPE_AGENT); }
__device__ __forceinline__ unsigned xb_xcc_id() { return (unsigned)__builtin_amdgcn_s_getreg((3 << 11) | 20) & 0xFu; }
#define XB_SPIN(cond, bar) do { unsigned _sp = 0; while (cond) { __builtin_amdgcn_s_sleep(1); \
    if ((++_sp & 255u) == 0u) { if (xb_ld(&(bar)[XB_TMO])) break; if (_sp > XB_SPIN_CAP) { atomicAdd(&(bar)[XB_TMO], 1u); break; } } } } while (0)
struct XcdBarrier { unsigned* bar; unsigned x; volatile LAS unsigned* st; };
__device__ __forceinline__ XcdBarrier xcd_barrier_post(unsigned* bar, volatile LAS unsigned* st) {
    XcdBarrier b; b.bar = bar; b.x = xb_xcc_id(); b.st = st;
    if (threadIdx.x == 0) (void)xb_add(&bar[XB_XCNT(b.x)], 1u);
    return b;
}
__device__ __forceinline__ void xcd_barrier_complete(unsigned* bar, unsigned x, unsigned& nloc, unsigned& nx) {
    const unsigned G = gridDim.x * gridDim.y * gridDim.z;
    unsigned sum, cnt, mine, sp = 0u;
    for (;;) {
        sum = 0u; cnt = 0u; mine = 0u;
#pragma unroll
        for (unsigned j = 0; j < 16; ++j) { const unsigned c = xb_ld(&bar[XB_XCNT(j)]); sum += c; cnt += (c > 0u) ? 1u : 0u; mine = (j == x) ? c : mine; }
        if (sum == G) break;
        __builtin_amdgcn_s_sleep(1);
        if ((++sp & 255u) == 0u) { if (xb_ld(&bar[XB_TMO])) break; if (sp > XB_SPIN_CAP) { atomicAdd(&bar[XB_TMO], 1u); break; } }
    }
    nloc = mine > 0u ? mine : 1u; nx = cnt > 0u ? cnt : 1u;
}
__device__ __forceinline__ void xcd_barrier(const XcdBarrier& b) {
    asm volatile("s_waitcnt vmcnt(0)" ::: "memory");
    __syncthreads();
    if (threadIdx.x == 0) {
        unsigned* bar = b.bar;
        __builtin_amdgcn_s_waitcnt(0);
        unsigned nloc = b.st[0], nx = b.st[1];
        if (nloc == 0u) { xcd_barrier_complete(bar, b.x, nloc, nx); b.st[0] = nloc; b.st[1] = nx; }
        const unsigned old = xb_add(&bar[XB_XSUB(b.x)], 1u);
        const unsigned gen = old / nloc;
        if (old + 1u == (gen + 1u) * nloc) {
            __builtin_amdgcn_fence(__ATOMIC_RELEASE, "agent");
            asm volatile("s_waitcnt vmcnt(0)" ::: "memory");
            const unsigned og = xb_add(&bar[XB_TOP], 1u);
            const unsigned tg = og / nx;
            if (og + 1u == (tg + 1u) * nx) xb_add(&bar[XB_TOPGEN], 1u);
            else XB_SPIN(xb_ld(&bar[XB_TOPGEN]) == tg, bar);
            __builtin_amdgcn_fence(__ATOMIC_ACQUIRE, "agent");
            xb_add(&bar[XB_XGEN(b.x)], 1u);
            asm volatile("s_waitcnt vmcnt(0)" ::: "memory");
        } else {
            XB_SPIN(xb_ld(&bar[XB_XGEN(b.x)]) == gen, bar);
            __builtin_amdgcn_fence(__ATOMIC_ACQUIRE, "agent");
            asm volatile("s_waitcnt vmcnt(0)" ::: "memory");
        }
    }
    __syncthreads();
}

#define XB_LSUB(j)  (3456 + 16 * (j))
#define XB_LGEN(j)  (3712 + 16 * (j))
__device__ __forceinline__ void xcd_barrier_local(const XcdBarrier& b) {
    asm volatile("s_waitcnt vmcnt(0)" ::: "memory");
    __syncthreads();
    if (threadIdx.x == 0) {
        unsigned* bar = b.bar;
        __builtin_amdgcn_s_waitcnt(0);
        const unsigned nloc = b.st[0];
        const unsigned old = xb_add(&bar[XB_LSUB(b.x)], 1u);
        const unsigned gen = old / nloc;
        if (old + 1u == (gen + 1u) * nloc) xb_add(&bar[XB_LGEN(b.x)], 1u);
        else XB_SPIN(xb_ld(&bar[XB_LGEN(b.x)]) == gen, bar);
        __builtin_amdgcn_fence(__ATOMIC_ACQUIRE, "agent");
        asm volatile("s_waitcnt vmcnt(0)" ::: "memory");
    }
    __syncthreads();
}

__device__ __forceinline__ float wave_sum(float v) {
#pragma unroll
    for (int o = 1; o < 64; o <<= 1) v += __shfl_xor(v, o);
    return v;
}
__device__ __forceinline__ float wave_max(float v) {
#pragma unroll
    for (int o = 1; o < 64; o <<= 1) v = fmaxf(v, __shfl_xor(v, o));
    return v;
}
__device__ __forceinline__ float silu_f(float v) { return v * __builtin_amdgcn_rcpf(1.0f + __builtin_amdgcn_exp2f(-1.4426950408889634f * v)); }

struct Args {
    const float* x; const float* c; const int* pos; const float* mod_w; const float* mod_b; const float* norm_g;
    const float* conv_w_in; const float* conv_w; const float* conv_w_out; const float* ffn_g; const float* ffn_u; const float* ffn_d;
    const float* w_qkv; const float* w_o; const float* router_w; const float* moe_g; const float* moe_u; const float* moe_d; const float* final_g;
    float* out; unsigned char* ws; int ph_lo, ph_hi;
};

using pg8::Unit; using pg8::HALF; using pg8::BM;
#define PINV(x) asm volatile("" : "+v"(x))
#define ROWSTEP(k) (((k) == 3) ? 80u : 16u)
#ifndef STORE_AUX
#define STORE_AUX 0
#endif
__device__ __forceinline__ __amdgpu_buffer_rsrc_t mk_rsrc(const void* base) { return __builtin_amdgcn_make_buffer_rsrc(const_cast<void*>(base), 0, 0x7fffffff, 0x00020000); }
__device__ __forceinline__ void st16(__amdgpu_buffer_rsrc_t r, unsigned off, v4u v) { __builtin_amdgcn_raw_buffer_store_b128(v, r, (int)off, 0, STORE_AUX); }
__device__ __forceinline__ void st8(__amdgpu_buffer_rsrc_t r, unsigned off, v2u v) { __builtin_amdgcn_raw_buffer_store_b64(v, r, (int)off, 0, STORE_AUX); }
__device__ __forceinline__ void st16f(__amdgpu_buffer_rsrc_t r, unsigned off, f32x4 v) { __builtin_amdgcn_raw_buffer_store_b128(__builtin_bit_cast(v4u, v), r, (int)off, 0, STORE_AUX); }
template <class T> __device__ __forceinline__ T* at_off(T* base, unsigned byteoff) { return (T*)((char*)base + byteoff); }
template <class T> __device__ __forceinline__ const T* at_off(const T* base, unsigned byteoff) { return (const T*)((const char*)base + byteoff); }
__device__ __forceinline__ v4u pack8(const f32x4 a, const f32x4 b) { v4u w; w.x = pg8::cvt_pk_bf16(a[0], a[1]); w.y = pg8::cvt_pk_bf16(a[2], a[3]); w.z = pg8::cvt_pk_bf16(b[0], b[1]); w.w = pg8::cvt_pk_bf16(b[2], b[3]); return w; }
typedef int i32x4 __attribute__((ext_vector_type(4)));
__device__ __forceinline__ f32x4 acc_f32(const f32x4 a, bool i8) { return i8 ? __builtin_convertvector(__builtin_bit_cast(i32x4, a), f32x4) : a; }
template <bool I8> struct EpiConvInT {
    static constexpr bool PERM = true, SIDE = false;
    bf16* V; bf16* Bg;
    __device__ __forceinline__ void operator()(const f32x4 (&acc)[2][2][4][2], const Unit& u, int wr, int wc, int fr, int fq) const {
        PINV(fr); PINV(fq);
        const int row0 = u.pm * BM + wr * 64 + fr; const __amdgpu_buffer_rsrc_t rV = mk_rsrc(V), rB = mk_rsrc(Bg);
        constexpr float ci = I8 ? 1.0f / (GU_SA * GU_SW) : 1.0f;
        if (u.pn < 8) {
            unsigned ro = (unsigned)(row0 * D + u.pn * 128 + wc * 32 + 8 * fq) * 2u;
#pragma unroll
            for (int k = 0; k < 8; ++k) { const int ai = k >> 2, m = k & 3;
                st16(rV, ro, pack8(acc_f32(acc[ai][0][m][0], I8) * acc_f32(acc[ai][1][m][0], I8) * (ci * ci), acc_f32(acc[ai][0][m][1], I8) * acc_f32(acc[ai][1][m][1], I8) * (ci * ci)));
                ro += ROWSTEP(k) * (unsigned)(D * 2); PINV(ro); }
        } else {
            unsigned ro = (unsigned)(row0 * D + (u.pn - 8) * 256 + wc * 32 + 8 * fq) * 2u;
#pragma unroll
            for (int k = 0; k < 8; ++k) { const int ai = k >> 2, m = k & 3;
                st16(rB, ro, pack8(acc_f32(acc[ai][0][m][0], I8) * ci, acc_f32(acc[ai][0][m][1], I8) * ci));
                st16(rB, ro + HALF * 2, pack8(acc_f32(acc[ai][1][m][0], I8) * ci, acc_f32(acc[ai][1][m][1], I8) * ci));
                ro += ROWSTEP(k) * (unsigned)(D * 2); PINV(ro); }
        }
    }
};
typedef EpiConvInT<false> EpiConvIn;
typedef float f32x2 __attribute__((ext_vector_type(2)));
__device__ __forceinline__ f32x2 swiglu2(f32x2 g, f32x2 u, float cg, float cgu) {
    const f32x2 t = g * (-1.4426950408889634f * cg);
    f32x2 e; e.x = __builtin_amdgcn_exp2f(t.x); e.y = __builtin_amdgcn_exp2f(t.y);
    const float k = 1.0f / cgu;
    const f32x2 d = e * k + k;
    f32x2 r; r.x = __builtin_amdgcn_rcpf(d.x); r.y = __builtin_amdgcn_rcpf(d.y);
    return (g * u) * r;
}
__device__ __forceinline__ f32x4 swiglu4(f32x4 g, f32x4 u, float cg, float cgu) {
    const f32x2 a = swiglu2((f32x2){g.x, g.y}, (f32x2){u.x, u.y}, cg, cgu), b = swiglu2((f32x2){g.z, g.w}, (f32x2){u.z, u.w}, cg, cgu); return (f32x4){a.x, a.y, b.x, b.y}; }
__device__ __forceinline__ float rinv_of(const f32x4 s) { return __builtin_amdgcn_rsqf(((s.x + s.y) + (s.z + s.w)) * (1.0f / D) + RMS_EPS); }
constexpr int SIDE_BYTES = 5120;
template <bool NORM, bool F8 = false, bool F8O = F8> struct EpiSwiGLU {
    static constexpr bool PERM = true, SIDE = NORM;
    bf16* Hd; int nN; const float* SS; const float* bias; LAS unsigned char* side;
    __device__ __forceinline__ void side_issue(const Unit& u, int wid, int lane) const {
        LAS unsigned char* sl = side + u.sp * SIDE_BYTES;
        if (wid < 4) __builtin_amdgcn_global_load_lds((const unsigned*)(SS + ((size_t)(u.pm * BM + wid * 64 + lane)) * 4), (LAS unsigned*)(sl + wid * 1024), 16, 0, 0);
        else if (wid == 4) __builtin_amdgcn_global_load_lds((const unsigned*)(bias + (size_t)((u.pm * BM) / SEQ) * (2 * FF) + u.pn * BM + lane * 4), (LAS unsigned*)(sl + 4096), 16, 0, 0);
    }
    __device__ __forceinline__ void operator()(const f32x4 (&acc)[2][2][4][2], const Unit& u, int wr, int wc, int fr, int fq) const {
        PINV(fr); PINV(fq);
        const int row0 = u.pm * BM + wr * 64 + fr, pnl = u.pn % nN;
        f32x4 (&a)[2][2][4][2] = const_cast<f32x4 (&)[2][2][4][2]>(acc);
        if (NORM) {
            const LAS unsigned char* sl = side + u.sp * SIDE_BYTES;
            f32x4 bv[2][2];
#pragma unroll
            for (int bj = 0; bj < 2; ++bj)
#pragma unroll
                for (int n = 0; n < 2; ++n) bv[bj][n] = *(const LAS f32x4*)(sl + 4096 + (bj * HALF + wc * 32 + 8 * fq + 4 * n) * 4);
#pragma unroll
            for (int k = 0; k < 8; ++k) { const float r = rinv_of(*(const LAS f32x4*)(sl + ((k >> 2) * HALF + wr * 64 + (k & 3) * 16 + fr) * 16)) * (F8 ? 1.0f / (GU_SA * GU_SW) : 1.0f);
#pragma unroll
                for (int bj = 0; bj < 2; ++bj)
#pragma unroll
                    for (int n = 0; n < 2; ++n) a[k >> 2][bj][k & 3][n] = acc_f32(a[k >> 2][bj][k & 3][n], F8 && GU_I8) * r + bv[bj][n]; }
        }
        unsigned ro = (unsigned)(row0 * FF + pnl * 128 + wc * 32 + 8 * fq) * (F8O ? 1u : 2u); const __amdgpu_buffer_rsrc_t rH = mk_rsrc(Hd);
#pragma unroll
        for (int k = 0; k < 8; ++k) { const int ai = k >> 2, m = k & 3;
            const f32x4 g0 = a[ai][0][m][0], g1 = a[ai][0][m][1], u0 = a[ai][1][m][0], u1 = a[ai][1][m][1];
            const f32x4 v0 = swiglu4(g0, u0, 1.0f, F8O ? F8_SH : 1.0f), v1 = swiglu4(g1, u1, 1.0f, F8O ? F8_SH : 1.0f);
            if (F8O) { v2u w8; w8.x = pk_fp8x4(v0); w8.y = pk_fp8x4(v1); st8(rH, ro, w8); } else st16(rH, ro, pack8(v0, v1));
            ro += ROWSTEP(k) * (unsigned)(FF * (F8O ? 1 : 2)); PINV(ro); }
    }
};
struct EpiSwiGLU8 {
    static constexpr bool PERM = true, SIDE = false;
    unsigned char* Hd; int nN;
    __device__ __forceinline__ void operator()(const f32x4 (&acc)[2][2][4][2], const Unit& u, int wr, int wc, int fr, int fq) const {
        PINV(fr); PINV(fq);
        const int row0 = u.pm * BM + wr * 64 + fr, pnl = u.pn % nN;
        unsigned ro = (unsigned)(row0 * FF + pnl * 128 + wc * 32 + 8 * fq); const __amdgpu_buffer_rsrc_t rH = mk_rsrc(Hd);
        constexpr float ci = 1.0f / (MOE_SA * MOE_SW);
#pragma unroll
        for (int k = 0; k < 8; ++k) { const int ai = k >> 2, m = k & 3;
            const f32x4 v0 = swiglu4(acc_f32(acc[ai][0][m][0], MOE_I8), acc_f32(acc[ai][1][m][0], MOE_I8), ci, ci * ci * F8_SH), v1 = swiglu4(acc_f32(acc[ai][0][m][1], MOE_I8), acc_f32(acc[ai][1][m][1], MOE_I8), ci, ci * ci * F8_SH);
            v2u w; w.x = pk_fp8x4(v0); w.y = pk_fp8x4(v1); st8(rH, ro, w);
            ro += ROWSTEP(k) * (unsigned)FF; PINV(ro); }
    }
};
template <bool I8> struct EpiQkvRopeT {
    static constexpr bool PERM = true, SIDE = true;
    bf16* QKV; const unsigned* rope; const float* SS; const float* bias; LAS unsigned char* side;
    __device__ __forceinline__ void side_issue(const Unit& u, int wid, int lane) const {
        LAS unsigned char* sl = side + u.sp * SIDE_BYTES;
        if (wid < 4) __builtin_amdgcn_global_load_lds((const unsigned*)(SS + ((size_t)(u.pm * BM + wid * 64 + lane)) * 4), (LAS unsigned*)(sl + wid * 1024), 16, 0, 0);
        else if (wid == 4) __builtin_amdgcn_global_load_lds((const unsigned*)(bias + (size_t)((u.pm * BM) / SEQ) * (2 * FF) + u.pn * BM + lane * 4), (LAS unsigned*)(sl + 4096), 16, 0, 0);
    }
    __device__ __forceinline__ void operator()(const f32x4 (&acc)[2][2][4][2], const Unit& u, int wr, int wc, int fr, int fq) const {
        PINV(fr); PINV(fq);
        const int hd = 4 * u.pn + wc; if (hd >= NHQKV) return;
        const int row0 = u.pm * BM + wr * 64 + fr;
        const float sc = hd < NH ? C2 : 1.0f;
        f32x4 (&a)[2][2][4][2] = const_cast<f32x4 (&)[2][2][4][2]>(acc);
        { const LAS unsigned char* sl = side + u.sp * SIDE_BYTES;
            f32x4 bv[2][2];
#pragma unroll
            for (int bj = 0; bj < 2; ++bj)
#pragma unroll
                for (int n = 0; n < 2; ++n) bv[bj][n] = *(const LAS f32x4*)(sl + 4096 + (bj * HALF + wc * 32 + 8 * fq + 4 * n) * 4);
#pragma unroll
            for (int k = 0; k < 8; ++k) { const float r = rinv_of(*(const LAS f32x4*)(sl + ((k >> 2) * HALF + wr * 64 + (k & 3) * 16 + fr) * 16)) * (I8 ? 1.0f / (GU_SA * GU_SW) : 1.0f);
#pragma unroll
                for (int bj = 0; bj < 2; ++bj)
#pragma unroll
                    for (int n = 0; n < 2; ++n) a[k >> 2][bj][k & 3][n] = acc_f32(a[k >> 2][bj][k & 3][n], I8) * r + bv[bj][n]; } }
        const bool rot = hd < 2 * NH; const __amdgpu_buffer_rsrc_t rQ = mk_rsrc(QKV);
        v4u cs[2][2];
        unsigned co = (unsigned)(row0 * 32 + 8 * fq) * 4u, ro = (unsigned)(row0 * QKVP + hd * 64 + 8 * fq) * 2u;
#define RP_H2F(u, hi) ((float)__builtin_bit_cast(_Float16, (unsigned short)((hi) ? ((u) >> 16) : ((u) & 0xffffu))))
        cs[0][0] = *at_off((const v4u*)rope, co); cs[0][1] = *at_off((const v4u*)rope, co + 16);
#pragma unroll
        for (int k = 0; k < 8; ++k) { const int ai = k >> 2, m = k & 3, cb_ = k & 1;
            co += ROWSTEP(k) * 128u; PINV(co);
            if (k < 7) { cs[cb_ ^ 1][0] = *at_off((const v4u*)rope, co); cs[cb_ ^ 1][1] = *at_off((const v4u*)rope, co + 16); }
#pragma unroll
            for (int n = 0; n < 2; ++n) {
                const f32x4 x1 = a[ai][0][m][n], x2 = a[ai][1][m][n]; f32x4 c, s;
#pragma unroll
                for (int i = 0; i < 4; ++i) { const float cf = RP_H2F(cs[cb_][n][i], 0), sf = RP_H2F(cs[cb_][n][i], 1); c[i] = rot ? cf : 1.0f; s[i] = rot ? sf : 0.0f; }
                const f32x4 o1 = (x1 * c - x2 * s) * sc, o2 = (x2 * c + x1 * s) * sc;
                v2u w; w.x = pg8::cvt_pk_bf16(o1[0], o1[1]); w.y = pg8::cvt_pk_bf16(o1[2], o1[3]); st8(rQ, ro + 8 * n, w);
                w.x = pg8::cvt_pk_bf16(o2[0], o2[1]); w.y = pg8::cvt_pk_bf16(o2[2], o2[3]); st8(rQ, ro + 64 + 8 * n, w); }
            ro += ROWSTEP(k) * (unsigned)(QKVP * 2); PINV(ro); }
#undef RP_H2F
    }
};
typedef EpiQkvRopeT<false> EpiQkvRope;
__device__ __forceinline__ void unpack8(const v4u u, f32x4& a, f32x4& b) { a = (f32x4){bflo(u.x), bfhi(u.x), bflo(u.y), bfhi(u.y)}; b = (f32x4){bflo(u.z), bfhi(u.z), bflo(u.w), bfhi(u.w)}; }
template <bool BASE_F32, bool NEXT, bool XB8 = false> struct EpiResidB {
    static constexpr bool PERM = true, SIDE = false;
    const void* base; bf16* XR; const float* gate; bf16* XB; float* SS; const float* scl; const float* ng; LAS float* red; float ascale;
    __device__ __forceinline__ void operator()(const f32x4 (&acc)[2][2][4][2], const Unit& u, int wr, int wc, int fr, int fq) const {
        PINV(fr); PINV(fq);
        const int row0 = u.pm * BM + wr * 64 + fr, col0 = u.pn * BM + wc * 32 + 8 * fq, b = (u.pm * BM) / SEQ;
        f32x4 gv[2][2], can[2][2];
#pragma unroll
        for (int bj = 0; bj < 2; ++bj)
#pragma unroll
            for (int n = 0; n < 2; ++n) { gv[bj][n] = *(const f32x4*)(gate + (size_t)b * 3072 + col0 + bj * HALF + 4 * n) * ascale;
                if (NEXT) can[bj][n] = *(const f32x4*)(ng + col0 + bj * HALF + 4 * n) * (*(const f32x4*)(scl + (size_t)b * 3072 + col0 + bj * HALF + 4 * n) + 1.0f); }
        const __amdgpu_buffer_rsrc_t rR = mk_rsrc(XR), rX = mk_rsrc(XB);
        f32x4 bf[2][2][2]; v4u bh[2][2];
        unsigned lo = (unsigned)(row0 * D + col0) * (BASE_F32 ? 4u : 2u), so = (unsigned)(row0 * D + col0) * 2u; int rl = wr * 64 + fr;
#define ER_LOAD(buf) do { if (BASE_F32) { _Pragma("unroll") for (int bj = 0; bj < 2; ++bj) _Pragma("unroll") for (int n = 0; n < 2; ++n) bf[buf][bj][n] = *at_off((const f32x4*)base, lo + (bj * HALF + 4 * n) * 4); } \
        else { _Pragma("unroll") for (int bj = 0; bj < 2; ++bj) bh[buf][bj] = *at_off((const v4u*)base, lo + bj * HALF * 2); } } while (0)
        ER_LOAD(0);
#pragma unroll
        for (int k = 0; k < 8; ++k) { const int ai = k >> 2, m = k & 3, cb_ = k & 1;
            lo += ROWSTEP(k) * (unsigned)(D * (BASE_F32 ? 4 : 2)); PINV(lo);
            if (k < 7) { if (cb_) ER_LOAD(0); else ER_LOAD(1); }
            float s = 0.f;
#pragma unroll
            for (int bj = 0; bj < 2; ++bj) { f32x4 x0, x1;
                if (BASE_F32) { x0 = bf[cb_][bj][0]; x1 = bf[cb_][bj][1]; } else unpack8(bh[cb_][bj], x0, x1);
                x0 = x0 + gv[bj][0] * acc[ai][bj][m][0]; x1 = x1 + gv[bj][1] * acc[ai][bj][m][1];
                st16(rR, so + bj * HALF * 2, pack8(x0, x1));
                if (NEXT) { s += ((x0.x * x0.x + x0.y * x0.y) + (x0.z * x0.z + x0.w * x0.w)) + ((x1.x * x1.x + x1.y * x1.y) + (x1.z * x1.z + x1.w * x1.w));
                    if (XB8) { v2u w8; w8.x = pk_q8x4(x0 * can[bj][0] * GU_SA); w8.y = pk_q8x4(x1 * can[bj][1] * GU_SA); st8(rX, (so >> 1) + bj * HALF, w8); }
                    else st16(rX, so + bj * HALF * 2, pack8(x0 * can[bj][0], x1 * can[bj][1])); } }
            if (NEXT) { s += __shfl_xor(s, 16); s += __shfl_xor(s, 32); if (fq == 0) red[rl * 4 + wc] = s; }
            so += ROWSTEP(k) * (unsigned)(D * 2); PINV(so); rl += (int)ROWSTEP(k); }
#undef ER_LOAD
        if (NEXT) {
            asm volatile("s_waitcnt lgkmcnt(0)" ::: "memory"); __builtin_amdgcn_s_barrier(); asm volatile("" ::: "memory");
            if (threadIdx.x < 256) { const f32x4 t = *(const LAS f32x4*)(red + threadIdx.x * 4); SS[(size_t)(u.pm * BM + threadIdx.x) * 4 + u.pn] = (t.x + t.y) + (t.z + t.w); }
        }
    }
};
struct EpiMoeDown {
    static constexpr bool PERM = true, SIDE = true;
    bf16* XR; bf16* Y1; const int* rowtok; const float* roww; const LAS float* gate; float oscale; LAS unsigned char* side;
    __device__ __forceinline__ void side_issue(const Unit& u, int wid, int lane) const {
        LAS unsigned char* sl = side + u.sp * 2048; const size_t lb = (size_t)u.g * M + 256 * u.k;
        if (wid < 4) __builtin_amdgcn_global_load_lds((const unsigned*)(rowtok + lb + wid * 64 + lane), (LAS unsigned*)(sl + wid * 256), 4, 0, 0);
        else __builtin_amdgcn_global_load_lds((const unsigned*)(roww + lb + (wid - 4) * 64 + lane), (LAS unsigned*)(sl + 1024 + (wid - 4) * 256), 4, 0, 0);
    }
    __device__ __forceinline__ void operator()(const f32x4 (&acc)[2][2][4][2], const Unit& u, int wr, int wc, int fr, int fq) const {
        PINV(fr); PINV(fq);
        const int col0 = (u.pn & 3) * BM + wc * 32 + 8 * fq; const LAS unsigned char* sl = side + u.sp * 2048;
        int tok[8]; float w[8];
#pragma unroll
        for (int k = 0; k < 8; ++k) { const int rl = (k >> 2) * HALF + wr * 64 + (k & 3) * 16 + fr; const bool ok = rl < u.nv; const int t_ = *(const LAS int*)(sl + rl * 4); const float w_ = *(const LAS float*)(sl + 1024 + rl * 4);
            tok[k] = ok ? t_ : -1; w[k] = ok ? w_ * oscale : 0.f; }
        if (u.g < 8) {
            const __amdgpu_buffer_rsrc_t rR = mk_rsrc(XR);
            v4u bh[2][2];
#define ER_LOAD(buf, kk) do { const unsigned o_ = (unsigned)((tok[kk] < 0 ? 0 : tok[kk]) * D + col0) * 2u; \
            _Pragma("unroll") for (int bj = 0; bj < 2; ++bj) bh[buf][bj] = *at_off((const v4u*)XR, o_ + bj * HALF * 2); } while (0)
            ER_LOAD(0, 0);
#pragma unroll
            for (int k = 0; k < 8; ++k) { const int ai = k >> 2, m = k & 3, cb_ = k & 1;
                if (k < 7) { if (cb_) ER_LOAD(0, (k + 1) & 7); else ER_LOAD(1, (k + 1) & 7); }
#pragma unroll
                for (int bj = 0; bj < 2; ++bj) PINV(bh[cb_][bj]);
                if (tok[k] >= 0) { const unsigned o_ = (unsigned)(tok[k] * D + col0) * 2u; const LAS float* g_ = gate + (tok[k] >> 13) * D + col0; const float w_ = w[k];
#pragma unroll
                    for (int bj = 0; bj < 2; ++bj) { f32x4 x0, x1; unpack8(bh[cb_][bj], x0, x1);
                        x0 = x0 + *(const LAS f32x4*)(g_ + bj * HALF) * w_ * acc[ai][bj][m][0]; x1 = x1 + *(const LAS f32x4*)(g_ + bj * HALF + 4) * w_ * acc[ai][bj][m][1];
                        st16(rR, o_ + bj * HALF * 2, pack8(x0, x1)); } } }
#undef ER_LOAD
        } else {
            const __amdgpu_buffer_rsrc_t rY = mk_rsrc(Y1);
#pragma unroll
            for (int k = 0; k < 8; ++k) { const int ai = k >> 2, m = k & 3;
                if (tok[k] >= 0) { const unsigned o_ = (unsigned)(tok[k] * D + col0) * 2u; const LAS float* g_ = gate + (tok[k] >> 13) * D + col0; const float w_ = w[k];
#pragma unroll
                    for (int bj = 0; bj < 2; ++bj) st16(rY, o_ + bj * HALF * 2, pack8(*(const LAS f32x4*)(g_ + bj * HALF) * w_ * acc[ai][bj][m][0], *(const LAS f32x4*)(g_ + bj * HALF + 4) * w_ * acc[ai][bj][m][1])); } }
        }
    }
};
struct EpiNull { static constexpr bool PERM = true, SIDE = false;
    __device__ __forceinline__ void operator()(const f32x4 (&acc)[2][2][4][2], const Unit& u, int wr, int wc, int fr, int fq) const {
        PINV(fr); PINV(fq);
#pragma unroll
        for (int ai = 0; ai < 2; ++ai)
#pragma unroll
            for (int bj = 0; bj < 2; ++bj)
                asm volatile("" :: "v"(acc[ai][bj][0][0]), "v"(acc[ai][bj][0][1]), "v"(acc[ai][bj][1][0]), "v"(acc[ai][bj][1][1]), "v"(acc[ai][bj][2][0]), "v"(acc[ai][bj][2][1]), "v"(acc[ai][bj][3][0]), "v"(acc[ai][bj][3][1])); } };
__constant__ float INVF[32] = {
    1.0f, 0.7498942093324559f, 0.5623413251903491f, 0.4216965034285822f, 0.31622776601683794f, 0.23713737056616552f, 0.1778279410038923f, 0.1333521432163324f,
    0.1f, 0.07498942093324558f, 0.05623413251903491f, 0.04216965034285822f, 0.03162277660168379f, 0.023713737056616554f, 0.01778279410038923f, 0.01333521432163324f,
    0.01f, 0.007498942093324558f, 0.005623413251903491f, 0.004216965034285823f, 0.0031622776601683794f, 0.0023713737056616554f, 0.0017782794100389228f, 0.001333521432163324f,
    0.001f, 0.0007498942093324559f, 0.0005623413251903491f, 0.0004216965034285823f, 0.00031622776601683794f, 0.00023713737056616554f, 0.00017782794100389227f, 0.0001333521432163324f };

template <int MAP, int FMT  >
__device__ __forceinline__ void conv_block(const float* W, int ld, int ncol, int kvalid, int k0, int c0, unsigned char* dst, int Kp  , int rowoff, float sc, int wave, int lane) {
    const int col = c0 + 4 * lane, kb = k0 + 16 * wave; const bool act = col < ncol;
    f32x4 v[16];
#pragma unroll
    for (int i = 0; i < 16; ++i) v[i] = (act && kb + i < kvalid) ? *(const f32x4*)(W + (size_t)(kb + i) * ld + col) : (f32x4){0.f, 0.f, 0.f, 0.f};
    if (!act) return;
    int nrow;
    if (MAP == 0) nrow = col;
    else if (MAP == 1) { if (col < 1024) nrow = 2048 + col; else { const int cc = (col - 1024) & 1023, up = col >= 2048; nrow = 256 * (cc >> 7) + (cc & 127) + (up ? 128 : 0); } }
    else if (MAP == 2) nrow = 256 * (col >> 7) + (col & 127);
    else { const int head = col >> 6, bj = (col >> 5) & 1, dd = col & 31; nrow = 256 * (head >> 2) + 128 * bj + 32 * (head & 3) + dd; }
    nrow += rowoff;
#pragma unroll
    for (int j = 0; j < 4; ++j) {
        if (FMT != 0) { v4u o;
#pragma unroll
            for (int q = 0; q < 4; ++q) { const f32x4 t = (f32x4){v[4 * q][j], v[4 * q + 1][j], v[4 * q + 2][j], v[4 * q + 3][j]} * sc; o[q] = FMT == 2 ? pk_i8x4(t) : pk_fp8x4(t); }
            *(v4u*)(dst + (size_t)(nrow + j) * Kp + kb) = o; }
        else { v4u o0, o1;
#pragma unroll
            for (int q = 0; q < 4; ++q) { o0[q] = pk2(v[2 * q][j], v[2 * q + 1][j]); o1[q] = pk2(v[8 + 2 * q][j], v[8 + 2 * q + 1][j]); }
            bf16* p = (bf16*)dst + (size_t)(nrow + j) * Kp + kb; *(v4u*)p = o0; *(v4u*)(p + 8) = o1; }
    }
}
__device__ __forceinline__ void p0_prologue(const Args& a, LAS unsigned char* lds, int gw, int NGW, int wave, int lane, int tid) {
    unsigned char* ws = a.ws;
    LAS float* sc = (LAS float*)(lds + 69632);
    for (int i = tid; i < NB * D; i += NTHR) sc[i] = silu_f(a.c[i]);
    if (blockIdx.x == 0) for (int i = tid; i < 16 * 3072; i += NTHR) ((float*)(ws + WS_ZG))[i] = 0.f;
    if (blockIdx.x == 1) for (int i = tid; i < 2 * RPAD; i += NTHR) ((int*)(ws + WS_IDENT))[i] = i;
    if (blockIdx.x == 2) {
        for (int i = tid; i < 192 * (D / 8); i += NTHR) { const int rr = i / (D / 8), c8 = i % (D / 8), bj = rr / 96, q = rr % 96;
            if (QKV_I8) { if (c8 < D / 16) *(v4u*)(ws + WS_WQKV + (size_t)(2816 + 128 * bj + 32 + q) * D + 16 * c8) = (v4u){0u, 0u, 0u, 0u}; }
            else *(v4u*)((bf16*)(ws + WS_WQKV) + (size_t)(2816 + 128 * bj + 32 + q) * D + 8 * c8) = (v4u){0u, 0u, 0u, 0u}; } }
    __syncthreads();
    constexpr int B_CIN = 8 * 12, B_COUT = 8 * 4, B_FG = 8 * 11, B_FD = 22 * 4, B_QKV = 8 * 12, B_WO = 8 * 4, B_MG = NE * B_FG, B_MD = NE * B_FD;
    constexpr int NBLK = B_CIN + B_COUT + 2 * B_FG + B_FD + B_QKV + B_WO + 2 * B_MG + B_MD;
    for (int it = blockIdx.x; it < NBLK; it += gridDim.x) {
        int r = it;
        if (r < B_CIN) { conv_block<1, CONVIN_I8 ? 2 : 0>(a.conv_w_in, 3072, 3072, D, 128 * (r / 12), 256 * (r % 12), ws + WS_WCIN, D, 0, GU_SW, wave, lane); continue; } r -= B_CIN;
        if (r < B_COUT) { conv_block<0, WOUT_FP8 ? 1 : 0>(a.conv_w_out, D, D, D, 128 * (r / 4), 256 * (r % 4), ws + WS_WCOUT, D, 0, F8_SW, wave, lane); continue; } r -= B_COUT;
        if (r < 2 * B_FG) { const int up = r >= B_FG, q = up ? r - B_FG : r;
            conv_block<2, DENSE_GU_FP8 ? (GU_I8 ? 2 : 1) : 0>(up ? a.ffn_u : a.ffn_g, FF, FF, D, 128 * (q / 11), 256 * (q % 11), ws + WS_WFGU, D, up ? 128 : 0, GU_SW, wave, lane); continue; } r -= 2 * B_FG;
        if (r < B_FD) { conv_block<0, DENSE_DOWN_FP8 ? 1 : 0>(a.ffn_d, D, D, FF, 128 * (r / 4), 256 * (r % 4), ws + WS_WFD, FF, 0, F8_SW, wave, lane); continue; } r -= B_FD;
        if (r < B_QKV) { conv_block<3, QKV_I8 ? 2 : 0>(a.w_qkv, 2880, 2880, D, 128 * (r / 12), 256 * (r % 12), ws + WS_WQKV, D, 0, GU_SW, wave, lane); continue; } r -= B_QKV;
        if (r < B_WO) { conv_block<0, WO_FP8 ? 1 : 0>(a.w_o, D, D, 960, 128 * (r / 4), 256 * (r % 4), ws + WS_WO, D, 0, F8_SW, wave, lane); continue; } r -= B_WO;
        if (r < 2 * B_MG) { const int up = r >= B_MG, q = up ? r - B_MG : r, e = q / B_FG, qq = q % B_FG;
            conv_block<2, MOE_I8 ? 2 : 1>((up ? a.moe_u : a.moe_g) + (size_t)e * D * FF, FF, FF, D, 128 * (qq / 11), 256 * (qq % 11), ws + WS_WMGU, D, e * 2 * FF + (up ? 128 : 0), MOE_SW, wave, lane); continue; } r -= 2 * B_MG;
        { const int e = r / B_FD, qq = r % B_FD;
            conv_block<0, 1>(a.moe_d + (size_t)e * FF * D, D, D, FF, 128 * (qq / 4), 256 * (qq % 4), ws + WS_WMD, FF, e * D, F8_SW, wave, lane); }
    }
    constexpr int I_ADA = 4 * 12 * 8, I_ROPE = M / 2;
    for (int it = gw; it < I_ADA + I_ROPE; it += NGW) {
        int r = it;
        if (r < I_ADA) {
            const int ls = r / 96, q = r % 96, cg = q / 8, kc = q % 8;
            const float* W = a.mod_w + (size_t)ls * D * 3072 + (size_t)(kc * 128) * 3072 + cg * 256 + 4 * lane;
            f32x4 acc[NB];
#pragma unroll
            for (int b = 0; b < NB; ++b) acc[b] = (f32x4){0.f, 0.f, 0.f, 0.f};
#pragma unroll 8
            for (int k = 0; k < 128; ++k) { const f32x4 w = *(const f32x4*)(W + (size_t)k * 3072);
#pragma unroll
                for (int b = 0; b < NB; ++b) acc[b] += w * sc[b * D + kc * 128 + k]; }
            float* P = (float*)(ws + WS_MODP);
#pragma unroll
            for (int b = 0; b < NB; ++b) *(f32x4*)(P + (size_t)(kc * 16 + ls * 4 + b) * 3072 + cg * 256 + 4 * lane) = acc[b];
            continue;
        }
        r -= I_ADA;
        {
            const int tok = 2 * r + (lane >> 5), i = lane & 31;
            const float ang = (float)a.pos[tok] * INVF[i];
            double rev = (double)ang * 0.15915494309189535; rev -= __builtin_rint(rev);
            const float fr = (float)rev;
            unsigned* R = (unsigned*)(ws + WS_ROPE) + (size_t)tok * 32;
            const _Float16 hc = (_Float16)__builtin_amdgcn_cosf(fr), hs = (_Float16)__builtin_amdgcn_sinf(fr);
            R[i] = (unsigned)__builtin_bit_cast(unsigned short, hc) | ((unsigned)__builtin_bit_cast(unsigned short, hs) << 16);
        }
    }
}

__device__ __forceinline__ void bias_gemv(const Args& a, int gw, int NGW, int lane, const LAS float* shl);
template <bool FROM_PARTIALS, bool ROUTE, bool SRC16 = false, bool OUT8 = ROUTE>
__device__ __forceinline__ void norm_phase(const Args& a, const void* xsrc, int ls, LAS unsigned char* lds, int G, int wave, int lane, int tid) {
    unsigned char* ws = a.ws;
    LAS float* cA = (LAS float*)lds;
    LAS float* cB = (LAS float*)(lds + 4096);
    LAS float* rwT = (LAS float*)(lds + 8192);
    bf16* H = (bf16*)(ws + WS_H);
    const float* P = (const float*)(ws + WS_MODP); const float* MF = (const float*)(ws + WS_MODF);
    if (ROUTE) { for (int i = tid; i < D * NE; i += NTHR) { const int k = i >> 3, e = i & 7; rwT[e * D + k] = a.router_w[i]; } }
    for (int ch = (G % 8 == 0) ? (blockIdx.x % 8) * (G / 8) + blockIdx.x / 8 : blockIdx.x; ch < NCHUNK; ch += G) {
        const int b = ch / (SEQ / 128);
        __syncthreads();
        for (int k = tid; k < D; k += NTHR) {
            float sh, scl;
            if (FROM_PARTIALS) { sh = a.mod_b[ls * 3072 + k]; scl = a.mod_b[ls * 3072 + D + k];
#pragma unroll
                for (int kc = 0; kc < 8; ++kc) { sh += P[(size_t)(kc * 16 + ls * 4 + b) * 3072 + k]; scl += P[(size_t)(kc * 16 + ls * 4 + b) * 3072 + D + k]; } }
            else { sh = MF[(size_t)(ls * 4 + b) * 3072 + k]; scl = MF[(size_t)(ls * 4 + b) * 3072 + D + k]; }
            cA[k] = a.norm_g[ls * D + k] * (1.0f + scl); cB[k] = sh;
        }
        int my_e0 = -1, my_e1 = -1; float my_w0 = 0.f, my_w1 = 0.f;
        __syncthreads();
        v2u nb16[2][4]; f32x4 nb32[2][4];
#define NP_LOAD(buf, ii) do { const int row_ = ch * 128 + wave * 16 + (ii); \
            if (SRC16) { const v2u* xr = (const v2u*)((const bf16*)xsrc + (size_t)row_ * D) + lane; _Pragma("unroll") for (int j = 0; j < 4; ++j) nb16[buf][j] = xr[64 * j]; } \
            else { const f32x4* xr = (const f32x4*)((const float*)xsrc + (size_t)row_ * D) + lane; _Pragma("unroll") for (int j = 0; j < 4; ++j) nb32[buf][j] = xr[64 * j]; } } while (0)
        NP_LOAD(0, 0);
        for (int i2 = 0; i2 < 16; i2 += 2) {
#pragma unroll
          for (int pb = 0; pb < 2; ++pb) {
            const int i = i2 + pb;
            if (pb == 0) NP_LOAD(1, i + 1); else if (i + 1 < 16) NP_LOAD(0, i + 1);
            const int row = ch * 128 + wave * 16 + i;
            f32x4 v[4]; float s = 0.f;
#pragma unroll
            for (int j = 0; j < 4; ++j) { if (SRC16) { const v2u t = nb16[pb][j]; v[j] = (f32x4){bflo(t.x), bfhi(t.x), bflo(t.y), bfhi(t.y)}; } else v[j] = nb32[pb][j]; }
#pragma unroll
            for (int j = 0; j < 4; ++j) s += (v[j].x * v[j].x + v[j].y * v[j].y) + (v[j].z * v[j].z + v[j].w * v[j].w);
            const float rinv = 1.0f / sqrtf(wave_sum(s) * (1.0f / D) + RMS_EPS);
            if (FROM_PARTIALS) { unsigned long long* x8 = (unsigned long long*)((bf16*)(ws + WS_XR) + (size_t)row * D) + lane;
#pragma unroll
                for (int j = 0; j < 4; ++j) x8[64 * j] = (unsigned long long)pk2(v[j].x, v[j].y) | ((unsigned long long)pk2(v[j].z, v[j].w) << 32); }
            unsigned long long* o8 = (unsigned long long*)(H + (size_t)row * D) + lane;
#pragma unroll
            for (int j = 0; j < 4; ++j) { const f32x4 ca = *(const LAS f32x4*)(cA + 4 * lane + 256 * j), cb = *(const LAS f32x4*)(cB + 4 * lane + 256 * j);
                v[j] = v[j] * rinv * ca + cb;
                if (OUT8) ((unsigned*)((unsigned char*)H + (size_t)row * D))[lane + 64 * j] = MOE_I8 ? pk_i8x4(v[j] * MOE_SA) : pk_fp8x4(v[j] * MOE_SA);
                else o8[64 * j] = (unsigned long long)pk2(v[j].x, v[j].y) | ((unsigned long long)pk2(v[j].z, v[j].w) << 32); }
            if (ROUTE) {
                float pe[NE];
#pragma unroll
                for (int e = 0; e < NE; ++e) pe[e] = 0.f;
#pragma unroll
                for (int j = 0; j < 4; ++j) {
#pragma unroll
                    for (int e = 0; e < NE; ++e) { const f32x4 w = *(const LAS f32x4*)(rwT + e * D + 4 * lane + 256 * j); pe[e] += (v[j].x * w.x + v[j].y * w.y) + (v[j].z * w.z + v[j].w * w.w); }
                    asm volatile("" ::: "memory"); }
                float lg[NE];
#pragma unroll
                for (int e = 0; e < NE; ++e) lg[e] = wave_sum(pe[e]);
                int i0 = 0; float v0 = lg[0];
#pragma unroll
                for (int e = 1; e < NE; ++e) if (lg[e] > v0) { v0 = lg[e]; i0 = e; }
                int i1 = -1; float v1 = -INFINITY;
#pragma unroll
                for (int e = 0; e < NE; ++e) if (e != i0 && lg[e] > v1) { v1 = lg[e]; i1 = e; }
                const float w0 = 1.0f / (1.0f + expf(v1 - v0)), w1 = 1.0f - w0;
                if (lane == i) { my_e0 = i0; my_e1 = i1; my_w0 = w0; my_w1 = w1; }
            }
          }
        }
#undef NP_LOAD
        if (ROUTE) {
            unsigned* CNT = (unsigned*)(ws + WS_CTL) + CW_CNT; int* RT2 = (int*)(ws + WS_RT2); float* RW2 = (float*)(ws + WS_RW2);
#pragma unroll
            for (int s = 0; s < 2; ++s) {
                const int me = lane < 16 ? (s ? my_e1 : my_e0) : -1; int rank = 0, mycount = 0;
#pragma unroll
                for (int e = 0; e < NE; ++e) { const unsigned long long mask = __ballot(me == e); if (lane == e) mycount = __popcll(mask); if (me == e) rank = __popcll(mask & ((1ull << lane) - 1ull)); }
                int base = 0; if (lane < NE && mycount > 0) base = (int)__hip_atomic_fetch_add(CNT + s * 8 + lane, (unsigned)mycount, __ATOMIC_RELAXED, __HIP_MEMORY_SCOPE_AGENT);
                const int bs = __shfl(base, me < 0 ? 0 : me);
                if (lane < 16) { const size_t p = (size_t)(s * 8 + me) * M + bs + rank; RT2[p] = ch * 128 + wave * 16 + lane; RW2[p] = s ? my_w1 : my_w0; }
            }
        }
    }
    if (FROM_PARTIALS) {
        LAS float* shl = (LAS float*)(lds + 8192);
        __syncthreads();
        for (int i = tid; i < 2 * NB * D; i += NTHR) { const int lsb = 4 + (i >> 10), k = i & (D - 1); float v = a.mod_b[(lsb >> 2) * 3072 + k];
#pragma unroll
            for (int kc = 0; kc < 8; ++kc) v += P[(size_t)(kc * 16 + lsb) * 3072 + k];
            shl[i] = v; }
        __syncthreads();
        bias_gemv(a, ((G % 8 == 0) ? (blockIdx.x % 8) * (G / 8) + blockIdx.x / 8 : blockIdx.x) * NWAVES + wave, G * NWAVES, lane, shl);
    }
    if (FROM_PARTIALS) {
        float* MFw = (float*)(ws + WS_MODF);
        for (int idx = blockIdx.x * NTHR + tid; idx < 16 * 3072; idx += G * NTHR) { const int lsb = idx / 3072, n = idx % 3072; float s = a.mod_b[(lsb >> 2) * 3072 + n];
#pragma unroll
            for (int kc = 0; kc < 8; ++kc) s += P[(size_t)(kc * 16 + lsb) * 3072 + n];
            MFw[idx] = s; }
    }
}

__device__ __forceinline__ void conv_phase(const Args& a, int G, int tid) {
    unsigned char* ws = a.ws;
    const bf16* V = (const bf16*)(ws + WS_V); const bf16* Bg = (const bf16*)(ws + WS_BG); bf16* Y = (bf16*)(ws + WS_H);
    const int cg = tid & 127, rs = tid >> 7;
    float w0[8], w1[8], w2[8];
#pragma unroll
    for (int i = 0; i < 8; ++i) { w0[i] = a.conv_w[8 * cg + i]; w1[i] = a.conv_w[D + 8 * cg + i]; w2[i] = a.conv_w[2 * D + 8 * cg + i]; }
    for (int ch = (G % 8 == 0) ? (blockIdx.x % 8) * (G / 8) + blockIdx.x / 8 : blockIdx.x; ch < NCHUNK; ch += G) {
        const int r0 = ch * 128 + rs * 32, t0 = r0 & (SEQ - 1);
        v4u zz = (v4u){0u, 0u, 0u, 0u};
        v4u vm2 = t0 >= 2 ? *(const v4u*)(V + (size_t)(r0 - 2) * D + 8 * cg) : zz;
        v4u vm1 = t0 >= 1 ? *(const v4u*)(V + (size_t)(r0 - 1) * D + 8 * cg) : zz;
#pragma unroll 4
        for (int i = 0; i < 32; ++i) {
            const size_t off = (size_t)(r0 + i) * D + 8 * cg;
            const v4u v = *(const v4u*)(V + off), bg = *(const v4u*)(Bg + off);
            v4u o; float ylo8[4], yhi8[4];
#pragma unroll
            for (int q = 0; q < 4; ++q) {
                const float ylo = bflo(bg[q]) * (w0[2 * q] * bflo(vm2[q]) + w1[2 * q] * bflo(vm1[q]) + w2[2 * q] * bflo(v[q]));
                const float yhi = bfhi(bg[q]) * (w0[2 * q + 1] * bfhi(vm2[q]) + w1[2 * q + 1] * bfhi(vm1[q]) + w2[2 * q + 1] * bfhi(v[q]));
                o[q] = pk2(ylo, yhi); if (WOUT_FP8) { ylo8[q] = ylo; yhi8[q] = yhi; } }
            if (WOUT_FP8) { v2u w8; w8.x = pk_fp8x4((f32x4){ylo8[0], yhi8[0], ylo8[1], yhi8[1]} * F8_SH); w8.y = pk_fp8x4((f32x4){ylo8[2], yhi8[2], ylo8[3], yhi8[3]} * F8_SH); *(v2u*)((unsigned char*)Y + off) = w8; }
            else *(v4u*)(Y + off) = o;
            vm2 = vm1; vm1 = v;
        }
    }
}

__device__ __forceinline__ void bias_gemv(const Args& a, int gw, int NGW, int lane, const LAS float* shl) {
    unsigned char* ws = a.ws; float* BV = (float*)(ws + WS_BIASV);
    constexpr int NROW = 2 * FF + QKVP, RPW = 5;
    for (int base = 0; base < NROW; base += RPW * NGW) {
    float res[RPW][NB];
#pragma unroll
    for (int i = 0; i < RPW; ++i) {
        const int r = base + gw + i * NGW; const bool ok = r < NROW; const int rr = ok ? r : 0;
        const int ls = rr < 2 * FF ? 1 : 2, np = ls == 1 ? rr : rr - 2 * FF;
        float wf[16];
        if ((ls == 1 && DENSE_GU_FP8) || (ls == 2 && QKV_I8)) { const v4u w8 = *(const v4u*)(ws + (ls == 1 ? WS_WFGU : WS_WQKV) + (size_t)np * D + 16 * lane);
#pragma unroll
            for (int q = 0; q < 4; ++q) {
                if (GU_I8 || ls == 2) { const int w = (int)w8[q]; wf[4 * q] = (float)((w << 24) >> 24) * (1.0f / GU_SW); wf[4 * q + 1] = (float)((w << 16) >> 24) * (1.0f / GU_SW); wf[4 * q + 2] = (float)((w << 8) >> 24) * (1.0f / GU_SW); wf[4 * q + 3] = (float)(w >> 24) * (1.0f / GU_SW); }
                else { wf[4 * q] = __builtin_amdgcn_cvt_f32_fp8((int)w8[q], 0) * (1.0f / GU_SW); wf[4 * q + 1] = __builtin_amdgcn_cvt_f32_fp8((int)w8[q], 1) * (1.0f / GU_SW);
                    wf[4 * q + 2] = __builtin_amdgcn_cvt_f32_fp8((int)w8[q], 2) * (1.0f / GU_SW); wf[4 * q + 3] = __builtin_amdgcn_cvt_f32_fp8((int)w8[q], 3) * (1.0f / GU_SW); } } }
        else { const bf16* wrow = (ls == 1 ? (const bf16*)(ws + WS_WFGU) : (const bf16*)(ws + WS_WQKV)) + (size_t)np * D + 16 * lane;
            const v4u w0 = *(const v4u*)wrow, w1 = *(const v4u*)(wrow + 8);
#pragma unroll
            for (int q = 0; q < 4; ++q) { wf[2 * q] = bflo(w0[q]); wf[2 * q + 1] = bfhi(w0[q]); wf[8 + 2 * q] = bflo(w1[q]); wf[8 + 2 * q + 1] = bfhi(w1[q]); } }
#pragma unroll
        for (int b = 0; b < NB; ++b) { const LAS float* sh = shl + ((ls - 1) * 4 + b) * D + 16 * lane; float p = 0.f;
#pragma unroll
            for (int q = 0; q < 4; ++q) { const f32x4 s4 = *(const LAS f32x4*)(sh + 4 * q); p += (wf[4 * q] * s4.x + wf[4 * q + 1] * s4.y) + (wf[4 * q + 2] * s4.z + wf[4 * q + 3] * s4.w); }
            res[i][b] = wave_sum(p); }
    }
#pragma unroll
    for (int i = 0; i < RPW; ++i) { const int r = base + gw + i * NGW;
        if (r < NROW && lane == 0) { const int ls = r < 2 * FF ? 1 : 2, np = ls == 1 ? r : r - 2 * FF;
#pragma unroll
            for (int b = 0; b < NB; ++b) BV[(size_t)((ls - 1) * 4 + b) * (2 * FF) + np] = res[i][b]; } }
    }
}
typedef float f32x16 __attribute__((ext_vector_type(16)));
typedef short bf16x8 __attribute__((ext_vector_type(8)));
typedef short v4i16_t __attribute__((ext_vector_type(4)));
constexpr int ATT_TILES = NB * NH * 256;
constexpr int KROWB = 144;
constexpr int VROWB = 192;
template <int PASS>
__device__ __forceinline__ void attn_mfma(const Args& a, LAS unsigned char* lds, int gw, int NGW, int wave, int lane) {
    unsigned char* ws = a.ws;
    const bf16* QKV = (const bf16*)(ws + WS_QKV); bf16* AO = (bf16*)(ws + WS_H); float* LSE = (float*)(ws + WS_LSE);
    const int r32 = lane & 31, hi = lane >> 5;
    LAS unsigned char* vbuf = lds + wave * (32 * VROWB + 32 * KROWB);
    LAS unsigned char* kbuf = vbuf + 32 * VROWB;
    const int L16 = lane & 15, tq = L16 >> 2, tp = L16 & 3, gi = (lane >> 4) & 1;
    LAS unsigned char* trbase = vbuf + (4 * hi + tq) * VROWB + (16 * gi + 4 * tp) * 2;
    const bool OWNER = (NGW == 2048);
    const int ntl = OWNER ? NH * 128 : ATT_TILES, tstep = OWNER ? 256 : NGW;
    for (int lt = OWNER ? ((int)blockIdx.x >> 3) * NWAVES + wave : gw; lt < ntl; lt += tstep) {
        int tile = lt;
        if (OWNER) { const int x = (int)blockIdx.x & 7, hq_ = lt >> 7, tl = lt & 127, sh_ = 2 * (hq_ / 5), hb = 128 >> sh_;
            tile = ((tl >> (7 - sh_)) << (8 - sh_)) + (x & 1) * hb + (tl & (hb - 1)) + 256 * ((x >> 1) * NH + hq_); }
        const int ti = tile & 255, bh = tile >> 8, b = bh / NH, hq = bh - b * NH, g = hq / 5, slot = hq - g * 5;
        const int sh = 2 * g, r = 1 << sh, nblk = 256 >> sh, rho = ti >> (8 - sh), blk = ti & (nblk - 1), i0 = 32 * blk;
        const size_t tok0 = (size_t)b * SEQ + rho;
        const bf16* Qp = QKV + (tok0 + (size_t)r * (i0 + r32)) * QKVP + hq * 64 + 8 * hi;
        bf16x8 qf[4];
#pragma unroll
        for (int ds = 0; ds < 4; ++ds) qf[ds] = *(const bf16x8*)(Qp + 16 * ds);
        const int nkb = blk + 1 < 5 ? blk + 1 : 5;
        float m_run = -1e30f, l_run = 0.f, LT = 0.f;
        f32x16 o0 = {}, o1 = {};
        if (PASS == 1) { const float* lp = LSE + (tok0 + (size_t)r * (i0 + r32)) * 16 + slot; const float l0 = lp[0], l1 = lp[5], l2 = lp[10];
            const float mm = fmaxf(fmaxf(l0, l1), l2);
            LT = mm + __builtin_amdgcn_logf(__builtin_amdgcn_exp2f(l0 - mm) + __builtin_amdgcn_exp2f(l1 - mm) + __builtin_amdgcn_exp2f(l2 - mm)); }
        v4u krn[4], vrn[4];
#define ATT_LOAD(jj) do { const int p0_ = i0 + 32 * ((jj) - (nkb - 1)); \
            _Pragma("unroll") for (int c = 0; c < 4; ++c) { const int pi = lane + 64 * c, row = pi >> 3, chunk = pi & 7; const bf16* rp_ = QKV + (tok0 + (size_t)r * (p0_ + row)) * QKVP + 8 * chunk; \
                krn[c] = *(const v4u*)(rp_ + (NH + hq) * 64); if (PASS == 1) vrn[c] = *(const v4u*)(rp_ + (2 * NH + hq) * 64); } } while (0)
        ATT_LOAD(0);
        for (int j = 0; j < nkb; ++j) {
            const int kb = j - (nkb - 1);
            bf16x8 kf[4]; v4u vraw[4];
#pragma unroll
            for (int c = 0; c < 4; ++c) { const int pi = lane + 64 * c, row = pi >> 3, chunk = pi & 7; *(LAS v4u*)(kbuf + row * KROWB + chunk * 16) = krn[c]; }
            if (PASS == 1) {
#pragma unroll
                for (int c = 0; c < 4; ++c) vraw[c] = vrn[c]; }
            if (j + 1 < nkb) ATT_LOAD(j + 1);
#pragma unroll
            for (int ds = 0; ds < 4; ++ds) kf[ds] = *(const LAS bf16x8*)(kbuf + r32 * KROWB + (16 * ds + 8 * hi) * 2);
            f32x16 s = {};
#pragma unroll
            for (int ds = 0; ds < 4; ++ds) s = __builtin_amdgcn_mfma_f32_32x32x16_bf16(kf[ds], qf[ds], s, 0, 0, 0);
            if (kb == 0) {
#pragma unroll
                for (int q = 0; q < 16; ++q) { const int c = (q & 3) + 8 * (q >> 2) + 4 * hi; if (c > r32) s[q] = -1e30f; }
            } else if (kb == -4) {
#pragma unroll
                for (int q = 0; q < 16; ++q) { const int c = (q & 3) + 8 * (q >> 2) + 4 * hi; if (c < r32) s[q] = -1e30f; }
            }
            if (PASS == 0) {
                float bm = s[0];
#pragma unroll
                for (int q = 1; q < 16; ++q) bm = fmaxf(bm, s[q]);
                const float mn = fmaxf(m_run, bm); float acc = 0.f;
#pragma unroll
                for (int q = 0; q < 16; ++q) acc += __builtin_amdgcn_exp2f(s[q] - mn);
                l_run = l_run * __builtin_amdgcn_exp2f(m_run - mn) + acc; m_run = mn;
            } else {
#pragma unroll
                for (int c = 0; c < 4; ++c) { const int pi = lane + 64 * c, row = pi >> 3, chunk = pi & 7; *(LAS v4u*)(vbuf + row * VROWB + chunk * 16) = vraw[c]; }
                v4u pw0, pw1;
                { float p[16];
#pragma unroll
                  for (int q = 0; q < 16; ++q) p[q] = __builtin_amdgcn_exp2f(s[q] - LT);
                  pw0.x = pg8::cvt_pk_bf16(p[0], p[1]); pw0.y = pg8::cvt_pk_bf16(p[2], p[3]); pw0.z = pg8::cvt_pk_bf16(p[4], p[5]); pw0.w = pg8::cvt_pk_bf16(p[6], p[7]);
                  pw1.x = pg8::cvt_pk_bf16(p[8], p[9]); pw1.y = pg8::cvt_pk_bf16(p[10], p[11]); pw1.z = pg8::cvt_pk_bf16(p[12], p[13]); pw1.w = pg8::cvt_pk_bf16(p[14], p[15]); }
                const bf16x8 pa0 = __builtin_bit_cast(bf16x8, pw0), pa1 = __builtin_bit_cast(bf16x8, pw1);
#pragma unroll
                for (int db = 0; db < 2; ++db) {
                    bf16x8 vb[2];
#pragma unroll
                    for (int s2 = 0; s2 < 2; ++s2) {
                        const v4i16_t lo = __builtin_amdgcn_ds_read_tr16_b64_v4i16((LAS v4i16_t*)(trbase + (16 * s2) * VROWB + 64 * db));
                        const v4i16_t hh = __builtin_amdgcn_ds_read_tr16_b64_v4i16((LAS v4i16_t*)(trbase + (16 * s2 + 8) * VROWB + 64 * db));
                        vb[s2] = (bf16x8){lo[0], lo[1], lo[2], lo[3], hh[0], hh[1], hh[2], hh[3]};
                    }
                    if (db == 0) { o0 = __builtin_amdgcn_mfma_f32_32x32x16_bf16(pa0, vb[0], o0, 0, 0, 0); o0 = __builtin_amdgcn_mfma_f32_32x32x16_bf16(pa1, vb[1], o0, 0, 0, 0); }
                    else         { o1 = __builtin_amdgcn_mfma_f32_32x32x16_bf16(pa0, vb[0], o1, 0, 0, 0); o1 = __builtin_amdgcn_mfma_f32_32x32x16_bf16(pa1, vb[1], o1, 0, 0, 0); }
                }
            }
        }
        if (PASS == 0) {
            const float m2 = __shfl_xor(m_run, 32), l2 = __shfl_xor(l_run, 32);
            const float mt = fmaxf(m_run, m2), lt = l_run * __builtin_amdgcn_exp2f(m_run - mt) + l2 * __builtin_amdgcn_exp2f(m2 - mt);
            if (hi == 0) LSE[(tok0 + (size_t)r * (i0 + r32)) * 16 + hq] = mt + __builtin_amdgcn_logf(lt);
        } else {
#pragma unroll
            for (int q = 0; q < 16; ++q) { const int c = (q & 3) + 8 * (q >> 2) + 4 * hi;
                if (WO_FP8) { unsigned char* op8 = (unsigned char*)AO + (tok0 + (size_t)r * (i0 + c)) * D + hq * 64 + r32;
                    op8[0] = (unsigned char)(pk_fp8x4((f32x4){o0[q] * F8_SO, 0.f, 0.f, 0.f}) & 0xffu); op8[32] = (unsigned char)(pk_fp8x4((f32x4){o1[q] * F8_SO, 0.f, 0.f, 0.f}) & 0xffu); }
                else { bf16* op = AO + (tok0 + (size_t)r * (i0 + c)) * D + hq * 64 + r32; op[0] = (bf16)f2bf(o0[q]); op[32] = (bf16)f2bf(o1[q]); } }
            if (hq == 0) {
#pragma unroll
                for (int c = 0; c < 4; ++c) { const int pi = lane + 64 * c, row = pi >> 3, chunk = pi & 7;
                    if (WO_FP8) { if (chunk < 4) *(v4u*)((unsigned char*)AO + (tok0 + i0 + row) * D + 960 + 16 * chunk) = (v4u){0u, 0u, 0u, 0u}; }
                    else *(v4u*)(AO + (tok0 + i0 + row) * D + 960 + 8 * chunk) = (v4u){0u, 0u, 0u, 0u}; }
            }
        }
    }
}

__device__ __forceinline__ void attn_one(const Args& a, LAS unsigned char* lds, int gw, int NGW, int wave, int lane) {
    unsigned char* ws = a.ws;
    const bf16* QKV = (const bf16*)(ws + WS_QKV); unsigned char* AO = ws + WS_H; float* LSE = (float*)(ws + WS_LSE);
    const int r32 = lane & 31, hi = lane >> 5;
    LAS unsigned char* vbuf = lds + wave * (32 * VROWB + 32 * KROWB);
    LAS unsigned char* kbuf = vbuf + 32 * VROWB;
    const int L16 = lane & 15, tq = L16 >> 2, tp = L16 & 3, gi = (lane >> 4) & 1;
    LAS unsigned char* trbase = vbuf + (4 * hi + tq) * VROWB + (16 * gi + 4 * tp) * 2;
    const bool OWNER = (NGW == 2048);
    const int ntl = OWNER ? NH * 128 : ATT_TILES, tstep = OWNER ? 256 : NGW;
    for (int lt = OWNER ? ((int)blockIdx.x >> 3) * NWAVES + wave : gw; lt < ntl; lt += tstep) {
        int tile = lt;
        if (OWNER) { const int x = (int)blockIdx.x & 7, hq_ = lt >> 7, tl = lt & 127, sh_ = 2 * (hq_ / 5), hb = 128 >> sh_;
            tile = ((tl >> (7 - sh_)) << (8 - sh_)) + (x & 1) * hb + (tl & (hb - 1)) + 256 * ((x >> 1) * NH + hq_); }
        const int ti = tile & 255, bh = tile >> 8, b = bh / NH, hq = bh - b * NH, g = hq / 5;
        const int sh = 2 * g, r = 1 << sh, nblk = 256 >> sh, rho = ti >> (8 - sh), blk = ti & (nblk - 1), i0 = 32 * blk;
        const size_t tok0 = (size_t)b * SEQ + rho;
        const bf16* Qp = QKV + (tok0 + (size_t)r * (i0 + r32)) * QKVP + hq * 64 + 8 * hi;
        bf16x8 qf[4];
#pragma unroll
        for (int ds = 0; ds < 4; ++ds) qf[ds] = *(const bf16x8*)(Qp + 16 * ds);
        const int kb0 = blk >= 4 ? 0 : 4 - blk;
        v4u krn[4], vrn[4];
#define A1_LOAD(dst, kbi, hoff) do { const int p0_ = i0 + 32 * ((kbi) - 4); \
            _Pragma("unroll") for (int c = 0; c < 4; ++c) { const int pi = lane + 64 * c, row = pi >> 3, chunk = pi & 7; \
                dst[c] = *(const v4u*)(QKV + (tok0 + (size_t)r * (p0_ + row)) * QKVP + 8 * chunk + (hoff) * 64); } } while (0)
        A1_LOAD(krn, kb0, NH + hq);
        f32x16 S[5];
        float m_run = -1e30f, l_run = 0.f;
#pragma unroll
        for (int kbi = 0; kbi < 5; ++kbi) {
            if (kbi >= kb0) {
#pragma unroll
                for (int c = 0; c < 4; ++c) { const int pi = lane + 64 * c, row = pi >> 3, chunk = pi & 7; *(LAS v4u*)(kbuf + row * KROWB + chunk * 16) = krn[c]; }
                if (kbi < 4) A1_LOAD(krn, kbi + 1, NH + hq); else A1_LOAD(vrn, kb0, 2 * NH + hq);
                bf16x8 kf[4];
#pragma unroll
                for (int ds = 0; ds < 4; ++ds) kf[ds] = *(const LAS bf16x8*)(kbuf + r32 * KROWB + (16 * ds + 8 * hi) * 2);
                f32x16 s = {};
#pragma unroll
                for (int ds = 0; ds < 4; ++ds) s = __builtin_amdgcn_mfma_f32_32x32x16_bf16(kf[ds], qf[ds], s, 0, 0, 0);
                if (kbi == 4) {
#pragma unroll
                    for (int q = 0; q < 16; ++q) { const int c = (q & 3) + 8 * (q >> 2) + 4 * hi; if (c > r32) s[q] = -1e30f; }
                } else if (kbi == 0) {
#pragma unroll
                    for (int q = 0; q < 16; ++q) { const int c = (q & 3) + 8 * (q >> 2) + 4 * hi; if (c < r32) s[q] = -1e30f; }
                }
                float bm = s[0];
#pragma unroll
                for (int q = 1; q < 16; ++q) bm = fmaxf(bm, s[q]);
                const float mn = fmaxf(m_run, bm); float acc = 0.f;
#pragma unroll
                for (int q = 0; q < 16; ++q) acc += __builtin_amdgcn_exp2f(s[q] - mn);
                l_run = l_run * __builtin_amdgcn_exp2f(m_run - mn) + acc; m_run = mn;
                S[kbi] = s;
            }
        }
        float lse;
        { const float m2 = __shfl_xor(m_run, 32), l2 = __shfl_xor(l_run, 32);
          const float mt = fmaxf(m_run, m2), ltot = l_run * __builtin_amdgcn_exp2f(m_run - mt) + l2 * __builtin_amdgcn_exp2f(m2 - mt);
          lse = mt + __builtin_amdgcn_logf(ltot); }
        if (hi == 0) LSE[(tok0 + (size_t)r * (i0 + r32)) * 16 + hq] = lse;
        f32x16 o0 = {}, o1 = {};
#pragma unroll
        for (int kbi = 0; kbi < 5; ++kbi) {
            if (kbi >= kb0) {
#pragma unroll
                for (int c = 0; c < 4; ++c) { const int pi = lane + 64 * c, row = pi >> 3, chunk = pi & 7; *(LAS v4u*)(vbuf + row * VROWB + chunk * 16) = vrn[c]; }
                if (kbi < 4) A1_LOAD(vrn, kbi + 1, 2 * NH + hq);
                v4u pw0, pw1;
                { float p[16];
#pragma unroll
                  for (int q = 0; q < 16; ++q) p[q] = __builtin_amdgcn_exp2f(S[kbi][q] - lse);
                  pw0.x = pg8::cvt_pk_bf16(p[0], p[1]); pw0.y = pg8::cvt_pk_bf16(p[2], p[3]); pw0.z = pg8::cvt_pk_bf16(p[4], p[5]); pw0.w = pg8::cvt_pk_bf16(p[6], p[7]);
                  pw1.x = pg8::cvt_pk_bf16(p[8], p[9]); pw1.y = pg8::cvt_pk_bf16(p[10], p[11]); pw1.z = pg8::cvt_pk_bf16(p[12], p[13]); pw1.w = pg8::cvt_pk_bf16(p[14], p[15]); }
                const bf16x8 pa0 = __builtin_bit_cast(bf16x8, pw0), pa1 = __builtin_bit_cast(bf16x8, pw1);
#pragma unroll
                for (int db = 0; db < 2; ++db) {
                    bf16x8 vb[2];
#pragma unroll
                    for (int s2 = 0; s2 < 2; ++s2) {
                        const v4i16_t lo = __builtin_amdgcn_ds_read_tr16_b64_v4i16((LAS v4i16_t*)(trbase + (16 * s2) * VROWB + 64 * db));
                        const v4i16_t hh = __builtin_amdgcn_ds_read_tr16_b64_v4i16((LAS v4i16_t*)(trbase + (16 * s2 + 8) * VROWB + 64 * db));
                        vb[s2] = (bf16x8){lo[0], lo[1], lo[2], lo[3], hh[0], hh[1], hh[2], hh[3]};
                    }
                    if (db == 0) { o0 = __builtin_amdgcn_mfma_f32_32x32x16_bf16(pa0, vb[0], o0, 0, 0, 0); o0 = __builtin_amdgcn_mfma_f32_32x32x16_bf16(pa1, vb[1], o0, 0, 0, 0); }
                    else         { o1 = __builtin_amdgcn_mfma_f32_32x32x16_bf16(pa0, vb[0], o1, 0, 0, 0); o1 = __builtin_amdgcn_mfma_f32_32x32x16_bf16(pa1, vb[1], o1, 0, 0, 0); }
                }
            }
        }
#undef A1_LOAD
#pragma unroll
        for (int q = 0; q < 16; ++q) { const int c = (q & 3) + 8 * (q >> 2) + 4 * hi;
            unsigned char* op8 = AO + (tok0 + (size_t)r * (i0 + c)) * D + hq * 64 + r32;
            op8[0] = (unsigned char)(pk_fp8x4((f32x4){o0[q] * F8_SO, 0.f, 0.f, 0.f}) & 0xffu); op8[32] = (unsigned char)(pk_fp8x4((f32x4){o1[q] * F8_SO, 0.f, 0.f, 0.f}) & 0xffu); }
        if (hq == 0) {
#pragma unroll
            for (int c = 0; c < 4; ++c) { const int pi = lane + 64 * c, row = pi >> 3, chunk = pi & 7;
                if (chunk < 4) *(v4u*)(AO + (tok0 + i0 + row) * D + 960 + 16 * chunk) = (v4u){0u, 0u, 0u, 0u}; }
        }
    }
}
__device__ __forceinline__ void attn_fix(const Args& a, int G, int wave, int lane) {
    unsigned char* AO = a.ws + WS_H; const float* LSE = (const float*)(a.ws + WS_LSE);
    const int head = lane >> 2, slot = head % 5; const bool act = lane < 60;
    for (int ch = (G % 8 == 0) ? (blockIdx.x % 8) * (G / 8) + blockIdx.x / 8 : blockIdx.x; ch < NCHUNK; ch += G) {
        const int t0 = ch * 128 + wave * 16;
#pragma unroll 1
        for (int tb = 0; tb < 16; tb += 4) {
            v4u raw[4]; float l0[4], l1[4], l2[4];
#pragma unroll
            for (int j = 0; j < 4; ++j) { const size_t tok = (size_t)(t0 + tb + j);
                raw[j] = act ? *(const v4u*)(AO + tok * D + 16 * lane) : (v4u){0u, 0u, 0u, 0u};
                l0[j] = act ? LSE[tok * 16 + slot] : 0.f; l1[j] = act ? LSE[tok * 16 + slot + 5] : 0.f; l2[j] = act ? LSE[tok * 16 + slot + 10] : 0.f; }
#pragma unroll
            for (int j = 0; j < 4; ++j) { const size_t tok = (size_t)(t0 + tb + j);
                const float mm = fmaxf(fmaxf(l0[j], l1[j]), l2[j]);
                const float LT = mm + __builtin_amdgcn_logf(__builtin_amdgcn_exp2f(l0[j] - mm) + __builtin_amdgcn_exp2f(l1[j] - mm) + __builtin_amdgcn_exp2f(l2[j] - mm));
                const float mine = head < 5 ? l0[j] : (head < 10 ? l1[j] : l2[j]);
                const float f = __builtin_amdgcn_exp2f(mine - LT);
                v4u o;
#pragma unroll
                for (int q = 0; q < 4; ++q) { const int w = (int)raw[j][q];
                    o[q] = pk_fp8x4((f32x4){__builtin_amdgcn_cvt_f32_fp8(w, 0) * f, __builtin_amdgcn_cvt_f32_fp8(w, 1) * f, __builtin_amdgcn_cvt_f32_fp8(w, 2) * f, __builtin_amdgcn_cvt_f32_fp8(w, 3) * f}); }
                if (act) *(v4u*)(AO + tok * D + 16 * lane) = o; }
        }
    }
}

__device__ __forceinline__ void final_norm_phase(const Args& a, int gw, int NGW, int lane) {
    const bf16* XR = (const bf16*)(a.ws + WS_XR); const bf16* Y1 = (const bf16*)(a.ws + WS_Y1);
    f32x4 g[4];
#pragma unroll
    for (int j = 0; j < 4; ++j) g[j] = *((const f32x4*)a.final_g + lane + 64 * j);
    for (int row0 = gw; row0 < M; row0 += 2 * NGW) {
        v2u vv[2][4], yy[2][4];
#pragma unroll
        for (int q = 0; q < 2; ++q) { const int row = row0 + q * NGW; if (row < M) { const v2u* xr = (const v2u*)(XR + (size_t)row * D) + lane; const v2u* yr = (const v2u*)(Y1 + (size_t)row * D) + lane;
#pragma unroll
            for (int j = 0; j < 4; ++j) { vv[q][j] = xr[64 * j]; yy[q][j] = yr[64 * j]; } } }
#pragma unroll
        for (int q = 0; q < 2; ++q) { const int row = row0 + q * NGW; if (row < M) { f32x4* xo = (f32x4*)(a.out + (size_t)row * D) + lane; f32x4 v[4]; float s = 0.f;
#pragma unroll
            for (int j = 0; j < 4; ++j) { v[j] = (f32x4){bflo(vv[q][j].x) + bflo(yy[q][j].x), bfhi(vv[q][j].x) + bfhi(yy[q][j].x), bflo(vv[q][j].y) + bflo(yy[q][j].y), bfhi(vv[q][j].y) + bfhi(yy[q][j].y)};
                s += (v[j].x * v[j].x + v[j].y * v[j].y) + (v[j].z * v[j].z + v[j].w * v[j].w); }
            const float rinv = 1.0f / sqrtf(wave_sum(s) * (1.0f / D) + RMS_EPS);
#pragma unroll
            for (int j = 0; j < 4; ++j) xo[64 * j] = v[j] * rinv * g[j]; } }
    }
}

constexpr int NPHASE = 15;
__global__ void __launch_bounds__(NTHR, 2) trunk_fwd(Args args) {
    extern __shared__ __attribute__((aligned(16))) unsigned char lds_raw[];
    LAS unsigned char* lds = (LAS unsigned char*)lds_raw;
    volatile LAS unsigned* MISC = (volatile LAS unsigned*)(lds + MISC_OFF);
    const int tid = threadIdx.x, lane = tid & 63, wave = __builtin_amdgcn_readfirstlane(tid >> 6);
    const int G = gridDim.x; const int bx = blockIdx.x; const int vcu = (G % 8 == 0) ? (bx % 8) * (G / 8) + bx / 8 : bx;
    const int gw = vcu * NWAVES + wave, NGW = G * NWAVES;
    unsigned char* ws = args.ws;
    unsigned* ctl = (unsigned*)(ws + WS_CTL);
    if (tid < 256) ((LAS unsigned*)(lds + LDSCTL_OFF))[tid] = 0u;
    __syncthreads();
    XcdBarrier bar; bar.bar = ctl + CW_BAR; bar.x = 0; bar.st = nullptr;
    if (!MK_PER_PHASE) bar = xcd_barrier_post(ctl + CW_BAR, MISC + 8);
    if (!MK_PER_PHASE && tid == 0) __hip_atomic_fetch_or(ctl + CW_XMAP + (bx & 7), 1u << bar.x, __ATOMIC_RELAXED, __HIP_MEMORY_SCOPE_AGENT);
    bool local_ok = false;
    const int lo = args.ph_lo, hi = args.ph_hi;
#define IN(k) (lo <= (k) && (k) < hi)
#ifndef LOCAL_SEAMS
#define LOCAL_SEAMS 0x77au
#endif
#define SEAM(k) do { if (IN(k) && IN((k) + 1)) { if (((LOCAL_SEAMS >> (k)) & 1u) && local_ok) xcd_barrier_local(bar); else xcd_barrier(bar); } } while (0)
#define Hb ((bf16*)(ws + WS_H))
#define MF ((const float*)(ws + WS_MODF))

#ifndef PROBE_DUP
#define PROBE_DUP 0u
#endif
#ifndef PROBE_REP
#define PROBE_REP 1
#endif
#ifndef NOPH_MASK
#define NOPH_MASK 0u
#endif
#define RUN(k, body) do { if (IN(k) && !((NOPH_MASK >> (k)) & 1u)) { body; if ((PROBE_DUP >> (k)) & 1u) { _Pragma("unroll") for (int rep_ = 0; rep_ < PROBE_REP; ++rep_) { xcd_barrier(bar); body; } } } SEAM(k); } while (0)
#define COMMA ,
#define PH_GEMM(EPI, ORD, Aptr, Bptr, Mv, Nv, Kv, ...) do { pg8::Gemm g{Aptr, Bptr, Mv, Nv, Kv}; pg8::StaticOrder S; S.init(Mv, Nv, G, bx); EPI E{__VA_ARGS__}; \
        pg8::gemm_phase<EPI, pg8::StaticOrder, true, true>(lds, g, S, E); } while (0)
#define MOE_GU() do { pg8::MoeOrder S; S.init(ctl + CW_CNT, 2 * FF / 256, G, bx, (const int*)(ws + WS_RT2)); \
        pg8::Gemm g{Hb, (const bf16*)(ws + WS_WMGU), 0, 0, D}; EpiSwiGLU8 E{ws + WS_MHID, 2 * FF / 256}; \
        pg8::gemm_phase<EpiSwiGLU8, pg8::MoeOrder, true, true, true, 1, (MOE_I8 != 0)>(lds, g, S, E, lds + TOKSLOT_OFF); } while (0)
#define ZGp ((const float*)(ws + WS_ZG))
#define MOE_DN() do { pg8::MoeOrderId S; S.init(ctl + CW_CNT, D / 256, G, bx, (const int*)(ws + WS_IDENT), true); \
        LAS float* gt = (LAS float*)(lds + GATE_OFF); for (int i_ = tid; i_ < NB * D; i_ += NTHR) gt[i_] = MF[(size_t)(3 * 4 + (i_ >> 10)) * 3072 + 2048 + (i_ & (D - 1))]; __syncthreads(); \
        pg8::Gemm g{(const bf16*)(ws + WS_MHID), (const bf16*)(ws + WS_WMD), 0, 0, FF}; \
        EpiMoeDown E{XRp, (bf16*)(ws + WS_Y1), (const int*)(ws + WS_RT2), (const float*)(ws + WS_RW2), gt, 1.0f / (F8_SH * F8_SW), lds + RED_OFF}; \
        pg8::gemm_phase<EpiMoeDown, pg8::MoeOrderId, true, true, true, 1>(lds, g, S, E, lds + TOKSLOT_OFF); } while (0)
#define PH_GEMM8(EPI, I8v, Aptr, Bptr, Mv, Nv, Kv, ...) do { pg8::Gemm g{Aptr, Bptr, Mv, Nv, Kv}; pg8::StaticOrder S; S.init(Mv, Nv, G, bx, (const int*)(ws + WS_IDENT)); EPI E{__VA_ARGS__}; \
        pg8::gemm_phase<EPI, pg8::StaticOrder, true, true, true, 1, I8v>(lds, g, S, E, lds + TOKSLOT_OFF); } while (0)
#define SSb ((float*)(ws + WS_SS))
#define BV ((const float*)(ws + WS_BIASV))
    RUN(0, p0_prologue(args, lds, gw, NGW, wave, lane, tid));
    if (!MK_PER_PHASE && LOCAL_SEAMS && IN(0) && IN(1) && G == 256) {
        unsigned all = 0u; bool one = true;
#pragma unroll
        for (int j = 0; j < 8; ++j) { const unsigned m = xb_ld(ctl + CW_XMAP + j); one = one && (__builtin_popcount(m) == 1); all |= m; }
        local_ok = one && (__builtin_popcount(all) == 8) && (MISC[8] == 32u);
    }
    RUN(1, (norm_phase<true, false, false, (CONVIN_I8 != 0)>(args, args.x, 0, lds, G, wave, lane, tid)));
#if CONVIN_I8
    RUN(2, PH_GEMM8(EpiConvInT<true>, true, Hb, (const bf16*)(ws + WS_WCIN), M, 3072, D, (bf16*)(ws + WS_V), (bf16*)(ws + WS_BG)));
#else
    RUN(2, PH_GEMM(EpiConvIn, 0, Hb, (const bf16*)(ws + WS_WCIN), M, 3072, D, (bf16*)(ws + WS_V), (bf16*)(ws + WS_BG)));
#endif
#ifdef PROBE_NULLGEMM_K
    if (IN(2)) { xcd_barrier(bar); PH_GEMM(EpiNull, 0, Hb, (const bf16*)(ws + WS_WCIN), M, PROBE_NULLGEMM_N, PROBE_NULLGEMM_K); xcd_barrier(bar); }
#endif
    RUN(3, conv_phase(args, G, tid));
#define XRp ((bf16*)(ws + WS_XR))
#define XB4p ((bf16*)args.out)
#if WOUT_FP8
    RUN(4, PH_GEMM8(EpiResidB<false COMMA true COMMA (DENSE_GU_FP8 != 0)>, false, Hb, (const bf16*)(ws + WS_WCOUT), M, D, D, XRp, XRp, MF + 0 * 4 * 3072 + 2048, XB4p, SSb, MF + 1 * 4 * 3072 + 1024, args.norm_g + 1 * D, (LAS float*)(lds + RED_OFF), 1.0f / (F8_SH * F8_SW)));
#else
    RUN(4, PH_GEMM(EpiResidB<false COMMA true COMMA (DENSE_GU_FP8 != 0)>, 0, Hb, (const bf16*)(ws + WS_WCOUT), M, D, D, XRp, XRp, MF + 0 * 4 * 3072 + 2048, XB4p, SSb, MF + 1 * 4 * 3072 + 1024, args.norm_g + 1 * D, (LAS float*)(lds + RED_OFF), 1.0f));
#endif
#if DENSE_GU_FP8
    RUN(5, PH_GEMM8(EpiSwiGLU<true COMMA true COMMA (DENSE_DOWN_FP8 != 0)>, (GU_I8 != 0), XB4p, (const bf16*)(ws + WS_WFGU), M, 2 * FF, D, (bf16*)(ws + WS_HID), 2 * FF / 256, SSb, BV, lds + GATE_OFF));
#else
    RUN(5, PH_GEMM(EpiSwiGLU<true COMMA false COMMA (DENSE_DOWN_FP8 != 0)>, 0, XB4p, (const bf16*)(ws + WS_WFGU), M, 2 * FF, D, (bf16*)(ws + WS_HID), 2 * FF / 256, SSb, BV, lds + GATE_OFF));
#endif
#if DENSE_DOWN_FP8
    RUN(6, PH_GEMM8(EpiResidB<false COMMA true COMMA (QKV_I8 != 0)>, false, (const bf16*)(ws + WS_HID), (const bf16*)(ws + WS_WFD), M, D, FF, XRp, XRp, MF + 1 * 4 * 3072 + 2048, Hb, SSb, MF + 2 * 4 * 3072 + 1024, args.norm_g + 2 * D, (LAS float*)(lds + RED_OFF), 1.0f / (F8_SH * F8_SW)));
#else
    RUN(6, PH_GEMM(EpiResidB<false COMMA true>, 0, (const bf16*)(ws + WS_HID), (const bf16*)(ws + WS_WFD), M, D, FF, XRp, XRp, MF + 1 * 4 * 3072 + 2048, Hb, SSb, MF + 2 * 4 * 3072 + 1024, args.norm_g + 2 * D, (LAS float*)(lds + RED_OFF), 1.0f));
#endif
#if QKV_I8
    RUN(7, PH_GEMM8(EpiQkvRopeT<true>, true, Hb, (const bf16*)(ws + WS_WQKV), M, QKVP, D, (bf16*)(ws + WS_QKV), (const unsigned*)(ws + WS_ROPE), SSb, BV + 4 * 2 * FF, lds + GATE_OFF));
#else
    RUN(7, PH_GEMM(EpiQkvRope, 0, Hb, (const bf16*)(ws + WS_WQKV), M, QKVP, D, (bf16*)(ws + WS_QKV), (const unsigned*)(ws + WS_ROPE), SSb, BV + 4 * 2 * FF, lds + GATE_OFF));
#endif
#if ATTN_ONE_PASS
    RUN(8, attn_one(args, lds, gw, NGW, wave, lane));
    RUN(9, attn_fix(args, G, wave, lane));
#else
    RUN(8, attn_mfma<0>(args, lds, gw, NGW, wave, lane));
    RUN(9, attn_mfma<1>(args, lds, gw, NGW, wave, lane));
#endif
#if WO_FP8
    RUN(10, PH_GEMM8(EpiResidB<false COMMA false>, false, Hb, (const bf16*)(ws + WS_WO), M, D, D, XRp, XRp, MF + 2 * 4 * 3072 + 2048, nullptr, nullptr, nullptr, nullptr, nullptr, 1.0f / (F8_SO * F8_SW)));
#else
    RUN(10, PH_GEMM(EpiResidB<false COMMA false>, 0, Hb, (const bf16*)(ws + WS_WO), M, D, D, XRp, XRp, MF + 2 * 4 * 3072 + 2048, nullptr, nullptr, nullptr, nullptr, nullptr, 1.0f));
#endif
    RUN(11, (norm_phase<false, true, true>(args, XRp, 3, lds, G, wave, lane, tid)));
    RUN(12, MOE_GU());
    RUN(13, MOE_DN());
    RUN(14, final_norm_phase(args, gw, NGW, lane));
#ifdef PROBE_XBAR
    for (int q = 0; q < PROBE_XBAR; ++q) xcd_barrier(bar);
#endif
#undef IN
#undef SEAM
}

extern "C" void kernel_launch(void* const* d_in, const int* in_sizes, int n_in, void* d_out, int out_size, void* d_ws, size_t ws_size, hipStream_t stream) {
    static int grid = 0;
    if (grid == 0) {
        if (n_in != 19 || out_size != M * D || ws_size < WS_END) { fprintf(stderr, "kernel_launch: unexpected shapes (n_in %d out %d ws %zu)\n", n_in, out_size, ws_size); grid = -1; return; }
        int dev = 0, cus = 0, per_cu = 0;
        if (hipGetDevice(&dev) != hipSuccess || hipDeviceGetAttribute(&cus, hipDeviceAttributeMultiprocessorCount, dev) != hipSuccess) { grid = -1; return; }
        if (hipFuncSetAttribute((const void*)trunk_fwd, hipFuncAttributeMaxDynamicSharedMemorySize, LDS_BYTES) != hipSuccess) { fprintf(stderr, "kernel_launch: hipFuncSetAttribute failed\n"); grid = -1; return; }
        if (hipOccupancyMaxActiveBlocksPerMultiprocessor(&per_cu, (const void*)trunk_fwd, NTHR, LDS_BYTES) != hipSuccess || per_cu < 1) fprintf(stderr, "kernel_launch: occupancy query reports %d\n", per_cu);
        (void)hipGetLastError();
        grid = cus;
    }
    if (grid < 0) return;
    (void)hipMemsetAsync((char*)d_ws + WS_CTL, 0, CTL_ZERO_BYTES, stream);
    Args a{};
    a.x = (const float*)d_in[0]; a.c = (const float*)d_in[1]; a.pos = (const int*)d_in[2]; a.mod_w = (const float*)d_in[3]; a.mod_b = (const float*)d_in[4]; a.norm_g = (const float*)d_in[5];
    a.conv_w_in = (const float*)d_in[6]; a.conv_w = (const float*)d_in[7]; a.conv_w_out = (const float*)d_in[8]; a.ffn_g = (const float*)d_in[9]; a.ffn_u = (const float*)d_in[10]; a.ffn_d = (const float*)d_in[11];
    a.w_qkv = (const float*)d_in[12]; a.w_o = (const float*)d_in[13]; a.router_w = (const float*)d_in[14]; a.moe_g = (const float*)d_in[15]; a.moe_u = (const float*)d_in[16]; a.moe_d = (const float*)d_in[17]; a.final_g = (const float*)d_in[18];
    a.out = (float*)d_out; a.ws = (unsigned char*)d_ws;
#if MK_PER_PHASE
    for (int p = 0; p < NPHASE; ++p) { a.ph_lo = p; a.ph_hi = p + 1; hipLaunchKernelGGL(trunk_fwd, dim3(grid), dim3(NTHR), LDS_BYTES, stream, a); }
#else
    a.ph_lo = 0; a.ph_hi = NPHASE; hipLaunchKernelGGL(trunk_fwd, dim3(grid), dim3(NTHR), LDS_BYTES, stream, a);
#endif
}
```

```cpp
#include <hip/hip_runtime.h>
#include <cstdio>
#include <cstdint>

#ifndef DENSE_GU_FP8
#define DENSE_GU_FP8 1
#endif
#ifndef ATTN_ONE_PASS
#define ATTN_ONE_PASS 1
#endif
#ifndef DN_SPLIT_TAIL
#define DN_SPLIT_TAIL 1
#endif
#ifndef P0_NT
#define P0_NT 1
#endif
#ifndef QKV_F8
#define QKV_F8 1
#endif
#ifndef QK_F8MMA
#define QK_F8MMA 1
#endif
#ifndef QK_PERM
#define QK_PERM 1
#endif
#ifndef MOE_I8
#define MOE_I8 0
#endif
#ifndef GU_I8
#define GU_I8 1
#endif
#ifndef CONVIN_I8
#define CONVIN_I8 1
#endif
#ifndef QKV_I8
#define QKV_I8 1
#endif
#ifndef WO_FP8
#define WO_FP8 1
#endif
#ifndef WOUT_FP8
#define WOUT_FP8 0
#endif
#ifndef DENSE_DOWN_FP8
#define DENSE_DOWN_FP8 1
#endif
#ifndef MK_PER_PHASE
#define MK_PER_PHASE 0
#endif

namespace pg8 {
#define PG8_LAS __attribute__((address_space(3)))
typedef unsigned short bf16_t;
typedef short bf16x8 __attribute__((ext_vector_type(8)));
typedef float f32x4 __attribute__((ext_vector_type(4)));
typedef unsigned u32x4 __attribute__((ext_vector_type(4)));
constexpr int BM = 256, BK = 64, HALF = 128, HTB = HALF * BK * 2, STAGE_BYTES = 8 * HTB, NXCD = 8, WGM = 8;

__host__ __device__ __forceinline__ int lds_byte(int r, int c) { const int st = (r >> 4) * 2 + (c >> 5), rr = r & 15, cc = c & 31, ob = rr * 64 + cc * 2; return st * 1024 + (ob ^ (((ob >> 9) & 1) << 5)); }
__host__ __device__ __forceinline__ void stage_rc(int b, int& R, int& C) { const int st = b / 1024, sb = b % 1024, swz = sb ^ (((sb >> 9) & 1) << 5); R = (st >> 1) * 16 + swz / 64; C = (st & 1) * 32 + (swz % 64) / 2; }
__host__ __device__ __forceinline__ int perm32(int rho) { const int n = rho >> 4, i = rho & 15; return 8 * (i >> 2) + 4 * n + (i & 3); }

struct Unit { int pm, pn, k, nv, g, sp, ro; };
struct Gemm { const bf16_t* A; const bf16_t* Bt; int M, N, K; };

struct StaticOrder {
    static constexpr bool IDROWS = true;
    int nM, nN, nwg, G, c; const int* ident;
    __host__ __device__ void init(int M, int N, int G_, int c_, const int* id = nullptr) { nM = M / BM; nN = N / BM; nwg = nM * nN; G = G_; c = c_; ident = id; }
    __host__ __device__ bool next(int i, Unit& u) const {
        const long L = (long)i * G + c; if (L >= nwg) return false;
        int wgid = (int)L; { const int q = nwg / NXCD, r = nwg % NXCD, xcd = wgid % NXCD, off = wgid / NXCD; wgid = (xcd < r ? xcd * (q + 1) : r * (q + 1) + (xcd - r) * q) + off; }
        const int nig = WGM * nN, gid = wgid / nig, fm = gid * WGM, gsz = (nM - fm) < WGM ? (nM - fm) : WGM;
        u.pm = fm + ((wgid % nig) % gsz); u.pn = (wgid % nig) / gsz; u.nv = 256; u.ro = 0; return true;
    }
    __device__ __forceinline__ const int* tokens(const Unit& u) const { return ident + 256 * u.pm; }
    __device__ __forceinline__ void a_ready(const Unit&) const {}
    __device__ __forceinline__ void done(const Unit&) const {}
};
struct RepeatOrder : StaticOrder { int nrep;
    __host__ __device__ bool next(int i, Unit& u) const { if (i >= nrep) return false; return StaticOrder::next(0, u); } };
template <bool IDENT> struct MoeOrderT {
    static constexpr bool IDROWS = IDENT;
    int nM, nN, nwg, G, c; int nt[16]; const int* rowtok; bool ident;
    static constexpr int MTOK = 32768;
    __device__ __forceinline__ void init(unsigned* cnt, int nN_, int G_, int c_, const int* rt, bool ident_ = false) {
        ident = ident_;
        int b = 0;
#pragma unroll
        for (int q = 0; q < 16; ++q) { const int ne = __builtin_amdgcn_readfirstlane((int)__hip_atomic_load(cnt + q, __ATOMIC_RELAXED, __HIP_MEMORY_SCOPE_AGENT)); nt[q] = ne | (b << 16); b += (ne + 255) >> 8; }
        nM = b; nN = nN_; nwg = nM * nN; G = G_; c = c_; rowtok = rt;
    }
    __device__ __forceinline__ bool next(int i, Unit& u) const {
        long L = (long)i * G + c; int half = -1;
        if (IDENT && DN_SPLIT_TAIL) {
            const int R = nwg / G, rem = nwg - R * G;
            if (i >= R) { const long t = (long)(i - R) * G + c; if (t >= 2 * rem) return false; L = (long)R * G + (t >> 1); half = (int)(t & 1); }
        } else if (L >= nwg) return false;
        int wgid = (int)L; { const int q = nwg / NXCD, r = nwg % NXCD, xcd = wgid % NXCD, off = wgid / NXCD; wgid = (xcd < r ? xcd * (q + 1) : r * (q + 1) + (xcd - r) * q) + off; }
        const int nig = WGM * nN, gid = wgid / nig, fm = gid * WGM, gsz = (nM - fm) < WGM ? (nM - fm) : WGM;
        const int pm = fm + ((wgid % nig) % gsz), pn = (wgid % nig) / gsz;
        int q0 = 0, sel = nt[0];
#pragma unroll
        for (int q = 1; q < 16; ++q) if (pm >= (nt[q] >> 16)) { q0 = q; sel = nt[q]; }
        u.pm = pm; u.pn = (q0 & 7) * nN + pn; u.g = q0; u.k = pm - (sel >> 16); const int rem = (sel & 0xffff) - 256 * u.k; u.nv = rem < 256 ? rem : 256; u.ro = 0;
        if (half >= 0) { u.ro = 128 * half; const int nvh = u.nv - u.ro; u.nv = nvh < 0 ? 0 : (nvh > 128 ? 128 : nvh); }
        return true;
    }
    __device__ __forceinline__ const int* tokens(const Unit& u) const { return ident ? rowtok + 256 * u.pm : rowtok + (size_t)u.g * MTOK + 256 * u.k; }
    __device__ __forceinline__ void a_ready(const Unit&) const {}
    __device__ __forceinline__ void done(const Unit&) const {}
};
typedef MoeOrderT<false> MoeOrder; typedef MoeOrderT<true> MoeOrderId;

typedef int v8i_t __attribute__((ext_vector_type(8)));
typedef int v4i_t __attribute__((ext_vector_type(4)));
__device__ __forceinline__ v8i_t cat8(bf16x8 a, bf16x8 b) { const v4i_t x = __builtin_bit_cast(v4i_t, a), y = __builtin_bit_cast(v4i_t, b); return __builtin_shufflevector(x, y, 0, 1, 2, 3, 4, 5, 6, 7); }
__device__ __forceinline__ unsigned cvt_pk_bf16(float lo, float hi) { unsigned r; asm volatile("v_cvt_pk_bf16_f32 %0, %1, %2" : "=v"(r) : "v"(lo), "v"(hi)); return r; }

template <class Epi, class Sched, bool ALIGN_EPI = false, bool SP2 = false, bool GATHER = false, int ES = 2, bool I8 = false>
__device__ __forceinline__ void gemm_phase(PG8_LAS unsigned char* lds, const Gemm g, const Sched& S, const Epi& E, PG8_LAS unsigned char* tokslots = nullptr) {
    const int tid = threadIdx.x, wid = __builtin_amdgcn_readfirstlane(tid >> 6), lane = tid & 63, wr = wid >> 2, wc = wid & 3, fr = lane & 15, fq = lane >> 4;
    const int K = g.K, KB = K * ES  , nt = KB / (BK * 2);
    static_assert(!GATHER || SP2, "the gathering A path is written for the SP2 loop only");
    unsigned voffA[2], voffB[2];
#pragma unroll
    for (int i = 0; i < 2; ++i) { int R, C; stage_rc(tid * 16 + i * 8192, R, C); const int Rb = Epi::PERM ? ((R & ~31) + perm32(R & 31)) : R;
        voffA[i] = (unsigned)(R * KB + C * 2); voffB[i] = (unsigned)(Rb * KB + C * 2); }
    unsigned gcur[2][2] = {{0u, 0u}, {0u, 0u}};
    const size_t kstep = (size_t)(BK * 2);
    const size_t hstep = (size_t)HALF * KB;
    const size_t tstep = 2 * hstep;
    const unsigned ldsw = (unsigned)wid * 1024u;
    const int aoff = lds_byte(wr * 64 + fr, fq * 8), boff = lds_byte(wc * 32 + fr, fq * 8);
#define PG8_SA(b, h) (((b) * 2 + (h)) * HTB)
#define PG8_SB(b, h) ((4 + (b) * 2 + (h)) * HTB)
#define PG8_STAGE(bufoff, gbase, voff) do { _Pragma("unroll") for (int _i = 0; _i < 2; ++_i) \
        __builtin_amdgcn_global_load_lds((const unsigned*)((const char*)(gbase) + (voff)[_i]), (PG8_LAS unsigned*)(lds + (bufoff) + ldsw + _i * 8192), 16, 0, 0); } while (0)
#define PG8_STAGE_A(bufoff, kptr, half, ofs) do { if constexpr (GATHER) { _Pragma("unroll") for (int _i = 0; _i < 2; ++_i) \
        __builtin_amdgcn_global_load_lds((const unsigned*)((const char*)(kptr) + (ofs)[half][_i]), (PG8_LAS unsigned*)(lds + (bufoff) + ldsw + _i * 8192), 16, 0, 0); } \
        else { PG8_STAGE(bufoff, (const char*)(kptr) + (half) * hstep, voffA); } } while (0)
#define PG8_LDA(dst, b, h) do { _Pragma("unroll") for (int m = 0; m < 4; ++m) _Pragma("unroll") for (int k = 0; k < 2; ++k) dst[m][k] = *(const PG8_LAS bf16x8*)(lds + PG8_SA(b, h) + aoff + m * 2048 + k * 1024); } while (0)
#define PG8_LDB(dst, b, h) do { _Pragma("unroll") for (int n = 0; n < 2; ++n) _Pragma("unroll") for (int k = 0; k < 2; ++k) dst[n][k] = *(const PG8_LAS bf16x8*)(lds + PG8_SB(b, h) + boff + n * 2048 + k * 1024); } while (0)
#define PG8_MMA(ai, bj, At, Bt) do { __builtin_amdgcn_s_setprio(1); _Pragma("unroll") for (int m = 0; m < 4; ++m) _Pragma("unroll") for (int n = 0; n < 2; ++n) { \
        if constexpr (ES == 2) { _Pragma("unroll") for (int k = 0; k < 2; ++k) acc[ai][bj][m][n] = __builtin_amdgcn_mfma_f32_16x16x32_bf16(Bt[n][k], At[m][k], acc[ai][bj][m][n], 0, 0, 0); } \
        else if constexpr (I8) { _Pragma("unroll") for (int k = 0; k < 2; ++k) acc[ai][bj][m][n] = __builtin_bit_cast(f32x4, __builtin_amdgcn_mfma_i32_16x16x64_i8(__builtin_bit_cast(v4i_t, Bt[n][k]), __builtin_bit_cast(v4i_t, At[m][k]), __builtin_bit_cast(v4i_t, acc[ai][bj][m][n]), 0, 0, 0)); } \
        else { acc[ai][bj][m][n] = __builtin_amdgcn_mfma_scale_f32_16x16x128_f8f6f4(cat8(Bt[n][0], Bt[n][1]), cat8(At[m][0], At[m][1]), acc[ai][bj][m][n], 0, 0, 0, 0x7f7f7f7f, 0, 0x7f7f7f7f); } } \
        __builtin_amdgcn_s_setprio(0); } while (0)
#define PG8_WAIT_V(n) asm volatile("s_waitcnt vmcnt(" #n ")" ::: "memory")
#define PG8_WAIT_L(n) asm volatile("s_waitcnt lgkmcnt(" #n ")" ::: "memory")
#define PG8_BAR __builtin_amdgcn_s_barrier()
#define PG8_SCHED __builtin_amdgcn_sched_barrier(0)
    Unit cur, nxt; int ui = 0;
    if (!S.next(0, cur)) return;
    f32x4 acc[2][2][4][2];
#pragma unroll
    for (int a = 0; a < 2; ++a)
#pragma unroll
        for (int b = 0; b < 2; ++b)
#pragma unroll
            for (int m = 0; m < 4; ++m)
#pragma unroll
                for (int n = 0; n < 2; ++n) acc[a][b][m][n] = (f32x4){0.f, 0.f, 0.f, 0.f};
    bf16x8 At[4][2], B0[2][2], B1[2][2];
    const char* cA = GATHER ? (const char*)g.A : (const char*)g.A + (size_t)cur.pm * tstep; const char* cB = (const char*)g.Bt + (size_t)cur.pn * tstep;
    if constexpr (GATHER) { const int* tk = S.tokens(cur);
#pragma unroll
        for (int h = 0; h < 2; ++h)
#pragma unroll
            for (int i = 0; i < 2; ++i) { int R, C; stage_rc(tid * 16 + i * 8192, R, C); const int rl = h * HALF + R; int tok;
                if constexpr (Sched::IDROWS) tok = rl < cur.nv ? 256 * cur.pm + cur.ro + rl : 0; else tok = rl < cur.nv ? tk[rl] : 0;
                gcur[h][i] = (unsigned)tok * (unsigned)KB + (unsigned)C * 2u; } }
    S.a_ready(cur);
    if constexpr (SP2) {
        PG8_STAGE(PG8_SB(0, 0), cB, voffB); PG8_STAGE(PG8_SB(0, 1), cB + hstep, voffB); PG8_STAGE_A(PG8_SA(0, 0), cA, 0, gcur); PG8_STAGE_A(PG8_SA(0, 1), cA, 1, gcur);
        PG8_STAGE(PG8_SB(1, 0), cB + kstep, voffB); PG8_STAGE_A(PG8_SA(1, 0), cA + kstep, 0, gcur); PG8_STAGE(PG8_SB(1, 1), cB + hstep + kstep, voffB);
        if (wr == 1) PG8_BAR;
        PG8_WAIT_V(8); PG8_BAR;
        PG8_WAIT_V(6); PG8_BAR;
    } else {
        PG8_STAGE(PG8_SB(0, 0), cB, voffB); PG8_STAGE_A(PG8_SA(0, 0), cA, 0, gcur); PG8_STAGE(PG8_SB(0, 1), cB + hstep, voffB); PG8_STAGE_A(PG8_SA(0, 1), cA, 1, gcur);
        if (wr == 1) PG8_BAR;
        PG8_WAIT_V(4); PG8_BAR;
        PG8_STAGE(PG8_SB(1, 0), cB + kstep, voffB); PG8_STAGE_A(PG8_SA(1, 0), cA + kstep, 0, gcur); PG8_STAGE(PG8_SB(1, 1), cB + hstep + kstep, voffB);
        PG8_WAIT_V(6); PG8_BAR;
    }
    for (;;) {
        cur.sp = ui & 1;
        if constexpr (Epi::SIDE) E.side_issue(cur, wid, lane);
        const bool has_next = S.next(ui + 1, nxt);
        const char* nA = GATHER ? cA : (has_next ? (const char*)g.A + (size_t)nxt.pm * tstep : cA); const char* nB = has_next ? (const char*)g.Bt + (size_t)nxt.pn * tstep : cB;
        if constexpr (GATHER && !Sched::IDROWS) { if (has_next && wid < 4)
            __builtin_amdgcn_global_load_lds((const unsigned*)(S.tokens(nxt) + wid * 64 + lane), (PG8_LAS unsigned*)(tokslots + ((ui + 1) & 1) * 1024 + wid * 256), 4, 0, 0); }
#pragma unroll 1
        for (int t = 0; t < nt; t += 2) {
            const bool last = (t == nt - 2);
            const char* a1 = cA + (size_t)(t + 1) * kstep;
            const char* a2 = last ? nA : cA + (size_t)(t + 2) * kstep; const char* b2 = last ? nB : cB + (size_t)(t + 2) * kstep;
            const char* a3 = a2 + kstep; const char* b3 = b2 + kstep;
            if (last && has_next) S.a_ready(nxt);
            if constexpr (SP2) {
            PG8_LDB(B0, 0, 0); PG8_LDB(B1, 0, 1); PG8_SCHED; PG8_LDA(At, 0, 0); PG8_STAGE_A(PG8_SA(1, 1), a1, 1, gcur);
            if constexpr (GATHER) { if (last && has_next) {
#pragma unroll
                for (int h = 0; h < 2; ++h)
#pragma unroll
                    for (int i = 0; i < 2; ++i) { int R, C; stage_rc(tid * 16 + i * 8192, R, C); const int rl = h * HALF + R; int tok; if constexpr (Sched::IDROWS) tok = 256 * nxt.pm + nxt.ro + rl; else tok = *(const PG8_LAS int*)(tokslots + ((ui + 1) & 1) * 1024 + rl * 4);
                        gcur[h][i] = (unsigned)(rl < nxt.nv ? tok : 0) * (unsigned)KB + (unsigned)C * 2u; } } }
            PG8_WAIT_V(8); PG8_WAIT_L(0); PG8_BAR; PG8_MMA(0, 0, At, B0); PG8_MMA(0, 1, At, B1); PG8_BAR; PG8_SCHED;
            PG8_LDA(At, 0, 1); PG8_STAGE(PG8_SB(0, 0), b2, voffB); PG8_STAGE(PG8_SB(0, 1), b2 + hstep, voffB); PG8_STAGE_A(PG8_SA(0, 0), a2, 0, gcur);
            PG8_WAIT_V(8); PG8_WAIT_L(0); PG8_BAR; PG8_MMA(1, 0, At, B0); PG8_MMA(1, 1, At, B1); PG8_BAR; PG8_SCHED;
            PG8_LDB(B0, 1, 0); PG8_LDB(B1, 1, 1); PG8_SCHED; PG8_LDA(At, 1, 0); PG8_STAGE_A(PG8_SA(0, 1), a2, 1, gcur);
            PG8_WAIT_V(8); PG8_WAIT_L(0); PG8_BAR; PG8_MMA(0, 0, At, B0); PG8_MMA(0, 1, At, B1); PG8_BAR; PG8_SCHED;
            PG8_LDA(At, 1, 1); PG8_STAGE(PG8_SB(1, 0), b3, voffB); PG8_STAGE(PG8_SB(1, 1), b3 + hstep, voffB); PG8_STAGE_A(PG8_SA(1, 0), a3, 0, gcur);
            PG8_WAIT_V(8); PG8_WAIT_L(0); PG8_BAR; PG8_MMA(1, 0, At, B0); PG8_MMA(1, 1, At, B1); PG8_BAR; PG8_SCHED;
            } else {
            PG8_LDB(B0, 0, 0); PG8_SCHED; PG8_LDA(At, 0, 0); PG8_STAGE_A(PG8_SA(1, 1), a1, 1, gcur);
            PG8_WAIT_L(8); PG8_BAR; PG8_WAIT_L(0); PG8_MMA(0, 0, At, B0); PG8_BAR; PG8_SCHED;
            PG8_LDB(B1, 0, 1); PG8_STAGE(PG8_SB(0, 0), b2, voffB);
            PG8_BAR; PG8_WAIT_L(0); PG8_MMA(0, 1, At, B1); PG8_BAR;
            PG8_LDA(At, 0, 1); PG8_STAGE_A(PG8_SA(0, 0), a2, 0, gcur);
            PG8_BAR; PG8_WAIT_L(0); PG8_MMA(1, 0, At, B0); PG8_BAR; PG8_SCHED;
            PG8_STAGE(PG8_SB(0, 1), b2 + hstep, voffB);
            PG8_WAIT_V(6); PG8_BAR; PG8_MMA(1, 1, At, B1); PG8_BAR;
            PG8_LDB(B0, 1, 0); PG8_SCHED; PG8_LDA(At, 1, 0); PG8_STAGE_A(PG8_SA(0, 1), a2, 1, gcur);
            PG8_WAIT_L(8); PG8_BAR; PG8_WAIT_L(0); PG8_MMA(0, 0, At, B0); PG8_BAR; PG8_SCHED;
            PG8_LDB(B1, 1, 1); PG8_STAGE(PG8_SB(1, 0), b3, voffB);
            PG8_BAR; PG8_WAIT_L(0); PG8_MMA(0, 1, At, B1); PG8_BAR;
            PG8_LDA(At, 1, 1); PG8_STAGE_A(PG8_SA(1, 0), a3, 0, gcur);
            PG8_BAR; PG8_WAIT_L(0); PG8_MMA(1, 0, At, B0); PG8_BAR; PG8_SCHED;
            PG8_STAGE(PG8_SB(1, 1), b3 + hstep, voffB);
            PG8_WAIT_V(6); PG8_BAR; PG8_MMA(1, 1, At, B1); PG8_BAR;
            }
        }
        if constexpr (ALIGN_EPI) { if (wr == 0) PG8_BAR; }
        E(acc, cur, wr, wc, fr, fq); S.done(cur);
        if (!has_next) break;
#pragma unroll
        for (int a = 0; a < 2; ++a)
#pragma unroll
            for (int b = 0; b < 2; ++b)
#pragma unroll
                for (int m = 0; m < 4; ++m)
#pragma unroll
                    for (int n = 0; n < 2; ++n) acc[a][b][m][n] = (f32x4){0.f, 0.f, 0.f, 0.f};
        cur = nxt; cA = nA; cB = nB; ++ui;

        if constexpr (ALIGN_EPI) { if (wr == 1) PG8_BAR; }
    }
    PG8_WAIT_V(0);
    if constexpr (!ALIGN_EPI) { if (wr == 0) PG8_BAR; }
    PG8_BAR;
#undef PG8_SA
#undef PG8_SB
#undef PG8_STAGE
#undef PG8_STAGE_A
#undef PG8_LDA
#undef PG8_LDB
#undef PG8_MMA
#undef PG8_WAIT_V
#undef PG8_WAIT_L
#undef PG8_BAR
#undef PG8_SCHED
}
}

constexpr int NWAVES = 8, NTHR = NWAVES * 64;
constexpr int NB = 4, SEQ = 8192, D = 1024, M = NB * SEQ;
constexpr int FF = 2816, NE = 8;
constexpr int NH = 15, NHQKV = 45, QKVP = 3072;
constexpr int RPAD = M + NE * 256;
constexpr int NCHUNK = M / 128;
constexpr float RMS_EPS = 1e-6f;
constexpr float I8_SA = 127.f / 8.f, I8_SW = 127.f * 32.f / 5.f;
constexpr float GU_SA = GU_I8 ? I8_SA : 16.f, GU_SW = GU_I8 ? I8_SW : 128.f;
constexpr float MOE_SA = MOE_I8 ? I8_SA : 16.f, MOE_SW = MOE_I8 ? I8_SW : 128.f;
constexpr float F8_SQKV = 16.f;
constexpr float F8_SO = 32.f;
constexpr float F8_SA = 16.f, F8_SW = 128.f, F8_SH = 8.f;
constexpr float C2 = 0.125f * 1.4426950408889634f;

constexpr size_t MiB = 1u << 20;
constexpr size_t WS_CTL = 0, CTL_ZERO_BYTES = 64 * 1024;
constexpr size_t WS_MODP = 1 * MiB;
constexpr size_t WS_MODF = 3 * MiB;
constexpr size_t WS_IDENT = 4 * MiB + 512 * 1024;
constexpr size_t WS_ZG = WS_MODF + 256 * 1024;
constexpr size_t WS_RSC = 3 * MiB + 512 * 1024;
constexpr size_t WS_SS = 4 * MiB;
constexpr size_t WS_BIASV = 5 * MiB;
constexpr size_t WS_XR = 448 * MiB;
constexpr size_t WS_ROPE = 6 * MiB;
constexpr size_t WS_LSE = 14 * MiB;
constexpr size_t WS_WCIN = 16 * MiB, WS_WCOUT = 22 * MiB, WS_WFGU = 24 * MiB, WS_WFD = 35 * MiB, WS_WQKV = 41 * MiB, WS_WO = 47 * MiB, WS_WMGU = 49 * MiB, WS_WMD = 137 * MiB;
constexpr size_t WS_H = 181 * MiB;
constexpr size_t WS_BIG = 245 * MiB;
constexpr size_t WS_BG = WS_BIG, WS_V = WS_BIG + 64 * MiB;
constexpr size_t WS_HID = WS_BIG;
constexpr size_t WS_QKV = WS_BIG;
constexpr size_t WS_RT2 = 10 * MiB, WS_RW2 = 12 * MiB;
constexpr size_t WS_MHID = WS_BIG;
constexpr size_t WS_Y1 = WS_H;
constexpr size_t WS_END = 512 * MiB;
static_assert(WS_MHID + (size_t)2 * RPAD * FF <= WS_XR && WS_QKV + (size_t)M * QKVP * 2 <= WS_XR && WS_HID + (size_t)M * FF * 2 <= WS_XR && WS_XR + (size_t)M * D * 2 <= WS_END, "d_ws map");
static_assert(WS_WMD + (size_t)NE * D * FF * 2 <= WS_H && WS_H + (size_t)M * D * 2 <= WS_BIG, "d_ws map 2");
constexpr int CW_XMAP = 8320;
constexpr int CW_CNT = 8192;
constexpr int CW_BAR = 4096;

constexpr int RING_BYTES = 131072;
constexpr int LDSCTL_OFF = RING_BYTES, MISC_OFF = LDSCTL_OFF + 320;
constexpr int RED_OFF = LDSCTL_OFF + 4096;
constexpr int TOKSLOT_OFF = LDSCTL_OFF + 1024;
constexpr int GATE_OFF = LDSCTL_OFF + 8192;
constexpr int LDS_BYTES = 155648;

#define GAS __attribute__((address_space(1)))
#define LAS __attribute__((address_space(3)))
typedef unsigned short bf16;
typedef unsigned v4u __attribute__((ext_vector_type(4)));
typedef unsigned v2u __attribute__((ext_vector_type(2)));
typedef float f32x4 __attribute__((ext_vector_type(4)));
#define LDS_WAIT() asm volatile("s_waitcnt lgkmcnt(0)" ::: "memory")
__device__ __forceinline__ unsigned f2bf(float f) { unsigned u = __builtin_bit_cast(unsigned, f); return (u + 0x7fffu + ((u >> 16) & 1u)) >> 16; }
__device__ __forceinline__ unsigned pk2(float lo, float hi) { return f2bf(lo) | (f2bf(hi) << 16); }
__device__ __forceinline__ float bflo(unsigned u) { return __builtin_bit_cast(float, u << 16); }
__device__ __forceinline__ float bfhi(unsigned u) { return __builtin_bit_cast(float, u & 0xffff0000u); }

__device__ __forceinline__ unsigned pk_fp8x4(f32x4 v) {
    const float a = __builtin_amdgcn_fmed3f(v.x, -448.f, 448.f), b = __builtin_amdgcn_fmed3f(v.y, -448.f, 448.f), c = __builtin_amdgcn_fmed3f(v.z, -448.f, 448.f), d = __builtin_amdgcn_fmed3f(v.w, -448.f, 448.f);
    int p = __builtin_amdgcn_cvt_pk_fp8_f32(a, b, 0, false); p = __builtin_amdgcn_cvt_pk_fp8_f32(c, d, p, true); return (unsigned)p; }
__device__ __forceinline__ unsigned pk_i8x4(f32x4 v) {
    const float mg = 12582912.0f;
    const unsigned a = __builtin_bit_cast(unsigned, __builtin_amdgcn_fmed3f(v.x, -127.f, 127.f) + mg), b = __builtin_bit_cast(unsigned, __builtin_amdgcn_fmed3f(v.y, -127.f, 127.f) + mg);
    const unsigned c = __builtin_bit_cast(unsigned, __builtin_amdgcn_fmed3f(v.z, -127.f, 127.f) + mg), d = __builtin_bit_cast(unsigned, __builtin_amdgcn_fmed3f(v.w, -127.f, 127.f) + mg);
    return __builtin_amdgcn_perm(__builtin_amdgcn_perm(d, c, 0x0c0c0400u), __builtin_amdgcn_perm(b, a, 0x0c0c0400u), 0x05040100u); }
__device__ __forceinline__ unsigned pk_q8x4(f32x4 v) { return GU_I8 ? pk_i8x4(v) : pk_fp8x4(v); }
#define XB_TMO      128
#define XB_XCNT(j)  (256  + 64 * (j))
#define XB_XSUB(j)  (1280 + 64 * (j))
#define XB_XGEN(j)  (2304 + 64 * (j))
#define XB_TOP      3328
#define XB_TOPGEN   3392
#define XCD_BAR_WORDS 3456
#define XB_SPIN_CAP (1u << 18)
__device__ __forceinline__ unsigned xb_ld(unsigned* p)              { return __hip_atomic_load(p, __ATOMIC_RELAXED, __HIP_MEMORY_SCOPE_AGENT); }
__device__ __forceinline__ unsigned xb_add(unsigned* p, unsigned v) { return __hip_atomic_fetch_add(p, v, __ATOMIC_RELAXED, __HIP_MEMORY_SCOPE_AGENT); }
__device__ __forceinline__ unsigned xb_xcc_id() { return (unsigned)__builtin_amdgcn_s_getreg((3 << 11) | 20) & 0xFu; }
#define XB_SPIN(cond, bar) do { unsigned _sp = 0; while (cond) { __builtin_amdgcn_s_sleep(1); \
    if ((++_sp & 255u) == 0u) { if (xb_ld(&(bar)[XB_TMO])) break; if (_sp > XB_SPIN_CAP) { atomicAdd(&(bar)[XB_TMO], 1u); break; } } } } while (0)
struct XcdBarrier { unsigned* bar; unsigned x; volatile LAS unsigned* st; };
__device__ __forceinline__ XcdBarrier xcd_barrier_post(unsigned* bar, volatile LAS unsigned* st) {
    XcdBarrier b; b.bar = bar; b.x = xb_xcc_id(); b.st = st;
    if (threadIdx.x == 0) (void)xb_add(&bar[XB_XCNT(b.x)], 1u);
    return b;
}
__device__ __forceinline__ void xcd_barrier_complete(unsigned* bar, unsigned x, unsigned& nloc, unsigned& nx) {
    const unsigned G = gridDim.x * gridDim.y * gridDim.z;
    unsigned sum, cnt, mine, sp = 0u;
    for (;;) {
        sum = 0u; cnt = 0u; mine = 0u;
#pragma unroll
        for (unsigned j = 0; j < 16; ++j) { const unsigned c = xb_ld(&bar[XB_XCNT(j)]); sum += c; cnt += (c > 0u) ? 1u : 0u; mine = (j == x) ? c : mine; }
        if (sum == G) break;
        __builtin_amdgcn_s_sleep(1);
        if ((++sp & 255u) == 0u) { if (xb_ld(&bar[XB_TMO])) break; if (sp > XB_SPIN_CAP) { atomicAdd(&bar[XB_TMO], 1u); break; } }
    }
    nloc = mine > 0u ? mine : 1u; nx = cnt > 0u ? cnt : 1u;
}
__device__ __forceinline__ void xcd_barrier(const XcdBarrier& b) {
    asm volatile("s_waitcnt vmcnt(0)" ::: "memory");
    __syncthreads();
    if (threadIdx.x == 0) {
        unsigned* bar = b.bar;
        __builtin_amdgcn_s_waitcnt(0);
        unsigned nloc = b.st[0], nx = b.st[1];
        if (nloc == 0u) { xcd_barrier_complete(bar, b.x, nloc, nx); b.st[0] = nloc; b.st[1] = nx; }
        const unsigned old = xb_add(&bar[XB_XSUB(b.x)], 1u);
        const unsigned gen = old / nloc;
        if (old + 1u == (gen + 1u) * nloc) {
            __builtin_amdgcn_fence(__ATOMIC_RELEASE, "agent");
            asm volatile("s_waitcnt vmcnt(0)" ::: "memory");
            const unsigned og = xb_add(&bar[XB_TOP], 1u);
            const unsigned tg = og / nx;
            if (og + 1u == (tg + 1u) * nx) xb_add(&bar[XB_TOPGEN], 1u);
            else XB_SPIN(xb_ld(&bar[XB_TOPGEN]) == tg, bar);
            __builtin_amdgcn_fence(__ATOMIC_ACQUIRE, "agent");
            xb_add(&bar[XB_XGEN(b.x)], 1u);
            asm volatile("s_waitcnt vmcnt(0)" ::: "memory");
        } else {
            XB_SPIN(xb_ld(&bar[XB_XGEN(b.x)]) == gen, bar);
            __builtin_amdgcn_fence(__ATOMIC_ACQUIRE, "agent");
            asm volatile("s_waitcnt vmcnt(0)" ::: "memory");
        }
    }
    __syncthreads();
}

#define XB_LSUB(j)  (3456 + 16 * (j))
#define XB_LGEN(j)  (3712 + 16 * (j))
__device__ __forceinline__ void xcd_barrier_local(const XcdBarrier& b) {
    asm volatile("s_waitcnt vmcnt(0)" ::: "memory");
    __syncthreads();
    if (threadIdx.x == 0) {
        unsigned* bar = b.bar;
        __builtin_amdgcn_s_waitcnt(0);
        const unsigned nloc = b.st[0];
        const unsigned old = xb_add(&bar[XB_LSUB(b.x)], 1u);
        const unsigned gen = old / nloc;
        if (old + 1u == (gen + 1u) * nloc) xb_add(&bar[XB_LGEN(b.x)], 1u);
        else { unsigned sp_ = 0; while (xb_ld(&bar[XB_LGEN(b.x)]) == gen) { if ((++sp_ & 1023u) == 0u) { if (xb_ld(&bar[XB_TMO])) break; if (sp_ > XB_SPIN_CAP) { atomicAdd(&bar[XB_TMO], 1u); break; } } } }
        __builtin_amdgcn_fence(__ATOMIC_ACQUIRE, "agent");
        asm volatile("s_waitcnt vmcnt(0)" ::: "memory");
    }
    __syncthreads();
}

__device__ __forceinline__ float wave_sum(float v) {
#pragma unroll
    for (int o = 1; o < 64; o <<= 1) v += __shfl_xor(v, o);
    return v;
}
__device__ __forceinline__ float wave_max(float v) {
#pragma unroll
    for (int o = 1; o < 64; o <<= 1) v = fmaxf(v, __shfl_xor(v, o));
    return v;
}
__device__ __forceinline__ float silu_f(float v) { return v * __builtin_amdgcn_rcpf(1.0f + __builtin_amdgcn_exp2f(-1.4426950408889634f * v)); }

struct Args {
    const float* x; const float* c; const int* pos; const float* mod_w; const float* mod_b; const float* norm_g;
    const float* conv_w_in; const float* conv_w; const float* conv_w_out; const float* ffn_g; const float* ffn_u; const float* ffn_d;
    const float* w_qkv; const float* w_o; const float* router_w; const float* moe_g; const float* moe_u; const float* moe_d; const float* final_g;
    float* out; unsigned char* ws; int ph_lo, ph_hi;
};

using pg8::Unit; using pg8::HALF; using pg8::BM;
#define PINV(x) asm volatile("" : "+v"(x))
#define ROWSTEP(k) (((k) == 3) ? 80u : 16u)
#ifndef STORE_AUX
#define STORE_AUX 0
#endif
__device__ __forceinline__ __amdgpu_buffer_rsrc_t mk_rsrc(const void* base) { return __builtin_amdgcn_make_buffer_rsrc(const_cast<void*>(base), 0, 0x7fffffff, 0x00020000); }
__device__ __forceinline__ void st16(__amdgpu_buffer_rsrc_t r, unsigned off, v4u v) { __builtin_amdgcn_raw_buffer_store_b128(v, r, (int)off, 0, STORE_AUX); }
__device__ __forceinline__ void st8(__amdgpu_buffer_rsrc_t r, unsigned off, v2u v) { __builtin_amdgcn_raw_buffer_store_b64(v, r, (int)off, 0, STORE_AUX); }
__device__ __forceinline__ void st16f(__amdgpu_buffer_rsrc_t r, unsigned off, f32x4 v) { __builtin_amdgcn_raw_buffer_store_b128(__builtin_bit_cast(v4u, v), r, (int)off, 0, STORE_AUX); }
template <class T> __device__ __forceinline__ T* at_off(T* base, unsigned byteoff) { return (T*)((char*)base + byteoff); }
template <class T> __device__ __forceinline__ const T* at_off(const T* base, unsigned byteoff) { return (const T*)((const char*)base + byteoff); }
__device__ __forceinline__ v4u pack8(const f32x4 a, const f32x4 b) { v4u w; w.x = pg8::cvt_pk_bf16(a[0], a[1]); w.y = pg8::cvt_pk_bf16(a[2], a[3]); w.z = pg8::cvt_pk_bf16(b[0], b[1]); w.w = pg8::cvt_pk_bf16(b[2], b[3]); return w; }
typedef int i32x4 __attribute__((ext_vector_type(4)));
__device__ __forceinline__ f32x4 acc_f32(const f32x4 a, bool i8) { return i8 ? __builtin_convertvector(__builtin_bit_cast(i32x4, a), f32x4) : a; }
template <bool I8> struct EpiConvInT {
    static constexpr bool PERM = true, SIDE = I8;
    bf16* V; bf16* Bg; const float* rsc; LAS unsigned char* side;
    __device__ __forceinline__ void side_issue(const Unit& u, int wid, int lane) const {
        if (wid < 4) __builtin_amdgcn_global_load_lds((const unsigned*)(rsc + (size_t)(u.pm * BM + wid * 64 + lane)), (LAS unsigned*)(side + u.sp * 1024 + wid * 256), 4, 0, 0);
    }
    __device__ __forceinline__ void operator()(const f32x4 (&acc)[2][2][4][2], const Unit& u, int wr, int wc, int fr, int fq) const {
        PINV(fr); PINV(fq);
        const int row0 = u.pm * BM + wr * 64 + fr; const __amdgpu_buffer_rsrc_t rV = mk_rsrc(V), rB = mk_rsrc(Bg);
        float ci[8];
#pragma unroll
        for (int k = 0; k < 8; ++k) ci[k] = I8 ? *(const LAS float*)(side + u.sp * 1024 + ((k >> 2) * HALF + wr * 64 + (k & 3) * 16 + fr) * 4) * (1.0f / GU_SW) : 1.0f;
        if (u.pn < 8) {
            unsigned ro = (unsigned)(row0 * D + u.pn * 128 + wc * 32 + 8 * fq) * 2u;
#pragma unroll
            for (int k = 0; k < 8; ++k) { const int ai = k >> 2, m = k & 3; const float c2 = ci[k] * ci[k];
                st16(rV, ro, pack8(acc_f32(acc[ai][0][m][0], I8) * acc_f32(acc[ai][1][m][0], I8) * c2, acc_f32(acc[ai][0][m][1], I8) * acc_f32(acc[ai][1][m][1], I8) * c2));
                ro += ROWSTEP(k) * (unsigned)(D * 2); PINV(ro); }
        } else {
            unsigned ro = (unsigned)(row0 * D + (u.pn - 8) * 256 + wc * 32 + 8 * fq) * 2u;
#pragma unroll
            for (int k = 0; k < 8; ++k) { const int ai = k >> 2, m = k & 3;
                st16(rB, ro, pack8(acc_f32(acc[ai][0][m][0], I8) * ci[k], acc_f32(acc[ai][0][m][1], I8) * ci[k]));
                st16(rB, ro + HALF * 2, pack8(acc_f32(acc[ai][1][m][0], I8) * ci[k], acc_f32(acc[ai][1][m][1], I8) * ci[k]));
                ro += ROWSTEP(k) * (unsigned)(D * 2); PINV(ro); }
        }
    }
};
typedef EpiConvInT<false> EpiConvIn;
typedef float f32x2 __attribute__((ext_vector_type(2)));
__device__ __forceinline__ f32x2 swiglu2(f32x2 g, f32x2 u, float cg, float cgu) {
    const f32x2 t = g * (-1.4426950408889634f * cg);
    f32x2 e; e.x = __builtin_amdgcn_exp2f(t.x); e.y = __builtin_amdgcn_exp2f(t.y);
    const float k = 1.0f / cgu;
    const f32x2 d = e * k + k;
    f32x2 r; r.x = __builtin_amdgcn_rcpf(d.x); r.y = __builtin_amdgcn_rcpf(d.y);
    return (g * u) * r;
}
__device__ __forceinline__ f32x4 swiglu4(f32x4 g, f32x4 u, float cg, float cgu) {
    const f32x2 a = swiglu2((f32x2){g.x, g.y}, (f32x2){u.x, u.y}, cg, cgu), b = swiglu2((f32x2){g.z, g.w}, (f32x2){u.z, u.w}, cg, cgu); return (f32x4){a.x, a.y, b.x, b.y}; }
__device__ __forceinline__ float rinv_of(const f32x4 s) { return __builtin_amdgcn_rsqf(((s.x + s.y) + (s.z + s.w)) * (1.0f / D) + RMS_EPS); }
constexpr int SIDE_BYTES = 5120;
template <bool NORM, bool F8 = false, bool F8O = F8> struct EpiSwiGLU {
    static constexpr bool PERM = true, SIDE = NORM;
    bf16* Hd; int nN; const float* SS; const float* bias; LAS unsigned char* side;
    __device__ __forceinline__ void side_issue(const Unit& u, int wid, int lane) const {
        LAS unsigned char* sl = side + u.sp * SIDE_BYTES;
        if (wid < 4) __builtin_amdgcn_global_load_lds((const unsigned*)(SS + ((size_t)(u.pm * BM + wid * 64 + lane)) * 4), (LAS unsigned*)(sl + wid * 1024), 16, 0, 0);
        else if (wid == 4) __builtin_amdgcn_global_load_lds((const unsigned*)(bias + (size_t)((u.pm * BM) / SEQ) * (2 * FF) + u.pn * BM + lane * 4), (LAS unsigned*)(sl + 4096), 16, 0, 0);
    }
    __device__ __forceinline__ void operator()(const f32x4 (&acc)[2][2][4][2], const Unit& u, int wr, int wc, int fr, int fq) const {
        PINV(fr); PINV(fq);
        const int row0 = u.pm * BM + wr * 64 + fr, pnl = u.pn % nN;
        f32x4 (&a)[2][2][4][2] = const_cast<f32x4 (&)[2][2][4][2]>(acc);
        if (NORM) {
            const LAS unsigned char* sl = side + u.sp * SIDE_BYTES;
            f32x4 bv[2][2];
#pragma unroll
            for (int bj = 0; bj < 2; ++bj)
#pragma unroll
                for (int n = 0; n < 2; ++n) bv[bj][n] = *(const LAS f32x4*)(sl + 4096 + (bj * HALF + wc * 32 + 8 * fq + 4 * n) * 4);
#pragma unroll
            for (int k = 0; k < 8; ++k) { const float r = rinv_of(*(const LAS f32x4*)(sl + ((k >> 2) * HALF + wr * 64 + (k & 3) * 16 + fr) * 16)) * (F8 ? 1.0f / (GU_SA * GU_SW) : 1.0f);
#pragma unroll
                for (int bj = 0; bj < 2; ++bj)
#pragma unroll
                    for (int n = 0; n < 2; ++n) a[k >> 2][bj][k & 3][n] = acc_f32(a[k >> 2][bj][k & 3][n], F8 && GU_I8) * r + bv[bj][n]; }
        }
        unsigned ro = (unsigned)(row0 * FF + pnl * 128 + wc * 32 + 8 * fq) * (F8O ? 1u : 2u); const __amdgpu_buffer_rsrc_t rH = mk_rsrc(Hd);
#pragma unroll
        for (int k = 0; k < 8; ++k) { const int ai = k >> 2, m = k & 3;
            const f32x4 g0 = a[ai][0][m][0], g1 = a[ai][0][m][1], u0 = a[ai][1][m][0], u1 = a[ai][1][m][1];
            const f32x4 v0 = swiglu4(g0, u0, 1.0f, F8O ? F8_SH : 1.0f), v1 = swiglu4(g1, u1, 1.0f, F8O ? F8_SH : 1.0f);
            if (F8O) { v2u w8; w8.x = pk_fp8x4(v0); w8.y = pk_fp8x4(v1); st8(rH, ro, w8); } else st16(rH, ro, pack8(v0, v1));
            ro += ROWSTEP(k) * (unsigned)(FF * (F8O ? 1 : 2)); PINV(ro); }
    }
};
struct EpiSwiGLU8 {
    static constexpr bool PERM = true, SIDE = false;
    unsigned char* Hd; int nN;
    __device__ __forceinline__ void operator()(const f32x4 (&acc)[2][2][4][2], const Unit& u, int wr, int wc, int fr, int fq) const {
        PINV(fr); PINV(fq);
        const int row0 = u.pm * BM + wr * 64 + fr, pnl = u.pn % nN;
        unsigned ro = (unsigned)(row0 * FF + pnl * 128 + wc * 32 + 8 * fq); const __amdgpu_buffer_rsrc_t rH = mk_rsrc(Hd);
        constexpr float ci = 1.0f / (MOE_SA * MOE_SW);
#pragma unroll
        for (int k = 0; k < 8; ++k) { const int ai = k >> 2, m = k & 3;
            const f32x4 v0 = swiglu4(acc_f32(acc[ai][0][m][0], MOE_I8), acc_f32(acc[ai][1][m][0], MOE_I8), ci, ci * ci * F8_SH), v1 = swiglu4(acc_f32(acc[ai][0][m][1], MOE_I8), acc_f32(acc[ai][1][m][1], MOE_I8), ci, ci * ci * F8_SH);
            v2u w; w.x = pk_fp8x4(v0); w.y = pk_fp8x4(v1); st8(rH, ro, w);
            ro += ROWSTEP(k) * (unsigned)FF; PINV(ro); }
    }
};
template <bool I8> struct EpiQkvRopeT {
    static constexpr bool PERM = true, SIDE = true;
    bf16* QKV; const unsigned* rope; const float* SS; const float* bias; LAS unsigned char* side;
    __device__ __forceinline__ void side_issue(const Unit& u, int wid, int lane) const {
        LAS unsigned char* sl = side + u.sp * SIDE_BYTES;
        if (wid < 4) __builtin_amdgcn_global_load_lds((const unsigned*)(SS + ((size_t)(u.pm * BM + wid * 64 + lane)) * 4), (LAS unsigned*)(sl + wid * 1024), 16, 0, 0);
        else if (wid == 4) __builtin_amdgcn_global_load_lds((const unsigned*)(bias + (size_t)((u.pm * BM) / SEQ) * (2 * FF) + u.pn * BM + lane * 4), (LAS unsigned*)(sl + 4096), 16, 0, 0);
    }
    __device__ __forceinline__ void operator()(const f32x4 (&acc)[2][2][4][2], const Unit& u, int wr, int wc, int fr, int fq) const {
        PINV(fr); PINV(fq);
        const int hd = 4 * u.pn + wc; if (hd >= NHQKV) return;
        const int row0 = u.pm * BM + wr * 64 + fr;
        const float sc = hd < NH ? C2 : 1.0f;
        f32x4 (&a)[2][2][4][2] = const_cast<f32x4 (&)[2][2][4][2]>(acc);
        { const LAS unsigned char* sl = side + u.sp * SIDE_BYTES;
            f32x4 bv[2][2];
#pragma unroll
            for (int bj = 0; bj < 2; ++bj)
#pragma unroll
                for (int n = 0; n < 2; ++n) bv[bj][n] = *(const LAS f32x4*)(sl + 4096 + (bj * HALF + wc * 32 + 8 * fq + 4 * n) * 4);
#pragma unroll
            for (int k = 0; k < 8; ++k) { const float r = rinv_of(*(const LAS f32x4*)(sl + ((k >> 2) * HALF + wr * 64 + (k & 3) * 16 + fr) * 16)) * (I8 ? 1.0f / (GU_SA * GU_SW) : 1.0f);
#pragma unroll
                for (int bj = 0; bj < 2; ++bj)
#pragma unroll
                    for (int n = 0; n < 2; ++n) a[k >> 2][bj][k & 3][n] = acc_f32(a[k >> 2][bj][k & 3][n], I8) * r + bv[bj][n]; } }
        const bool rot = hd < 2 * NH; const __amdgpu_buffer_rsrc_t rQ = mk_rsrc(QKV);
        v4u cs[2][2];
        unsigned co = (unsigned)(row0 * 32 + 8 * fq) * 4u, ro = (unsigned)(row0 * QKVP + hd * 64 + 8 * fq) * (QKV_F8 ? 1u : 2u);
#define RP_H2F(u, hi) ((float)__builtin_bit_cast(_Float16, (unsigned short)((hi) ? ((u) >> 16) : ((u) & 0xffffu))))
        cs[0][0] = *at_off((const v4u*)rope, co); cs[0][1] = *at_off((const v4u*)rope, co + 16);
#pragma unroll
        for (int k = 0; k < 8; ++k) { const int ai = k >> 2, m = k & 3, cb_ = k & 1;
            co += ROWSTEP(k) * 128u; PINV(co);
            if (k < 7) { cs[cb_ ^ 1][0] = *at_off((const v4u*)rope, co); cs[cb_ ^ 1][1] = *at_off((const v4u*)rope, co + 16); }
            v4u w1, w2; v2u q1, q2;
#pragma unroll
            for (int n = 0; n < 2; ++n) {
                const f32x4 x1 = a[ai][0][m][n], x2 = a[ai][1][m][n]; f32x4 c, s;
#pragma unroll
                for (int i = 0; i < 4; ++i) { const float cf = RP_H2F(cs[cb_][n][i], 0), sf = RP_H2F(cs[cb_][n][i], 1); c[i] = rot ? cf : 1.0f; s[i] = rot ? sf : 0.0f; }
                const f32x4 o1 = (x1 * c - x2 * s) * sc, o2 = (x2 * c + x1 * s) * sc;
                if (QKV_F8) { q1[n] = pk_fp8x4(o1 * F8_SQKV); q2[n] = pk_fp8x4(o2 * F8_SQKV); }
                else { w1[2 * n] = pg8::cvt_pk_bf16(o1[0], o1[1]); w1[2 * n + 1] = pg8::cvt_pk_bf16(o1[2], o1[3]);
                    w2[2 * n] = pg8::cvt_pk_bf16(o2[0], o2[1]); w2[2 * n + 1] = pg8::cvt_pk_bf16(o2[2], o2[3]); } }
            if (QKV_F8) { if (rot && QK_PERM) st16(rQ, ro + 8 * fq, (v4u){q1.x, q1.y, q2.x, q2.y});
                else { st8(rQ, ro, q1); st8(rQ, ro + 32, q2); } } else { st16(rQ, ro, w1); st16(rQ, ro + 64, w2); }
            ro += ROWSTEP(k) * (unsigned)(QKVP * (QKV_F8 ? 1 : 2)); PINV(ro); }
#undef RP_H2F
    }
};
typedef EpiQkvRopeT<false> EpiQkvRope;
__device__ __forceinline__ void unpack8(const v4u u, f32x4& a, f32x4& b) { a = (f32x4){bflo(u.x), bfhi(u.x), bflo(u.y), bfhi(u.y)}; b = (f32x4){bflo(u.z), bfhi(u.z), bflo(u.w), bfhi(u.w)}; }
template <bool BASE_F32, bool NEXT, bool XB8 = false> struct EpiResidB {
    static constexpr bool PERM = true, SIDE = false;
    const void* base; bf16* XR; const float* gate; bf16* XB; float* SS; const float* scl; const float* ng; LAS float* red; float ascale;
    __device__ __forceinline__ void operator()(const f32x4 (&acc)[2][2][4][2], const Unit& u, int wr, int wc, int fr, int fq) const {
        PINV(fr); PINV(fq);
        const int row0 = u.pm * BM + wr * 64 + fr, col0 = u.pn * BM + wc * 32 + 8 * fq, b = (u.pm * BM) / SEQ;
        f32x4 gv[2][2], can[2][2];
#pragma unroll
        for (int bj = 0; bj < 2; ++bj)
#pragma unroll
            for (int n = 0; n < 2; ++n) { gv[bj][n] = *(const f32x4*)(gate + (size_t)b * 3072 + col0 + bj * HALF + 4 * n) * ascale;
                if (NEXT) can[bj][n] = *(const f32x4*)(ng + col0 + bj * HALF + 4 * n) * (*(const f32x4*)(scl + (size_t)b * 3072 + col0 + bj * HALF + 4 * n) + 1.0f); }
        const __amdgpu_buffer_rsrc_t rR = mk_rsrc(XR), rX = mk_rsrc(XB);
        f32x4 bf[2][2][2]; v4u bh[2][2];
        unsigned lo = (unsigned)(row0 * D + col0) * (BASE_F32 ? 4u : 2u), so = (unsigned)(row0 * D + col0) * 2u; int rl = wr * 64 + fr;
#define ER_LOAD(buf) do { if (BASE_F32) { _Pragma("unroll") for (int bj = 0; bj < 2; ++bj) _Pragma("unroll") for (int n = 0; n < 2; ++n) bf[buf][bj][n] = *at_off((const f32x4*)base, lo + (bj * HALF + 4 * n) * 4); } \
        else { _Pragma("unroll") for (int bj = 0; bj < 2; ++bj) bh[buf][bj] = *at_off((const v4u*)base, lo + bj * HALF * 2); } } while (0)
        ER_LOAD(0);
#pragma unroll
        for (int k = 0; k < 8; ++k) { const int ai = k >> 2, m = k & 3, cb_ = k & 1;
            lo += ROWSTEP(k) * (unsigned)(D * (BASE_F32 ? 4 : 2)); PINV(lo);
            if (k < 7) { if (cb_) ER_LOAD(0); else ER_LOAD(1); }
            float s = 0.f;
#pragma unroll
            for (int bj = 0; bj < 2; ++bj) { f32x4 x0, x1;
                if (BASE_F32) { x0 = bf[cb_][bj][0]; x1 = bf[cb_][bj][1]; } else unpack8(bh[cb_][bj], x0, x1);
                x0 = x0 + gv[bj][0] * acc[ai][bj][m][0]; x1 = x1 + gv[bj][1] * acc[ai][bj][m][1];
                st16(rR, so + bj * HALF * 2, pack8(x0, x1));
                if (NEXT) { s += ((x0.x * x0.x + x0.y * x0.y) + (x0.z * x0.z + x0.w * x0.w)) + ((x1.x * x1.x + x1.y * x1.y) + (x1.z * x1.z + x1.w * x1.w));
                    if (XB8) { v2u w8; w8.x = pk_q8x4(x0 * can[bj][0] * GU_SA); w8.y = pk_q8x4(x1 * can[bj][1] * GU_SA); st8(rX, (so >> 1) + bj * HALF, w8); }
                    else st16(rX, so + bj * HALF * 2, pack8(x0 * can[bj][0], x1 * can[bj][1])); } }
            if (NEXT) { s += __shfl_xor(s, 16); s += __shfl_xor(s, 32); if (fq == 0) red[rl * 4 + wc] = s; }
            so += ROWSTEP(k) * (unsigned)(D * 2); PINV(so); rl += (int)ROWSTEP(k); }
#undef ER_LOAD
        if (NEXT) {
            asm volatile("s_waitcnt lgkmcnt(0)" ::: "memory"); __builtin_amdgcn_s_barrier(); asm volatile("" ::: "memory");
            if (threadIdx.x < 256) { const f32x4 t = *(const LAS f32x4*)(red + threadIdx.x * 4); SS[(size_t)(u.pm * BM + threadIdx.x) * 4 + u.pn] = (t.x + t.y) + (t.z + t.w); }
        }
    }
};
struct EpiMoeDown {
    static constexpr bool PERM = true, SIDE = true;
    bf16* XR; bf16* Y1; const int* rowtok; const float* roww; const LAS float* gate; float oscale; LAS unsigned char* side;
    __device__ __forceinline__ void side_issue(const Unit& u, int wid, int lane) const {
        LAS unsigned char* sl = side + u.sp * 2048; const size_t lb = (size_t)u.g * M + 256 * u.k + u.ro;
        if (wid < 4) __builtin_amdgcn_global_load_lds((const unsigned*)(rowtok + lb + wid * 64 + lane), (LAS unsigned*)(sl + wid * 256), 4, 0, 0);
        else __builtin_amdgcn_global_load_lds((const unsigned*)(roww + lb + (wid - 4) * 64 + lane), (LAS unsigned*)(sl + 1024 + (wid - 4) * 256), 4, 0, 0);
    }
    __device__ __forceinline__ void operator()(const f32x4 (&acc)[2][2][4][2], const Unit& u, int wr, int wc, int fr, int fq) const {
        PINV(fr); PINV(fq);
        const int col0 = (u.pn & 3) * BM + wc * 32 + 8 * fq; const LAS unsigned char* sl = side + u.sp * 2048;
        int tok[8]; float w[8];
#pragma unroll
        for (int k = 0; k < 8; ++k) { const int rl = (k >> 2) * HALF + wr * 64 + (k & 3) * 16 + fr; const bool ok = rl < u.nv; const int t_ = *(const LAS int*)(sl + rl * 4); const float w_ = *(const LAS float*)(sl + 1024 + rl * 4);
            tok[k] = ok ? t_ : -1; w[k] = ok ? w_ * oscale : 0.f; }
        if (u.g < 8) {
            const __amdgpu_buffer_rsrc_t rR = mk_rsrc(XR);
            v4u bh[2][2];
#define ER_LOAD(buf, kk) do { const unsigned o_ = (unsigned)((tok[kk] < 0 ? 0 : tok[kk]) * D + col0) * 2u; \
            _Pragma("unroll") for (int bj = 0; bj < 2; ++bj) bh[buf][bj] = *at_off((const v4u*)XR, o_ + bj * HALF * 2); } while (0)
            ER_LOAD(0, 0);
#pragma unroll
            for (int k = 0; k < 8; ++k) { const int ai = k >> 2, m = k & 3, cb_ = k & 1;
                if (k < 7) { if (cb_) ER_LOAD(0, (k + 1) & 7); else ER_LOAD(1, (k + 1) & 7); }
#pragma unroll
                for (int bj = 0; bj < 2; ++bj) PINV(bh[cb_][bj]);
                if (tok[k] >= 0) { const unsigned o_ = (unsigned)(tok[k] * D + col0) * 2u; const LAS float* g_ = gate + (tok[k] >> 13) * D + col0; const float w_ = w[k];
#pragma unroll
                    for (int bj = 0; bj < 2; ++bj) { f32x4 x0, x1; unpack8(bh[cb_][bj], x0, x1);
                        x0 = x0 + *(const LAS f32x4*)(g_ + bj * HALF) * w_ * acc[ai][bj][m][0]; x1 = x1 + *(const LAS f32x4*)(g_ + bj * HALF + 4) * w_ * acc[ai][bj][m][1];
                        st16(rR, o_ + bj * HALF * 2, pack8(x0, x1)); } } }
#undef ER_LOAD
        } else {
            const __amdgpu_buffer_rsrc_t rY = mk_rsrc(Y1);
#pragma unroll
            for (int k = 0; k < 8; ++k) { const int ai = k >> 2, m = k & 3;
                if (tok[k] >= 0) { const unsigned o_ = (unsigned)(tok[k] * D + col0) * 2u; const LAS float* g_ = gate + (tok[k] >> 13) * D + col0; const float w_ = w[k];
#pragma unroll
                    for (int bj = 0; bj < 2; ++bj) st16(rY, o_ + bj * HALF * 2, pack8(*(const LAS f32x4*)(g_ + bj * HALF) * w_ * acc[ai][bj][m][0], *(const LAS f32x4*)(g_ + bj * HALF + 4) * w_ * acc[ai][bj][m][1])); } }
        }
    }
};
struct EpiNull { static constexpr bool PERM = true, SIDE = false;
    __device__ __forceinline__ void operator()(const f32x4 (&acc)[2][2][4][2], const Unit& u, int wr, int wc, int fr, int fq) const {
        PINV(fr); PINV(fq);
#pragma unroll
        for (int ai = 0; ai < 2; ++ai)
#pragma unroll
            for (int bj = 0; bj < 2; ++bj)
                asm volatile("" :: "v"(acc[ai][bj][0][0]), "v"(acc[ai][bj][0][1]), "v"(acc[ai][bj][1][0]), "v"(acc[ai][bj][1][1]), "v"(acc[ai][bj][2][0]), "v"(acc[ai][bj][2][1]), "v"(acc[ai][bj][3][0]), "v"(acc[ai][bj][3][1])); } };
__constant__ float INVF[32] = {
    1.0f, 0.7498942093324559f, 0.5623413251903491f, 0.4216965034285822f, 0.31622776601683794f, 0.23713737056616552f, 0.1778279410038923f, 0.1333521432163324f,
    0.1f, 0.07498942093324558f, 0.05623413251903491f, 0.04216965034285822f, 0.03162277660168379f, 0.023713737056616554f, 0.01778279410038923f, 0.01333521432163324f,
    0.01f, 0.007498942093324558f, 0.005623413251903491f, 0.004216965034285823f, 0.0031622776601683794f, 0.0023713737056616554f, 0.0017782794100389228f, 0.001333521432163324f,
    0.001f, 0.0007498942093324559f, 0.0005623413251903491f, 0.0004216965034285823f, 0.00031622776601683794f, 0.00023713737056616554f, 0.00017782794100389227f, 0.0001333521432163324f };

template <int MAP, int FMT  >
__device__ __forceinline__ void conv_block(const float* W, int ld, int ncol, int kvalid, int k0, int c0, unsigned char* dst, int Kp  , int rowoff, float sc, int wave, int lane) {
    const int col = c0 + 4 * lane, kb = k0 + 16 * wave; const bool act = col < ncol;
    f32x4 v[16];
#pragma unroll
    for (int i = 0; i < 16; ++i) v[i] = (act && kb + i < kvalid) ? (P0_NT ? __builtin_nontemporal_load((const f32x4*)(W + (size_t)(kb + i) * ld + col)) : *(const f32x4*)(W + (size_t)(kb + i) * ld + col)) : (f32x4){0.f, 0.f, 0.f, 0.f};
    if (!act) return;
    int nrow;
    if (MAP == 0) nrow = col;
    else if (MAP == 1) { if (col < 1024) nrow = 2048 + col; else { const int cc = (col - 1024) & 1023, up = col >= 2048; nrow = 256 * (cc >> 7) + (cc & 127) + (up ? 128 : 0); } }
    else if (MAP == 2) nrow = 256 * (col >> 7) + (col & 127);
    else { const int head = col >> 6, bj = (col >> 5) & 1, dd = col & 31; nrow = 256 * (head >> 2) + 128 * bj + 32 * (head & 3) + dd; }
    nrow += rowoff;
#pragma unroll
    for (int j = 0; j < 4; ++j) {
        if (FMT != 0) { v4u o;
#pragma unroll
            for (int q = 0; q < 4; ++q) { const f32x4 t = (f32x4){v[4 * q][j], v[4 * q + 1][j], v[4 * q + 2][j], v[4 * q + 3][j]} * sc; o[q] = FMT == 2 ? pk_i8x4(t) : pk_fp8x4(t); }
            *(v4u*)(dst + (size_t)(nrow + j) * Kp + kb) = o; }
        else { v4u o0, o1;
#pragma unroll
            for (int q = 0; q < 4; ++q) { o0[q] = pk2(v[2 * q][j], v[2 * q + 1][j]); o1[q] = pk2(v[8 + 2 * q][j], v[8 + 2 * q + 1][j]); }
            bf16* p = (bf16*)dst + (size_t)(nrow + j) * Kp + kb; *(v4u*)p = o0; *(v4u*)(p + 8) = o1; }
    }
}
__device__ __forceinline__ void p0_prologue(const Args& a, LAS unsigned char* lds, int gw, int NGW, int wave, int lane, int tid) {
    unsigned char* ws = a.ws;
    LAS float* sc = (LAS float*)(lds + 69632);
    for (int i = tid; i < NB * D; i += NTHR) sc[i] = silu_f(a.c[i]);
    if (blockIdx.x == 0) for (int i = tid; i < 16 * 3072; i += NTHR) ((float*)(ws + WS_ZG))[i] = 0.f;
    if (blockIdx.x == 1) for (int i = tid; i < 2 * RPAD; i += NTHR) ((int*)(ws + WS_IDENT))[i] = i;
    if (blockIdx.x == 2) {
        for (int i = tid; i < 192 * (D / 8); i += NTHR) { const int rr = i / (D / 8), c8 = i % (D / 8), bj = rr / 96, q = rr % 96;
            if (QKV_I8) { if (c8 < D / 16) *(v4u*)(ws + WS_WQKV + (size_t)(2816 + 128 * bj + 32 + q) * D + 16 * c8) = (v4u){0u, 0u, 0u, 0u}; }
            else *(v4u*)((bf16*)(ws + WS_WQKV) + (size_t)(2816 + 128 * bj + 32 + q) * D + 8 * c8) = (v4u){0u, 0u, 0u, 0u}; } }
    __syncthreads();
    constexpr int B_CIN = 8 * 12, B_COUT = 8 * 4, B_FG = 8 * 11, B_FD = 22 * 4, B_QKV = 8 * 12, B_WO = 8 * 4, B_MG = NE * B_FG, B_MD = NE * B_FD;
    constexpr int NBLK = B_CIN + B_COUT + 2 * B_FG + B_FD + B_QKV + B_WO + 2 * B_MG + B_MD;
    for (int it = blockIdx.x; it < NBLK; it += gridDim.x) {
        int r = it;
        if (r < B_CIN) { conv_block<1, CONVIN_I8 ? 2 : 0>(a.conv_w_in, 3072, 3072, D, 128 * (r / 12), 256 * (r % 12), ws + WS_WCIN, D, 0, GU_SW, wave, lane); continue; } r -= B_CIN;
        if (r < B_COUT) { conv_block<0, WOUT_FP8 ? 1 : 0>(a.conv_w_out, D, D, D, 128 * (r / 4), 256 * (r % 4), ws + WS_WCOUT, D, 0, F8_SW, wave, lane); continue; } r -= B_COUT;
        if (r < 2 * B_FG) { const int up = r >= B_FG, q = up ? r - B_FG : r;
            conv_block<2, DENSE_GU_FP8 ? (GU_I8 ? 2 : 1) : 0>(up ? a.ffn_u : a.ffn_g, FF, FF, D, 128 * (q / 11), 256 * (q % 11), ws + WS_WFGU, D, up ? 128 : 0, GU_SW, wave, lane); continue; } r -= 2 * B_FG;
        if (r < B_FD) { conv_block<0, DENSE_DOWN_FP8 ? 1 : 0>(a.ffn_d, D, D, FF, 128 * (r / 4), 256 * (r % 4), ws + WS_WFD, FF, 0, F8_SW, wave, lane); continue; } r -= B_FD;
        if (r < B_QKV) { conv_block<3, QKV_I8 ? 2 : 0>(a.w_qkv, 2880, 2880, D, 128 * (r / 12), 256 * (r % 12), ws + WS_WQKV, D, 0, GU_SW, wave, lane); continue; } r -= B_QKV;
        if (r < B_WO) { conv_block<0, WO_FP8 ? 1 : 0>(a.w_o, D, D, 960, 128 * (r / 4), 256 * (r % 4), ws + WS_WO, D, 0, F8_SW, wave, lane); continue; } r -= B_WO;
        if (r < 2 * B_MG) { const int up = r >= B_MG, q = up ? r - B_MG : r, e = q / B_FG, qq = q % B_FG;
            conv_block<2, MOE_I8 ? 2 : 1>((up ? a.moe_u : a.moe_g) + (size_t)e * D * FF, FF, FF, D, 128 * (qq / 11), 256 * (qq % 11), ws + WS_WMGU, D, e * 2 * FF + (up ? 128 : 0), MOE_SW, wave, lane); continue; } r -= 2 * B_MG;
        { const int e = r / B_FD, qq = r % B_FD;
            conv_block<0, 1>(a.moe_d + (size_t)e * FF * D, D, D, FF, 128 * (qq / 4), 256 * (qq % 4), ws + WS_WMD, FF, e * D, F8_SW, wave, lane); }
    }
    constexpr int I_ADA = 4 * 12 * 8, I_ROPE = M / 2;
    for (int it = gw; it < I_ADA + I_ROPE; it += NGW) {
        int r = it;
        if (r < I_ADA) {
            const int ls = r / 96, q = r % 96, cg = q / 8, kc = q % 8;
            const float* W = a.mod_w + (size_t)ls * D * 3072 + (size_t)(kc * 128) * 3072 + cg * 256 + 4 * lane;
            f32x4 acc[NB];
#pragma unroll
            for (int b = 0; b < NB; ++b) acc[b] = (f32x4){0.f, 0.f, 0.f, 0.f};
#pragma unroll 8
            for (int k = 0; k < 128; ++k) { const f32x4 w = P0_NT ? __builtin_nontemporal_load((const f32x4*)(W + (size_t)k * 3072)) : *(const f32x4*)(W + (size_t)k * 3072);
#pragma unroll
                for (int b = 0; b < NB; ++b) acc[b] += w * sc[b * D + kc * 128 + k]; }
            float* P = (float*)(ws + WS_MODP);
#pragma unroll
            for (int b = 0; b < NB; ++b) *(f32x4*)(P + (size_t)(kc * 16 + ls * 4 + b) * 3072 + cg * 256 + 4 * lane) = acc[b];
            continue;
        }
        r -= I_ADA;
        {
            const int tok = 2 * r + (lane >> 5), i = lane & 31;
            const float ang = (float)a.pos[tok] * INVF[i];
            double rev = (double)ang * 0.15915494309189535; rev -= __builtin_rint(rev);
            const float fr = (float)rev;
            unsigned* R = (unsigned*)(ws + WS_ROPE) + (size_t)tok * 32;
            const _Float16 hc = (_Float16)__builtin_amdgcn_cosf(fr), hs = (_Float16)__builtin_amdgcn_sinf(fr);
            R[i] = (unsigned)__builtin_bit_cast(unsigned short, hc) | ((unsigned)__builtin_bit_cast(unsigned short, hs) << 16);
        }
    }
}

__device__ __forceinline__ void bias_gemv(const Args& a, int gw, int NGW, int lane, const LAS float* shl);
template <bool FROM_PARTIALS, bool ROUTE, bool SRC16 = false, bool OUT8 = ROUTE>
__device__ __forceinline__ void norm_phase(const Args& a, const void* xsrc, int ls, LAS unsigned char* lds, int G, int wave, int lane, int tid) {
    unsigned char* ws = a.ws;
    LAS float* cA = (LAS float*)lds;
    LAS float* cB = (LAS float*)(lds + 4096);
    LAS float* rwT = (LAS float*)(lds + 8192);
    bf16* H = (bf16*)(ws + WS_H);
    const float* P = (const float*)(ws + WS_MODP); const float* MF = (const float*)(ws + WS_MODF);
    if (ROUTE) { for (int i = tid; i < D * NE; i += NTHR) { const int k = i >> 3, e = i & 7; rwT[e * D + k] = a.router_w[i]; } }
    for (int ch = (G % 8 == 0) ? (blockIdx.x % 8) * (G / 8) + blockIdx.x / 8 : blockIdx.x; ch < NCHUNK; ch += G) {
        const int b = ch / (SEQ / 128);
        __syncthreads();
        for (int k = tid; k < D; k += NTHR) {
            float sh, scl;
            if (FROM_PARTIALS) { sh = a.mod_b[ls * 3072 + k]; scl = a.mod_b[ls * 3072 + D + k];
#pragma unroll
                for (int kc = 0; kc < 8; ++kc) { sh += P[(size_t)(kc * 16 + ls * 4 + b) * 3072 + k]; scl += P[(size_t)(kc * 16 + ls * 4 + b) * 3072 + D + k]; } }
            else { sh = MF[(size_t)(ls * 4 + b) * 3072 + k]; scl = MF[(size_t)(ls * 4 + b) * 3072 + D + k]; }
            cA[k] = a.norm_g[ls * D + k] * (1.0f + scl); cB[k] = sh;
        }
        int my_e0 = -1, my_e1 = -1; float my_w0 = 0.f, my_w1 = 0.f;
        __syncthreads();
        v2u nb16[2][4]; f32x4 nb32[2][4];
#define NP_LOAD(buf, ii) do { const int row_ = ch * 128 + wave * 16 + (ii); \
            if (SRC16) { const v2u* xr = (const v2u*)((const bf16*)xsrc + (size_t)row_ * D) + lane; _Pragma("unroll") for (int j = 0; j < 4; ++j) nb16[buf][j] = xr[64 * j]; } \
            else { const f32x4* xr = (const f32x4*)((const float*)xsrc + (size_t)row_ * D) + lane; _Pragma("unroll") for (int j = 0; j < 4; ++j) nb32[buf][j] = P0_NT ? __builtin_nontemporal_load(xr + 64 * j) : xr[64 * j]; } } while (0)
        NP_LOAD(0, 0);
        for (int i2 = 0; i2 < 16; i2 += 2) {
#pragma unroll
          for (int pb = 0; pb < 2; ++pb) {
            const int i = i2 + pb;
            if (pb == 0) NP_LOAD(1, i + 1); else if (i + 1 < 16) NP_LOAD(0, i + 1);
            const int row = ch * 128 + wave * 16 + i;
            f32x4 v[4]; float s = 0.f;
#pragma unroll
            for (int j = 0; j < 4; ++j) { if (SRC16) { const v2u t = nb16[pb][j]; v[j] = (f32x4){bflo(t.x), bfhi(t.x), bflo(t.y), bfhi(t.y)}; } else v[j] = nb32[pb][j]; }
#pragma unroll
            for (int j = 0; j < 4; ++j) s += (v[j].x * v[j].x + v[j].y * v[j].y) + (v[j].z * v[j].z + v[j].w * v[j].w);
            const float rinv = 1.0f / sqrtf(wave_sum(s) * (1.0f / D) + RMS_EPS);
            if (FROM_PARTIALS) { unsigned long long* x8 = (unsigned long long*)((bf16*)(ws + WS_XR) + (size_t)row * D) + lane;
#pragma unroll
                for (int j = 0; j < 4; ++j) x8[64 * j] = (unsigned long long)pk2(v[j].x, v[j].y) | ((unsigned long long)pk2(v[j].z, v[j].w) << 32); }
            unsigned long long* o8 = (unsigned long long*)(H + (size_t)row * D) + lane;
#pragma unroll
            for (int j = 0; j < 4; ++j) { const f32x4 ca = *(const LAS f32x4*)(cA + 4 * lane + 256 * j), cb = *(const LAS f32x4*)(cB + 4 * lane + 256 * j);
                v[j] = v[j] * rinv * ca + cb;
                if (OUT8 && ROUTE) ((unsigned*)((unsigned char*)H + (size_t)row * D))[lane + 64 * j] = MOE_I8 ? pk_i8x4(v[j] * MOE_SA) : pk_fp8x4(v[j] * MOE_SA);
                else if (!OUT8) o8[64 * j] = (unsigned long long)pk2(v[j].x, v[j].y) | ((unsigned long long)pk2(v[j].z, v[j].w) << 32); }
            if (OUT8 && !ROUTE) {
                float am = 0.f;
#pragma unroll
                for (int j = 0; j < 4; ++j) am = fmaxf(am, fmaxf(fmaxf(fabsf(v[j].x), fabsf(v[j].y)), fmaxf(fabsf(v[j].z), fabsf(v[j].w))));
                am = fmaxf(wave_max(am), 1e-20f);
                const float qs = 127.0f / am;
                if (lane == 0) ((float*)(ws + WS_RSC))[row] = am * (1.0f / 127.0f);
#pragma unroll
                for (int j = 0; j < 4; ++j) ((unsigned*)((unsigned char*)H + (size_t)row * D))[lane + 64 * j] = pk_i8x4(v[j] * qs); }
            if (ROUTE) {
                float pe[NE];
#pragma unroll
                for (int e = 0; e < NE; ++e) pe[e] = 0.f;
#pragma unroll
                for (int j = 0; j < 4; ++j) {
#pragma unroll
                    for (int e = 0; e < NE; ++e) { const f32x4 w = *(const LAS f32x4*)(rwT + e * D + 4 * lane + 256 * j); pe[e] += (v[j].x * w.x + v[j].y * w.y) + (v[j].z * w.z + v[j].w * w.w); }
                    asm volatile("" ::: "memory"); }
                float lg[NE];
#pragma unroll
                for (int e = 0; e < NE; ++e) lg[e] = wave_sum(pe[e]);
                int i0 = 0; float v0 = lg[0];
#pragma unroll
                for (int e = 1; e < NE; ++e) if (lg[e] > v0) { v0 = lg[e]; i0 = e; }
                int i1 = -1; float v1 = -INFINITY;
#pragma unroll
                for (int e = 0; e < NE; ++e) if (e != i0 && lg[e] > v1) { v1 = lg[e]; i1 = e; }
                const float w0 = 1.0f / (1.0f + expf(v1 - v0)), w1 = 1.0f - w0;
                if (lane == i) { my_e0 = i0; my_e1 = i1; my_w0 = w0; my_w1 = w1; }
            }
          }
        }
#undef NP_LOAD
        if (ROUTE) {
            unsigned* CNT = (unsigned*)(ws + WS_CTL) + CW_CNT; int* RT2 = (int*)(ws + WS_RT2); float* RW2 = (float*)(ws + WS_RW2);
#pragma unroll
            for (int s = 0; s < 2; ++s) {
                const int me = lane < 16 ? (s ? my_e1 : my_e0) : -1; int rank = 0, mycount = 0;
#pragma unroll
                for (int e = 0; e < NE; ++e) { const unsigned long long mask = __ballot(me == e); if (lane == e) mycount = __popcll(mask); if (me == e) rank = __popcll(mask & ((1ull << lane) - 1ull)); }
                int base = 0; if (lane < NE && mycount > 0) base = (int)__hip_atomic_fetch_add(CNT + s * 8 + lane, (unsigned)mycount, __ATOMIC_RELAXED, __HIP_MEMORY_SCOPE_AGENT);
                const int bs = __shfl(base, me < 0 ? 0 : me);
                if (lane < 16) { const size_t p = (size_t)(s * 8 + me) * M + bs + rank; RT2[p] = ch * 128 + wave * 16 + lane; RW2[p] = s ? my_w1 : my_w0; }
            }
        }
    }
    if (FROM_PARTIALS) {
        LAS float* shl = (LAS float*)(lds + 8192);
        __syncthreads();
        for (int i = tid; i < 2 * NB * D; i += NTHR) { const int lsb = 4 + (i >> 10), k = i & (D - 1); float v = a.mod_b[(lsb >> 2) * 3072 + k];
#pragma unroll
            for (int kc = 0; kc < 8; ++kc) v += P[(size_t)(kc * 16 + lsb) * 3072 + k];
            shl[i] = v; }
        __syncthreads();
        bias_gemv(a, ((G % 8 == 0) ? (blockIdx.x % 8) * (G / 8) + blockIdx.x / 8 : blockIdx.x) * NWAVES + wave, G * NWAVES, lane, shl);
    }
    if (FROM_PARTIALS) {
        float* MFw = (float*)(ws + WS_MODF);
        for (int idx = blockIdx.x * NTHR + tid; idx < 16 * 3072; idx += G * NTHR) { const int lsb = idx / 3072, n = idx % 3072; float s = a.mod_b[(lsb >> 2) * 3072 + n];
#pragma unroll
            for (int kc = 0; kc < 8; ++kc) s += P[(size_t)(kc * 16 + lsb) * 3072 + n];
            MFw[idx] = s; }
    }
}

__device__ __forceinline__ void conv_phase(const Args& a, int G, int tid) {
    unsigned char* ws = a.ws;
    const bf16* V = (const bf16*)(ws + WS_V); const bf16* Bg = (const bf16*)(ws + WS_BG); bf16* Y = (bf16*)(ws + WS_H);
    const int cg = tid & 127, rs = tid >> 7;
    float w0[8], w1[8], w2[8];
#pragma unroll
    for (int i = 0; i < 8; ++i) { w0[i] = a.conv_w[8 * cg + i]; w1[i] = a.conv_w[D + 8 * cg + i]; w2[i] = a.conv_w[2 * D + 8 * cg + i]; }
    for (int ch = (G % 8 == 0) ? (blockIdx.x % 8) * (G / 8) + blockIdx.x / 8 : blockIdx.x; ch < NCHUNK; ch += G) {
        const int r0 = ch * 128 + rs * 32, t0 = r0 & (SEQ - 1);
        v4u zz = (v4u){0u, 0u, 0u, 0u};
        v4u vm2 = t0 >= 2 ? *(const v4u*)(V + (size_t)(r0 - 2) * D + 8 * cg) : zz;
        v4u vm1 = t0 >= 1 ? *(const v4u*)(V + (size_t)(r0 - 1) * D + 8 * cg) : zz;
#pragma unroll 4
        for (int i = 0; i < 32; ++i) {
            const size_t off = (size_t)(r0 + i) * D + 8 * cg;
            const v4u v = P0_NT ? __builtin_nontemporal_load((const v4u*)(V + off)) : *(const v4u*)(V + off), bg = P0_NT ? __builtin_nontemporal_load((const v4u*)(Bg + off)) : *(const v4u*)(Bg + off);
            v4u o; float ylo8[4], yhi8[4];
#pragma unroll
            for (int q = 0; q < 4; ++q) {
                const float ylo = bflo(bg[q]) * (w0[2 * q] * bflo(vm2[q]) + w1[2 * q] * bflo(vm1[q]) + w2[2 * q] * bflo(v[q]));
                const float yhi = bfhi(bg[q]) * (w0[2 * q + 1] * bfhi(vm2[q]) + w1[2 * q + 1] * bfhi(vm1[q]) + w2[2 * q + 1] * bfhi(v[q]));
                o[q] = pk2(ylo, yhi); if (WOUT_FP8) { ylo8[q] = ylo; yhi8[q] = yhi; } }
            if (WOUT_FP8) { v2u w8; w8.x = pk_fp8x4((f32x4){ylo8[0], yhi8[0], ylo8[1], yhi8[1]} * F8_SH); w8.y = pk_fp8x4((f32x4){ylo8[2], yhi8[2], ylo8[3], yhi8[3]} * F8_SH); *(v2u*)((unsigned char*)Y + off) = w8; }
            else *(v4u*)(Y + off) = o;
            vm2 = vm1; vm1 = v;
        }
    }
}

__device__ __forceinline__ void bias_gemv(const Args& a, int gw, int NGW, int lane, const LAS float* shl) {
    unsigned char* ws = a.ws; float* BV = (float*)(ws + WS_BIASV);
    constexpr int NROW = 2 * FF + QKVP, RPW = 5;
    for (int base = 0; base < NROW; base += RPW * NGW) {
    float res[RPW][NB];
#pragma unroll
    for (int i = 0; i < RPW; ++i) {
        const int r = base + gw + i * NGW; const bool ok = r < NROW; const int rr = ok ? r : 0;
        const int ls = rr < 2 * FF ? 1 : 2, np = ls == 1 ? rr : rr - 2 * FF;
        float wf[16];
        if ((ls == 1 && DENSE_GU_FP8) || (ls == 2 && QKV_I8)) { const v4u w8 = *(const v4u*)(ws + (ls == 1 ? WS_WFGU : WS_WQKV) + (size_t)np * D + 16 * lane);
#pragma unroll
            for (int q = 0; q < 4; ++q) {
                if (GU_I8 || ls == 2) { const int w = (int)w8[q]; wf[4 * q] = (float)((w << 24) >> 24) * (1.0f / GU_SW); wf[4 * q + 1] = (float)((w << 16) >> 24) * (1.0f / GU_SW); wf[4 * q + 2] = (float)((w << 8) >> 24) * (1.0f / GU_SW); wf[4 * q + 3] = (float)(w >> 24) * (1.0f / GU_SW); }
                else { wf[4 * q] = __builtin_amdgcn_cvt_f32_fp8((int)w8[q], 0) * (1.0f / GU_SW); wf[4 * q + 1] = __builtin_amdgcn_cvt_f32_fp8((int)w8[q], 1) * (1.0f / GU_SW);
                    wf[4 * q + 2] = __builtin_amdgcn_cvt_f32_fp8((int)w8[q], 2) * (1.0f / GU_SW); wf[4 * q + 3] = __builtin_amdgcn_cvt_f32_fp8((int)w8[q], 3) * (1.0f / GU_SW); } } }
        else { const bf16* wrow = (ls == 1 ? (const bf16*)(ws + WS_WFGU) : (const bf16*)(ws + WS_WQKV)) + (size_t)np * D + 16 * lane;
            const v4u w0 = *(const v4u*)wrow, w1 = *(const v4u*)(wrow + 8);
#pragma unroll
            for (int q = 0; q < 4; ++q) { wf[2 * q] = bflo(w0[q]); wf[2 * q + 1] = bfhi(w0[q]); wf[8 + 2 * q] = bflo(w1[q]); wf[8 + 2 * q + 1] = bfhi(w1[q]); } }
#pragma unroll
        for (int b = 0; b < NB; ++b) { const LAS float* sh = shl + ((ls - 1) * 4 + b) * D + 16 * lane; float p = 0.f;
#pragma unroll
            for (int q = 0; q < 4; ++q) { const f32x4 s4 = *(const LAS f32x4*)(sh + 4 * q); p += (wf[4 * q] * s4.x + wf[4 * q + 1] * s4.y) + (wf[4 * q + 2] * s4.z + wf[4 * q + 3] * s4.w); }
            res[i][b] = wave_sum(p); }
    }
#pragma unroll
    for (int i = 0; i < RPW; ++i) { const int r = base + gw + i * NGW;
        if (r < NROW && lane == 0) { const int ls = r < 2 * FF ? 1 : 2, np = ls == 1 ? r : r - 2 * FF;
#pragma unroll
            for (int b = 0; b < NB; ++b) BV[(size_t)((ls - 1) * 4 + b) * (2 * FF) + np] = res[i][b]; } }
    }
}
typedef float f32x16 __attribute__((ext_vector_type(16)));
__device__ __forceinline__ pg8::bf16x8 w8_bf16(v2u w) {
    typedef float f2_t __attribute__((ext_vector_type(2)));
    const f2_t a = __builtin_amdgcn_cvt_pk_f32_fp8((int)w.x, false) * (1.0f / F8_SQKV), b = __builtin_amdgcn_cvt_pk_f32_fp8((int)w.x, true) * (1.0f / F8_SQKV);
    const f2_t c = __builtin_amdgcn_cvt_pk_f32_fp8((int)w.y, false) * (1.0f / F8_SQKV), d = __builtin_amdgcn_cvt_pk_f32_fp8((int)w.y, true) * (1.0f / F8_SQKV);
    v4u o; o.x = pg8::cvt_pk_bf16(a.x, a.y); o.y = pg8::cvt_pk_bf16(b.x, b.y); o.z = pg8::cvt_pk_bf16(c.x, c.y); o.w = pg8::cvt_pk_bf16(d.x, d.y);
    return __builtin_bit_cast(pg8::bf16x8, o); }
typedef short bf16x8 __attribute__((ext_vector_type(8)));
typedef short v4i16_t __attribute__((ext_vector_type(4)));
constexpr int ATT_TILES = NB * NH * 256;
constexpr int KROWB = 144;
constexpr int VROWB = 192;
template <int PASS>
__device__ __forceinline__ void attn_mfma(const Args& a, LAS unsigned char* lds, int gw, int NGW, int wave, int lane) {
    unsigned char* ws = a.ws;
    const bf16* QKV = (const bf16*)(ws + WS_QKV); bf16* AO = (bf16*)(ws + WS_H); float* LSE = (float*)(ws + WS_LSE);
    const int r32 = lane & 31, hi = lane >> 5;
    LAS unsigned char* vbuf = lds + wave * (32 * VROWB + 32 * KROWB);
    LAS unsigned char* kbuf = vbuf + 32 * VROWB;
    const int L16 = lane & 15, tq = L16 >> 2, tp = L16 & 3, gi = (lane >> 4) & 1;
    LAS unsigned char* trbase = vbuf + (4 * hi + tq) * VROWB + (16 * gi + 4 * tp) * 2;
    const bool OWNER = (NGW == 2048);
    const int ntl = OWNER ? NH * 128 : ATT_TILES, tstep = OWNER ? 256 : NGW;
    for (int lt = OWNER ? ((int)blockIdx.x >> 3) * NWAVES + wave : gw; lt < ntl; lt += tstep) {
        int tile = lt;
        if (OWNER) { const int x = (int)blockIdx.x & 7, hq_ = lt >> 7, tl = lt & 127, sh_ = 2 * (hq_ / 5), hb = 128 >> sh_;
            tile = ((tl >> (7 - sh_)) << (8 - sh_)) + (x & 1) * hb + (tl & (hb - 1)) + 256 * ((x >> 1) * NH + hq_); }
        const int ti = tile & 255, bh = tile >> 8, b = bh / NH, hq = bh - b * NH, g = hq / 5, slot = hq - g * 5;
        const int sh = 2 * g, r = 1 << sh, nblk = 256 >> sh, rho = ti >> (8 - sh), blk = ti & (nblk - 1), i0 = 32 * blk;
        const size_t tok0 = (size_t)b * SEQ + rho;
        const bf16* Qp = QKV + (tok0 + (size_t)r * (i0 + r32)) * QKVP + hq * 64 + 8 * hi;
        bf16x8 qf[4];
#pragma unroll
        for (int ds = 0; ds < 4; ++ds) qf[ds] = *(const bf16x8*)(Qp + 16 * ds);
        const int nkb = blk + 1 < 5 ? blk + 1 : 5;
        float m_run = -1e30f, l_run = 0.f, LT = 0.f;
        f32x16 o0 = {}, o1 = {};
        if (PASS == 1) { const float* lp = LSE + (tok0 + (size_t)r * (i0 + r32)) * 16 + slot; const float l0 = lp[0], l1 = lp[5], l2 = lp[10];
            const float mm = fmaxf(fmaxf(l0, l1), l2);
            LT = mm + __builtin_amdgcn_logf(__builtin_amdgcn_exp2f(l0 - mm) + __builtin_amdgcn_exp2f(l1 - mm) + __builtin_amdgcn_exp2f(l2 - mm)); }
        v4u krn[4], vrn[4];
#define ATT_LOAD(jj) do { const int p0_ = i0 + 32 * ((jj) - (nkb - 1)); \
            _Pragma("unroll") for (int c = 0; c < 4; ++c) { const int pi = lane + 64 * c, row = pi >> 3, chunk = pi & 7; const bf16* rp_ = QKV + (tok0 + (size_t)r * (p0_ + row)) * QKVP + 8 * chunk; \
                krn[c] = *(const v4u*)(rp_ + (NH + hq) * 64); if (PASS == 1) vrn[c] = *(const v4u*)(rp_ + (2 * NH + hq) * 64); } } while (0)
        ATT_LOAD(0);
        for (int j = 0; j < nkb; ++j) {
            const int kb = j - (nkb - 1);
            bf16x8 kf[4]; v4u vraw[4];
#pragma unroll
            for (int c = 0; c < 4; ++c) { const int pi = lane + 64 * c, row = pi >> 3, chunk = pi & 7; *(LAS v4u*)(kbuf + row * KROWB + chunk * 16) = krn[c]; }
            if (PASS == 1) {
#pragma unroll
                for (int c = 0; c < 4; ++c) vraw[c] = vrn[c]; }
            if (j + 1 < nkb) ATT_LOAD(j + 1);
#pragma unroll
            for (int ds = 0; ds < 4; ++ds) kf[ds] = *(const LAS bf16x8*)(kbuf + r32 * KROWB + (16 * ds + 8 * hi) * 2);
            f32x16 s = {};
#pragma unroll
            for (int ds = 0; ds < 4; ++ds) s = __builtin_amdgcn_mfma_f32_32x32x16_bf16(kf[ds], qf[ds], s, 0, 0, 0);
            if (kb == 0) {
#pragma unroll
                for (int q = 0; q < 16; ++q) { const int c = (q & 3) + 8 * (q >> 2) + 4 * hi; if (c > r32) s[q] = -1e30f; }
            } else if (kb == -4) {
#pragma unroll
                for (int q = 0; q < 16; ++q) { const int c = (q & 3) + 8 * (q >> 2) + 4 * hi; if (c < r32) s[q] = -1e30f; }
            }
            if (PASS == 0) {
                float bm = s[0];
#pragma unroll
                for (int q = 1; q < 16; ++q) bm = fmaxf(bm, s[q]);
                const float mn = fmaxf(m_run, bm); float acc = 0.f;
#pragma unroll
                for (int q = 0; q < 16; ++q) acc += __builtin_amdgcn_exp2f(s[q] - mn);
                l_run = l_run * __builtin_amdgcn_exp2f(m_run - mn) + acc; m_run = mn;
            } else {
#pragma unroll
                for (int c = 0; c < 4; ++c) { const int pi = lane + 64 * c, row = pi >> 3, chunk = pi & 7; *(LAS v4u*)(vbuf + row * VROWB + chunk * 16) = vraw[c]; }
                v4u pw0, pw1;
                { float p[16];
#pragma unroll
                  for (int q = 0; q < 16; ++q) p[q] = __builtin_amdgcn_exp2f(s[q] - LT);
                  pw0.x = pg8::cvt_pk_bf16(p[0], p[1]); pw0.y = pg8::cvt_pk_bf16(p[2], p[3]); pw0.z = pg8::cvt_pk_bf16(p[4], p[5]); pw0.w = pg8::cvt_pk_bf16(p[6], p[7]);
                  pw1.x = pg8::cvt_pk_bf16(p[8], p[9]); pw1.y = pg8::cvt_pk_bf16(p[10], p[11]); pw1.z = pg8::cvt_pk_bf16(p[12], p[13]); pw1.w = pg8::cvt_pk_bf16(p[14], p[15]); }
                const bf16x8 pa0 = __builtin_bit_cast(bf16x8, pw0), pa1 = __builtin_bit_cast(bf16x8, pw1);
#pragma unroll
                for (int db = 0; db < 2; ++db) {
                    bf16x8 vb[2];
#pragma unroll
                    for (int s2 = 0; s2 < 2; ++s2) {
                        const v4i16_t lo = __builtin_amdgcn_ds_read_tr16_b64_v4i16((LAS v4i16_t*)(trbase + (16 * s2) * VROWB + 64 * db));
                        const v4i16_t hh = __builtin_amdgcn_ds_read_tr16_b64_v4i16((LAS v4i16_t*)(trbase + (16 * s2 + 8) * VROWB + 64 * db));
                        vb[s2] = (bf16x8){lo[0], lo[1], lo[2], lo[3], hh[0], hh[1], hh[2], hh[3]};
                    }
                    if (db == 0) { o0 = __builtin_amdgcn_mfma_f32_32x32x16_bf16(pa0, vb[0], o0, 0, 0, 0); o0 = __builtin_amdgcn_mfma_f32_32x32x16_bf16(pa1, vb[1], o0, 0, 0, 0); }
                    else         { o1 = __builtin_amdgcn_mfma_f32_32x32x16_bf16(pa0, vb[0], o1, 0, 0, 0); o1 = __builtin_amdgcn_mfma_f32_32x32x16_bf16(pa1, vb[1], o1, 0, 0, 0); }
                }
            }
        }
        if (PASS == 0) {
            const float m2 = __shfl_xor(m_run, 32), l2 = __shfl_xor(l_run, 32);
            const float mt = fmaxf(m_run, m2), lt = l_run * __builtin_amdgcn_exp2f(m_run - mt) + l2 * __builtin_amdgcn_exp2f(m2 - mt);
            if (hi == 0) LSE[(tok0 + (size_t)r * (i0 + r32)) * 16 + hq] = mt + __builtin_amdgcn_logf(lt);
        } else {
#pragma unroll
            for (int q = 0; q < 16; ++q) { const int c = (q & 3) + 8 * (q >> 2) + 4 * hi;
                if (WO_FP8) { unsigned char* op8 = (unsigned char*)AO + (tok0 + (size_t)r * (i0 + c)) * D + hq * 64 + r32;
                    op8[0] = (unsigned char)(pk_fp8x4((f32x4){o0[q] * F8_SO, 0.f, 0.f, 0.f}) & 0xffu); op8[32] = (unsigned char)(pk_fp8x4((f32x4){o1[q] * F8_SO, 0.f, 0.f, 0.f}) & 0xffu); }
                else { bf16* op = AO + (tok0 + (size_t)r * (i0 + c)) * D + hq * 64 + r32; op[0] = (bf16)f2bf(o0[q]); op[32] = (bf16)f2bf(o1[q]); } }
            if (hq == 0) {
#pragma unroll
                for (int c = 0; c < 4; ++c) { const int pi = lane + 64 * c, row = pi >> 3, chunk = pi & 7;
                    if (WO_FP8) { if (chunk < 4) *(v4u*)((unsigned char*)AO + (tok0 + i0 + row) * D + 960 + 16 * chunk) = (v4u){0u, 0u, 0u, 0u}; }
                    else *(v4u*)(AO + (tok0 + i0 + row) * D + 960 + 8 * chunk) = (v4u){0u, 0u, 0u, 0u}; }
            }
        }
    }
}

__device__ __forceinline__ void attn_one(const Args& a, LAS unsigned char* lds, int gw, int NGW, int wave, int lane) {
    unsigned char* ws = a.ws;
    const bf16* QKV = (const bf16*)(ws + WS_QKV); unsigned char* AO = ws + WS_H; float* LSE = (float*)(ws + WS_LSE);
    const int r32 = lane & 31, hi = lane >> 5;
    LAS unsigned char* vbuf = lds + wave * (32 * VROWB + 32 * KROWB);
    LAS unsigned char* kbuf = vbuf + 32 * VROWB;
    const int L16 = lane & 15, tq = L16 >> 2, tp = L16 & 3, gi = (lane >> 4) & 1;
    LAS unsigned char* trbase = vbuf + (4 * hi + tq) * VROWB + (16 * gi + 4 * tp) * 2;
    const bool OWNER = (NGW == 2048);
    const int ntl = OWNER ? NH * 128 : ATT_TILES, tstep = OWNER ? 256 : NGW;
    for (int lt = OWNER ? ((int)blockIdx.x >> 3) * NWAVES + wave : gw; lt < ntl; lt += tstep) {
        int tile = lt;
        if (OWNER) { const int x = (int)blockIdx.x & 7, hq_ = lt >> 7, tl = lt & 127, sh_ = 2 * (hq_ / 5), hb = 128 >> sh_;
            tile = ((tl >> (7 - sh_)) << (8 - sh_)) + (x & 1) * hb + (tl & (hb - 1)) + 256 * ((x >> 1) * NH + hq_); }
        const int ti = tile & 255, bh = tile >> 8, b = bh / NH, hq = bh - b * NH, g = hq / 5;
        const int sh = 2 * g, r = 1 << sh, nblk = 256 >> sh, rho = ti >> (8 - sh), blk = ti & (nblk - 1), i0 = 32 * blk;
        const size_t tok0 = (size_t)b * SEQ + rho;
        bf16x8 qf[4];
        long qf8[4] = {0, 0, 0, 0};
        if (QKV_F8) { const unsigned char* Qp8 = (const unsigned char*)QKV + (tok0 + (size_t)r * (i0 + r32)) * QKVP + hq * 64 + 8 * hi;
#pragma unroll
            for (int ds = 0; ds < 4; ++ds) { if (QK_F8MMA) qf8[ds] = *(const long*)(Qp8 + 16 * ds); else qf[ds] = w8_bf16(*(const v2u*)(Qp8 + 16 * ds)); } }
        else { const bf16* Qp = QKV + (tok0 + (size_t)r * (i0 + r32)) * QKVP + hq * 64 + 8 * hi;
#pragma unroll
            for (int ds = 0; ds < 4; ++ds) qf[ds] = *(const bf16x8*)(Qp + 16 * ds); }
        const int kb0 = blk >= 4 ? 0 : 4 - blk;
        v4u krn[4], vrn[4];
#define A1_LOAD(dst, kbi, hoff) do { const int p0_ = i0 + 32 * ((kbi) - 4); \
            if (QKV_F8) { _Pragma("unroll") for (int c = 0; c < 2; ++c) { const int pi = lane + 64 * c, row = pi >> 2, chunk = pi & 3;     \
                dst[c] = *(const v4u*)((const unsigned char*)QKV + (tok0 + (size_t)r * (p0_ + row)) * QKVP + 16 * chunk + (hoff) * 64); } } \
            else { _Pragma("unroll") for (int c = 0; c < 4; ++c) { const int pi = lane + 64 * c, row = pi >> 3, chunk = pi & 7; \
                dst[c] = *(const v4u*)(QKV + (tok0 + (size_t)r * (p0_ + row)) * QKVP + 8 * chunk + (hoff) * 64); } } } while (0)
#define A1_TOLDS(buf, pitch, src) do { if (QKV_F8) { _Pragma("unroll") for (int c = 0; c < 2; ++c) { const int pi = lane + 64 * c, row = pi >> 2, chunk = pi & 3; \
                *(LAS bf16x8*)(buf + row * pitch + chunk * 32) = w8_bf16((v2u){src[c].x, src[c].y}); *(LAS bf16x8*)(buf + row * pitch + chunk * 32 + 16) = w8_bf16((v2u){src[c].z, src[c].w}); } } \
            else { _Pragma("unroll") for (int c = 0; c < 4; ++c) { const int pi = lane + 64 * c, row = pi >> 3, chunk = pi & 7; *(LAS v4u*)(buf + row * pitch + chunk * 16) = src[c]; } } } while (0)
        A1_LOAD(krn, kb0, NH + hq);
        f32x16 S[5];
        float m_run = -1e30f, l_run = 0.f;
#pragma unroll
        for (int kbi = 0; kbi < 5; ++kbi) {
            if (kbi >= kb0) {
                if (QKV_F8 && QK_F8MMA) {
#pragma unroll
                    for (int c = 0; c < 2; ++c) { const int pi = lane + 64 * c, row = pi >> 2, chunk = pi & 3;
                        *(LAS v2u*)(kbuf + row * 72 + chunk * 16) = (v2u){krn[c].x, krn[c].y}; *(LAS v2u*)(kbuf + row * 72 + chunk * 16 + 8) = (v2u){krn[c].z, krn[c].w}; } }
                else A1_TOLDS(kbuf, KROWB, krn);
                if (kbi < 4) A1_LOAD(krn, kbi + 1, NH + hq); else A1_LOAD(vrn, kb0, 2 * NH + hq);
                f32x16 s = {};
                if (QKV_F8 && QK_F8MMA) { long kf8[4];
#pragma unroll
                    for (int ds = 0; ds < 4; ++ds) kf8[ds] = *(const LAS long*)(kbuf + r32 * 72 + 16 * ds + 8 * hi);
#pragma unroll
                    for (int ds = 0; ds < 4; ++ds) s = __builtin_amdgcn_mfma_f32_32x32x16_fp8_fp8(kf8[ds], qf8[ds], s, 0, 0, 0);
                    s = s * (1.0f / (F8_SQKV * F8_SQKV)); }
                else { bf16x8 kf[4];
#pragma unroll
                    for (int ds = 0; ds < 4; ++ds) kf[ds] = *(const LAS bf16x8*)(kbuf + r32 * KROWB + (16 * ds + 8 * hi) * 2);
#pragma unroll
                    for (int ds = 0; ds < 4; ++ds) s = __builtin_amdgcn_mfma_f32_32x32x16_bf16(kf[ds], qf[ds], s, 0, 0, 0); }
                if (kbi == 4) {
#pragma unroll
                    for (int q = 0; q < 16; ++q) { const int c = (q & 3) + 8 * (q >> 2) + 4 * hi; if (c > r32) s[q] = -1e30f; }
                } else if (kbi == 0) {
#pragma unroll
                    for (int q = 0; q < 16; ++q) { const int c = (q & 3) + 8 * (q >> 2) + 4 * hi; if (c < r32) s[q] = -1e30f; }
                }
                float bm = s[0];
#pragma unroll
                for (int q = 1; q < 16; ++q) bm = fmaxf(bm, s[q]);
                const float mn = fmaxf(m_run, bm); float acc = 0.f;
#pragma unroll
                for (int q = 0; q < 16; ++q) acc += __builtin_amdgcn_exp2f(s[q] - mn);
                l_run = l_run * __builtin_amdgcn_exp2f(m_run - mn) + acc; m_run = mn;
                S[kbi] = s;
            }
        }
        float lse;
        { const float m2 = __shfl_xor(m_run, 32), l2 = __shfl_xor(l_run, 32);
          const float mt = fmaxf(m_run, m2), ltot = l_run * __builtin_amdgcn_exp2f(m_run - mt) + l2 * __builtin_amdgcn_exp2f(m2 - mt);
          lse = mt + __builtin_amdgcn_logf(ltot); }
        if (hi == 0) LSE[(tok0 + (size_t)r * (i0 + r32)) * 16 + hq] = lse;
        f32x16 o0 = {}, o1 = {};
#pragma unroll
        for (int kbi = 0; kbi < 5; ++kbi) {
            if (kbi >= kb0) {
                A1_TOLDS(vbuf, VROWB, vrn);
                if (kbi < 4) A1_LOAD(vrn, kbi + 1, 2 * NH + hq);
                v4u pw0, pw1;
                { float p[16];
#pragma unroll
                  for (int q = 0; q < 16; ++q) p[q] = __builtin_amdgcn_exp2f(S[kbi][q] - lse);
                  pw0.x = pg8::cvt_pk_bf16(p[0], p[1]); pw0.y = pg8::cvt_pk_bf16(p[2], p[3]); pw0.z = pg8::cvt_pk_bf16(p[4], p[5]); pw0.w = pg8::cvt_pk_bf16(p[6], p[7]);
                  pw1.x = pg8::cvt_pk_bf16(p[8], p[9]); pw1.y = pg8::cvt_pk_bf16(p[10], p[11]); pw1.z = pg8::cvt_pk_bf16(p[12], p[13]); pw1.w = pg8::cvt_pk_bf16(p[14], p[15]); }
                const bf16x8 pa0 = __builtin_bit_cast(bf16x8, pw0), pa1 = __builtin_bit_cast(bf16x8, pw1);
#pragma unroll
                for (int db = 0; db < 2; ++db) {
                    bf16x8 vb[2];
#pragma unroll
                    for (int s2 = 0; s2 < 2; ++s2) {
                        const v4i16_t lo = __builtin_amdgcn_ds_read_tr16_b64_v4i16((LAS v4i16_t*)(trbase + (16 * s2) * VROWB + 64 * db));
                        const v4i16_t hh = __builtin_amdgcn_ds_read_tr16_b64_v4i16((LAS v4i16_t*)(trbase + (16 * s2 + 8) * VROWB + 64 * db));
                        vb[s2] = (bf16x8){lo[0], lo[1], lo[2], lo[3], hh[0], hh[1], hh[2], hh[3]};
                    }
                    if (db == 0) { o0 = __builtin_amdgcn_mfma_f32_32x32x16_bf16(pa0, vb[0], o0, 0, 0, 0); o0 = __builtin_amdgcn_mfma_f32_32x32x16_bf16(pa1, vb[1], o0, 0, 0, 0); }
                    else         { o1 = __builtin_amdgcn_mfma_f32_32x32x16_bf16(pa0, vb[0], o1, 0, 0, 0); o1 = __builtin_amdgcn_mfma_f32_32x32x16_bf16(pa1, vb[1], o1, 0, 0, 0); }
                }
            }
        }
#undef A1_LOAD
#undef A1_TOLDS
#pragma unroll
        for (int q = 0; q < 16; ++q) { const int c = (q & 3) + 8 * (q >> 2) + 4 * hi;
            const unsigned pk = pk_fp8x4((f32x4){o0[q] * F8_SO, o1[q] * F8_SO, 0.f, 0.f});
            *(LAS unsigned char*)(vbuf + c * 80 + r32) = (unsigned char)(pk & 0xffu); *(LAS unsigned char*)(vbuf + c * 80 + 32 + r32) = (unsigned char)((pk >> 8) & 0xffu); }
#pragma unroll
        for (int h2 = 0; h2 < 2; ++h2) { const int row = (lane >> 2) + 16 * h2;
            const v4u ov = *(const LAS v4u*)(vbuf + row * 80 + 16 * (lane & 3));
            *(v4u*)(AO + (tok0 + (size_t)r * (i0 + row)) * D + hq * 64 + 16 * (lane & 3)) = ov; }
        if (hq == 0) {
#pragma unroll
            for (int c = 0; c < 4; ++c) { const int pi = lane + 64 * c, row = pi >> 3, chunk = pi & 7;
                if (chunk < 4) *(v4u*)(AO + (tok0 + i0 + row) * D + 960 + 16 * chunk) = (v4u){0u, 0u, 0u, 0u}; }
        }
    }
}
__device__ __forceinline__ void attn_fix(const Args& a, int G, int wave, int lane) {
    unsigned char* AO = a.ws + WS_H; const float* LSE = (const float*)(a.ws + WS_LSE);
    const int head = lane >> 2, slot = head % 5; const bool act = lane < 60;
    for (int ch = (G % 8 == 0) ? (blockIdx.x % 8) * (G / 8) + blockIdx.x / 8 : blockIdx.x; ch < NCHUNK; ch += G) {
        const int t0 = ch * 128 + wave * 16;
#pragma unroll 1
        for (int tb = 0; tb < 16; tb += 4) {
            v4u raw[4]; float l0[4], l1[4], l2[4];
#pragma unroll
            for (int j = 0; j < 4; ++j) { const size_t tok = (size_t)(t0 + tb + j);
                raw[j] = act ? *(const v4u*)(AO + tok * D + 16 * lane) : (v4u){0u, 0u, 0u, 0u};
                l0[j] = act ? LSE[tok * 16 + slot] : 0.f; l1[j] = act ? LSE[tok * 16 + slot + 5] : 0.f; l2[j] = act ? LSE[tok * 16 + slot + 10] : 0.f; }
#pragma unroll
            for (int j = 0; j < 4; ++j) { const size_t tok = (size_t)(t0 + tb + j);
                const float mm = fmaxf(fmaxf(l0[j], l1[j]), l2[j]);
                const float LT = mm + __builtin_amdgcn_logf(__builtin_amdgcn_exp2f(l0[j] - mm) + __builtin_amdgcn_exp2f(l1[j] - mm) + __builtin_amdgcn_exp2f(l2[j] - mm));
                const float mine = head < 5 ? l0[j] : (head < 10 ? l1[j] : l2[j]);
                const float f = __builtin_amdgcn_exp2f(mine - LT);
                v4u o;
#pragma unroll
                for (int q = 0; q < 4; ++q) { const int w = (int)raw[j][q];
                    o[q] = pk_fp8x4((f32x4){__builtin_amdgcn_cvt_f32_fp8(w, 0) * f, __builtin_amdgcn_cvt_f32_fp8(w, 1) * f, __builtin_amdgcn_cvt_f32_fp8(w, 2) * f, __builtin_amdgcn_cvt_f32_fp8(w, 3) * f}); }
                if (act) *(v4u*)(AO + tok * D + 16 * lane) = o; }
        }
    }
}

__device__ __forceinline__ void final_norm_phase(const Args& a, int gw, int NGW, int lane) {
    const bf16* XR = (const bf16*)(a.ws + WS_XR); const bf16* Y1 = (const bf16*)(a.ws + WS_Y1);
    f32x4 g[4];
#pragma unroll
    for (int j = 0; j < 4; ++j) g[j] = *((const f32x4*)a.final_g + lane + 64 * j);
    for (int row0 = gw; row0 < M; row0 += 2 * NGW) {
        v2u vv[2][4], yy[2][4];
#pragma unroll
        for (int q = 0; q < 2; ++q) { const int row = row0 + q * NGW; if (row < M) { const v2u* xr = (const v2u*)(XR + (size_t)row * D) + lane; const v2u* yr = (const v2u*)(Y1 + (size_t)row * D) + lane;
#pragma unroll
            for (int j = 0; j < 4; ++j) { vv[q][j] = P0_NT ? __builtin_nontemporal_load(xr + 64 * j) : xr[64 * j]; yy[q][j] = P0_NT ? __builtin_nontemporal_load(yr + 64 * j) : yr[64 * j]; } } }
#pragma unroll
        for (int q = 0; q < 2; ++q) { const int row = row0 + q * NGW; if (row < M) { f32x4* xo = (f32x4*)(a.out + (size_t)row * D) + lane; f32x4 v[4]; float s = 0.f;
#pragma unroll
            for (int j = 0; j < 4; ++j) { v[j] = (f32x4){bflo(vv[q][j].x) + bflo(yy[q][j].x), bfhi(vv[q][j].x) + bfhi(yy[q][j].x), bflo(vv[q][j].y) + bflo(yy[q][j].y), bfhi(vv[q][j].y) + bfhi(yy[q][j].y)};
                s += (v[j].x * v[j].x + v[j].y * v[j].y) + (v[j].z * v[j].z + v[j].w * v[j].w); }
            const float rinv = 1.0f / sqrtf(wave_sum(s) * (1.0f / D) + RMS_EPS);
#pragma unroll
            for (int j = 0; j < 4; ++j) { if (P0_NT) __builtin_nontemporal_store(v[j] * rinv * g[j], xo + 64 * j); else xo[64 * j] = v[j] * rinv * g[j]; } } }
    }
}

constexpr int NPHASE = 15;
__global__ void __launch_bounds__(NTHR, 2) trunk_fwd(Args args) {
    extern __shared__ __attribute__((aligned(16))) unsigned char lds_raw[];
    LAS unsigned char* lds = (LAS unsigned char*)lds_raw;
    volatile LAS unsigned* MISC = (volatile LAS unsigned*)(lds + MISC_OFF);
    const int tid = threadIdx.x, lane = tid & 63, wave = __builtin_amdgcn_readfirstlane(tid >> 6);
    const int G = gridDim.x; const int bx = blockIdx.x; const int vcu = (G % 8 == 0) ? (bx % 8) * (G / 8) + bx / 8 : bx;
    const int gw = vcu * NWAVES + wave, NGW = G * NWAVES;
    unsigned char* ws = args.ws;
    unsigned* ctl = (unsigned*)(ws + WS_CTL);
    if (tid < 256) ((LAS unsigned*)(lds + LDSCTL_OFF))[tid] = 0u;
    __syncthreads();
    XcdBarrier bar; bar.bar = ctl + CW_BAR; bar.x = 0; bar.st = nullptr;
    if (!MK_PER_PHASE) bar = xcd_barrier_post(ctl + CW_BAR, MISC + 8);
    if (!MK_PER_PHASE && tid == 0) __hip_atomic_fetch_or(ctl + CW_XMAP + (bx & 7), 1u << bar.x, __ATOMIC_RELAXED, __HIP_MEMORY_SCOPE_AGENT);
    bool local_ok = false;
    const int lo = args.ph_lo, hi = args.ph_hi;
#define IN(k) (lo <= (k) && (k) < hi)
#ifndef LOCAL_SEAMS
#define LOCAL_SEAMS 0x77au
#endif
#define SEAM(k) do { if (IN(k) && IN((k) + 1)) { if (((LOCAL_SEAMS >> (k)) & 1u) && local_ok) xcd_barrier_local(bar); else xcd_barrier(bar); } } while (0)
#define Hb ((bf16*)(ws + WS_H))
#define MF ((const float*)(ws + WS_MODF))

#ifndef PROBE_DUP
#define PROBE_DUP 0u
#endif
#ifndef PROBE_REP
#define PROBE_REP 1
#endif
#ifndef NOPH_MASK
#define NOPH_MASK 0u
#endif
#define RUN(k, body) do { if (IN(k) && !((NOPH_MASK >> (k)) & 1u)) { body; if ((PROBE_DUP >> (k)) & 1u) { _Pragma("unroll") for (int rep_ = 0; rep_ < PROBE_REP; ++rep_) { xcd_barrier(bar); body; } } } SEAM(k); } while (0)
#define COMMA ,
#define PH_GEMM(EPI, ORD, Aptr, Bptr, Mv, Nv, Kv, ...) do { pg8::Gemm g{Aptr, Bptr, Mv, Nv, Kv}; pg8::StaticOrder S; S.init(Mv, Nv, G, bx); EPI E{__VA_ARGS__}; \
        pg8::gemm_phase<EPI, pg8::StaticOrder, true, true>(lds, g, S, E); } while (0)
#define MOE_GU() do { pg8::MoeOrder S; S.init(ctl + CW_CNT, 2 * FF / 256, G, bx, (const int*)(ws + WS_RT2)); \
        pg8::Gemm g{Hb, (const bf16*)(ws + WS_WMGU), 0, 0, D}; EpiSwiGLU8 E{ws + WS_MHID, 2 * FF / 256}; \
        pg8::gemm_phase<EpiSwiGLU8, pg8::MoeOrder, true, true, true, 1, (MOE_I8 != 0)>(lds, g, S, E, lds + TOKSLOT_OFF); } while (0)
#define ZGp ((const float*)(ws + WS_ZG))
#define MOE_DN() do { pg8::MoeOrderId S; S.init(ctl + CW_CNT, D / 256, G, bx, (const int*)(ws + WS_IDENT), true); \
        LAS float* gt = (LAS float*)(lds + GATE_OFF); for (int i_ = tid; i_ < NB * D; i_ += NTHR) gt[i_] = MF[(size_t)(3 * 4 + (i_ >> 10)) * 3072 + 2048 + (i_ & (D - 1))]; __syncthreads(); \
        pg8::Gemm g{(const bf16*)(ws + WS_MHID), (const bf16*)(ws + WS_WMD), 0, 0, FF}; \
        EpiMoeDown E{XRp, (bf16*)(ws + WS_Y1), (const int*)(ws + WS_RT2), (const float*)(ws + WS_RW2), gt, 1.0f / (F8_SH * F8_SW), lds + RED_OFF}; \
        pg8::gemm_phase<EpiMoeDown, pg8::MoeOrderId, true, true, true, 1>(lds, g, S, E, lds + TOKSLOT_OFF); } while (0)
#define PH_GEMM8(EPI, I8v, Aptr, Bptr, Mv, Nv, Kv, ...) do { pg8::Gemm g{Aptr, Bptr, Mv, Nv, Kv}; pg8::StaticOrder S; S.init(Mv, Nv, G, bx, (const int*)(ws + WS_IDENT)); EPI E{__VA_ARGS__}; \
        pg8::gemm_phase<EPI, pg8::StaticOrder, true, true, true, 1, I8v>(lds, g, S, E, lds + TOKSLOT_OFF); } while (0)
#define SSb ((float*)(ws + WS_SS))
#define BV ((const float*)(ws + WS_BIASV))
    RUN(0, p0_prologue(args, lds, gw, NGW, wave, lane, tid));
    if (!MK_PER_PHASE && LOCAL_SEAMS && IN(0) && IN(1) && G == 256) {
        unsigned all = 0u; bool one = true;
#pragma unroll
        for (int j = 0; j < 8; ++j) { const unsigned m = xb_ld(ctl + CW_XMAP + j); one = one && (__builtin_popcount(m) == 1); all |= m; }
        local_ok = one && (__builtin_popcount(all) == 8) && (MISC[8] == 32u);
    }
    RUN(1, (norm_phase<true, false, false, (CONVIN_I8 != 0)>(args, args.x, 0, lds, G, wave, lane, tid)));
#if CONVIN_I8
    RUN(2, PH_GEMM8(EpiConvInT<true>, true, Hb, (const bf16*)(ws + WS_WCIN), M, 3072, D, (bf16*)(ws + WS_V), (bf16*)(ws + WS_BG), (const float*)(ws + WS_RSC), lds + GATE_OFF));
#else
    RUN(2, PH_GEMM(EpiConvIn, 0, Hb, (const bf16*)(ws + WS_WCIN), M, 3072, D, (bf16*)(ws + WS_V), (bf16*)(ws + WS_BG), nullptr, nullptr));
#endif
#ifdef PROBE_NULLGEMM_K
    if (IN(2)) { xcd_barrier(bar); PH_GEMM(EpiNull, 0, Hb, (const bf16*)(ws + WS_WCIN), M, PROBE_NULLGEMM_N, PROBE_NULLGEMM_K); xcd_barrier(bar); }
#endif
    RUN(3, conv_phase(args, G, tid));
#define XRp ((bf16*)(ws + WS_XR))
#define XB4p ((bf16*)args.out)
#if WOUT_FP8
    RUN(4, PH_GEMM8(EpiResidB<false COMMA true COMMA (DENSE_GU_FP8 != 0)>, false, Hb, (const bf16*)(ws + WS_WCOUT), M, D, D, XRp, XRp, MF + 0 * 4 * 3072 + 2048, XB4p, SSb, MF + 1 * 4 * 3072 + 1024, args.norm_g + 1 * D, (LAS float*)(lds + RED_OFF), 1.0f / (F8_SH * F8_SW)));
#else
    RUN(4, PH_GEMM(EpiResidB<false COMMA true COMMA (DENSE_GU_FP8 != 0)>, 0, Hb, (const bf16*)(ws + WS_WCOUT), M, D, D, XRp, XRp, MF + 0 * 4 * 3072 + 2048, XB4p, SSb, MF + 1 * 4 * 3072 + 1024, args.norm_g + 1 * D, (LAS float*)(lds + RED_OFF), 1.0f));
#endif
#if DENSE_GU_FP8
    RUN(5, PH_GEMM8(EpiSwiGLU<true COMMA true COMMA (DENSE_DOWN_FP8 != 0)>, (GU_I8 != 0), XB4p, (const bf16*)(ws + WS_WFGU), M, 2 * FF, D, (bf16*)(ws + WS_HID), 2 * FF / 256, SSb, BV, lds + GATE_OFF));
#else
    RUN(5, PH_GEMM(EpiSwiGLU<true COMMA false COMMA (DENSE_DOWN_FP8 != 0)>, 0, XB4p, (const bf16*)(ws + WS_WFGU), M, 2 * FF, D, (bf16*)(ws + WS_HID), 2 * FF / 256, SSb, BV, lds + GATE_OFF));
#endif
#if DENSE_DOWN_FP8
    RUN(6, PH_GEMM8(EpiResidB<false COMMA true COMMA (QKV_I8 != 0)>, false, (const bf16*)(ws + WS_HID), (const bf16*)(ws + WS_WFD), M, D, FF, XRp, XRp, MF + 1 * 4 * 3072 + 2048, Hb, SSb, MF + 2 * 4 * 3072 + 1024, args.norm_g + 2 * D, (LAS float*)(lds + RED_OFF), 1.0f / (F8_SH * F8_SW)));
#else
    RUN(6, PH_GEMM(EpiResidB<false COMMA true>, 0, (const bf16*)(ws + WS_HID), (const bf16*)(ws + WS_WFD), M, D, FF, XRp, XRp, MF + 1 * 4 * 3072 + 2048, Hb, SSb, MF + 2 * 4 * 3072 + 1024, args.norm_g + 2 * D, (LAS float*)(lds + RED_OFF), 1.0f));
#endif
#if QKV_I8
    RUN(7, PH_GEMM8(EpiQkvRopeT<true>, true, Hb, (const bf16*)(ws + WS_WQKV), M, QKVP, D, (bf16*)(ws + WS_QKV), (const unsigned*)(ws + WS_ROPE), SSb, BV + 4 * 2 * FF, lds + GATE_OFF));
#else
    RUN(7, PH_GEMM(EpiQkvRope, 0, Hb, (const bf16*)(ws + WS_WQKV), M, QKVP, D, (bf16*)(ws + WS_QKV), (const unsigned*)(ws + WS_ROPE), SSb, BV + 4 * 2 * FF, lds + GATE_OFF));
#endif
#if ATTN_ONE_PASS
    RUN(8, attn_one(args, lds, gw, NGW, wave, lane));
    RUN(9, attn_fix(args, G, wave, lane));
#else
    RUN(8, attn_mfma<0>(args, lds, gw, NGW, wave, lane));
    RUN(9, attn_mfma<1>(args, lds, gw, NGW, wave, lane));
#endif
#if WO_FP8
    RUN(10, PH_GEMM8(EpiResidB<false COMMA false>, false, Hb, (const bf16*)(ws + WS_WO), M, D, D, XRp, XRp, MF + 2 * 4 * 3072 + 2048, nullptr, nullptr, nullptr, nullptr, nullptr, 1.0f / (F8_SO * F8_SW)));
#else
    RUN(10, PH_GEMM(EpiResidB<false COMMA false>, 0, Hb, (const bf16*)(ws + WS_WO), M, D, D, XRp, XRp, MF + 2 * 4 * 3072 + 2048, nullptr, nullptr, nullptr, nullptr, nullptr, 1.0f));
#endif
    RUN(11, (norm_phase<false, true, true>(args, XRp, 3, lds, G, wave, lane, tid)));
    RUN(12, MOE_GU());
    RUN(13, MOE_DN());
    RUN(14, final_norm_phase(args, gw, NGW, lane));
#ifdef PROBE_XBAR
    for (int q = 0; q < PROBE_XBAR; ++q) xcd_barrier(bar);
#endif
#undef IN
#undef SEAM
}

extern "C" void kernel_launch(void* const* d_in, const int* in_sizes, int n_in, void* d_out, int out_size, void* d_ws, size_t ws_size, hipStream_t stream) {
    static int grid = 0;
    if (grid == 0) {
        if (n_in != 19 || out_size != M * D || ws_size < WS_END) { fprintf(stderr, "kernel_launch: unexpected shapes (n_in %d out %d ws %zu)\n", n_in, out_size, ws_size); grid = -1; return; }
        int dev = 0, cus = 0, per_cu = 0;
        if (hipGetDevice(&dev) != hipSuccess || hipDeviceGetAttribute(&cus, hipDeviceAttributeMultiprocessorCount, dev) != hipSuccess) { grid = -1; return; }
        if (hipFuncSetAttribute((const void*)trunk_fwd, hipFuncAttributeMaxDynamicSharedMemorySize, LDS_BYTES) != hipSuccess) { fprintf(stderr, "kernel_launch: hipFuncSetAttribute failed\n"); grid = -1; return; }
        if (hipOccupancyMaxActiveBlocksPerMultiprocessor(&per_cu, (const void*)trunk_fwd, NTHR, LDS_BYTES) != hipSuccess || per_cu < 1) fprintf(stderr, "kernel_launch: occupancy query reports %d\n", per_cu);
        (void)hipGetLastError();
        grid = cus;
    }
    if (grid < 0) return;
    (void)hipMemsetAsync((char*)d_ws + WS_CTL, 0, CTL_ZERO_BYTES, stream);
    Args a{};
    a.x = (const float*)d_in[0]; a.c = (const float*)d_in[1]; a.pos = (const int*)d_in[2]; a.mod_w = (const float*)d_in[3]; a.mod_b = (const float*)d_in[4]; a.norm_g = (const float*)d_in[5];
    a.conv_w_in = (const float*)d_in[6]; a.conv_w = (const float*)d_in[7]; a.conv_w_out = (const float*)d_in[8]; a.ffn_g = (const float*)d_in[9]; a.ffn_u = (const float*)d_in[10]; a.ffn_d = (const float*)d_in[11];
    a.w_qkv = (const float*)d_in[12]; a.w_o = (const float*)d_in[13]; a.router_w = (const float*)d_in[14]; a.moe_g = (const float*)d_in[15]; a.moe_u = (const float*)d_in[16]; a.moe_d = (const float*)d_in[17]; a.final_g = (const float*)d_in[18];
    a.out = (float*)d_out; a.ws = (unsigned char*)d_ws;
#if MK_PER_PHASE
    for (int p = 0; p < NPHASE; ++p) { a.ph_lo = p; a.ph_hi = p + 1; hipLaunchKernelGGL(trunk_fwd, dim3(grid), dim3(NTHR), LDS_BYTES, stream, a); }
#else
    a.ph_lo = 0; a.ph_hi = NPHASE; hipLaunchKernelGGL(trunk_fwd, dim3(grid), dim3(NTHR), LDS_BYTES, stream, a);
#endif
}
```
